# Optimizing an MI355X kernel written in HIP

```python
import jax, jax.numpy as jnp
from jax import lax
import numpy as np

D_MODEL = 1024
BATCH = 8
SEQ = 2048
DEPTH = 2

CHUNK = 64
Q_BLOCK = 128
ROPE_THETA = 500000.0
EPS = 1e-6

A_HEADS = 4
A_HEAD_DIM = 128
A_ROT = A_HEAD_DIM // 4
IDX_HEADS = 8
IDX_DIM = 64
IDX_ROT = IDX_DIM // 4
TOPK_MAX = 256
B_HEADS = 4
B_NOPE = 128
B_ROPE = 64
B_V = 128
B_Q_RANK = 256
B_KV_RANK = 128
C_HEADS = 4
C_HEAD_DIM = 128
C_LEFT_CHUNKS = 8
C_BAND = (C_LEFT_CHUNKS + 1) * CHUNK
REL_CLIP = 128
N_BRANCH = 3
A_QW = A_HEADS * A_HEAD_DIM
B_OUT = B_HEADS * B_V
C_W = C_HEADS * C_HEAD_DIM
IN_SIZES = (A_QW, A_HEAD_DIM, A_HEAD_DIM, IDX_HEADS * IDX_DIM, IDX_DIM, IDX_HEADS,
            B_Q_RANK, B_KV_RANK, B_ROPE, C_W, C_W, C_W, N_BRANCH * D_MODEL)
N_IN = (A_QW + 2 * A_HEAD_DIM + IDX_HEADS * IDX_DIM + IDX_DIM + IDX_HEADS
        + B_Q_RANK + B_KV_RANK + B_ROPE + 3 * C_W + N_BRANCH * D_MODEL)
N_GROUPS = 4
EXPERTS_PER_GROUP = 8
N_EXPERTS = N_GROUPS * EXPERTS_PER_GROUP
TOP_K_EXPERT = 2
D_EXPERT = 256

kernel_name = "hybrid_chunk_causal_dsa_mla_chunkattn_hmoe"


def rmsnorm(x, g):
    xf = x.astype(jnp.float32)
    y = xf * lax.rsqrt(jnp.mean(xf * xf, axis=-1, keepdims=True) + EPS)
    return (y * g.astype(jnp.float32)).astype(x.dtype)


def rope_tables(seq, rot):
    pos = jnp.arange(seq, dtype=jnp.float32)
    inv = ROPE_THETA ** (-jnp.arange(0, rot, 2, dtype=jnp.float32) / rot)
    ang = pos[:, None] * inv[None, :]
    return jnp.cos(ang), jnp.sin(ang)


def apply_rope(x, cos, sin):
    if x.ndim == 4:
        cos, sin = cos[:, None, :], sin[:, None, :]
    xf = x.astype(jnp.float32)
    x1, x2 = jnp.split(xf, 2, axis=-1)
    out = jnp.concatenate([x1 * cos - x2 * sin, x1 * sin + x2 * cos], axis=-1)
    return out.astype(x.dtype)


def partial_rope(x, cos, sin, rot):
    return jnp.concatenate([apply_rope(x[..., :rot], cos, sin), x[..., rot:]], axis=-1)


def split_cols(z, sizes):
    outs, off = [], 0
    for s in sizes:
        outs.append(z[..., off:off + s])
        off += s
    return outs


def to_blocks(t, nb):
    b = t.shape[0]
    return jnp.moveaxis(t.reshape((b, nb, Q_BLOCK) + t.shape[2:]), 1, 0)


def from_blocks(t):
    t = jnp.moveaxis(t, 0, 1)
    return t.reshape(t.shape[0], t.shape[1] * t.shape[2], -1)


def dsa_mixer(q, k, v, iq, ik, iw):
    bsz, seq = q.shape[0], q.shape[1]
    topk = min(TOPK_MAX, seq // 4)
    nb = seq // Q_BLOCK
    kchunk = jnp.arange(seq) // CHUNK
    qchunk = kchunk.reshape(nb, Q_BLOCK)
    iw = iw.astype(jnp.float32) * (IDX_HEADS ** -0.5)

    def one_block(args):
        qb, iqb, iwb, qc = args
        rel = jax.nn.relu(jnp.einsum('bqhd,bkd->bqhk', iqb, ik).astype(jnp.float32) * (IDX_DIM ** -0.5))
        score = jnp.einsum('bqhk,bqh->bqk', rel, iwb)
        allowed = kchunk[None, :] <= qc[:, None]
        score = jnp.where(allowed[None], score, -jnp.inf)
        _, idx = lax.top_k(score, topk)
        sel_ok = kchunk[idx] <= qc[None, :, None]
        kg = jax.vmap(lambda kk, ii: kk[ii])(k, idx)
        vg = jax.vmap(lambda vv, ii: vv[ii])(v, idx)
        logits = jnp.einsum('bqhd,bqkd->bqhk', qb, kg).astype(jnp.float32) * (A_HEAD_DIM ** -0.5)
        logits = jnp.where(sel_ok[:, :, None, :], logits, -jnp.inf)
        p = jax.nn.softmax(logits, axis=-1).astype(vg.dtype)
        return jnp.einsum('bqhk,bqkd->bqhd', p, vg)

    out = lax.map(one_block, (to_blocks(q, nb), to_blocks(iq, nb), to_blocks(iw, nb), qchunk))
    return from_blocks(out)


def mla_mixer(q_nope, q_rope, k_nope, k_rope, v):
    seq = q_nope.shape[1]
    nb = seq // Q_BLOCK
    kchunk = jnp.arange(seq) // CHUNK
    qchunk = kchunk.reshape(nb, Q_BLOCK)
    scale = (B_NOPE + B_ROPE) ** -0.5

    def one_block(args):
        qn, qr, qc = args
        s = (jnp.einsum('bqhd,bkhd->bhqk', qn, k_nope)
             + jnp.einsum('bqhr,bkr->bhqk', qr, k_rope)).astype(jnp.float32) * scale
        mask = kchunk[None, :] <= qc[:, None]
        s = jnp.where(mask[None, None], s, -jnp.inf)
        p = jax.nn.softmax(s, axis=-1).astype(v.dtype)
        return jnp.einsum('bhqk,bkhd->bqhd', p, v)

    out = lax.map(one_block, (to_blocks(q_nope, nb), to_blocks(q_rope, nb), qchunk))
    return from_blocks(out)


def chunk_band_mixer(q, k, v, rel_table):
    bsz, seq = q.shape[0], q.shape[1]
    n_chunks = seq // CHUNK
    shp = (bsz, n_chunks, CHUNK, C_HEADS, C_HEAD_DIM)
    qc, kc, vc = q.reshape(shp), k.reshape(shp), v.reshape(shp)
    pad = ((0, 0), (C_LEFT_CHUNKS, 0), (0, 0), (0, 0), (0, 0))
    kp, vp = jnp.pad(kc, pad), jnp.pad(vc, pad)
    band_idx = jnp.arange(n_chunks)[:, None] + jnp.arange(C_LEFT_CHUNKS + 1)[None, :]
    kb = kp[:, band_idx].reshape(bsz, n_chunks, C_BAND, C_HEADS, C_HEAD_DIM)
    vb = vp[:, band_idx].reshape(bsz, n_chunks, C_BAND, C_HEADS, C_HEAD_DIM)
    valid = jnp.repeat(band_idx >= C_LEFT_CHUNKS, CHUNK, axis=1)
    qi = jnp.arange(CHUNK)
    kj = jnp.arange(C_BAND)
    dist = C_LEFT_CHUNKS * CHUNK + qi[:, None] - kj[None, :]
    bias = rel_table[:, jnp.clip(dist, -REL_CLIP, REL_CLIP) + REL_CLIP].astype(jnp.float32)
    s = jnp.einsum('bcqhd,bckhd->bchqk', qc, kb).astype(jnp.float32) * (C_HEAD_DIM ** -0.5) + bias[None, None]
    s = jnp.where(valid[None, :, None, None, :], s, -jnp.inf)
    p = jax.nn.softmax(s, axis=-1).astype(vb.dtype)
    out = jnp.einsum('bchqk,bckhd->bcqhd', p, vb)
    return out.reshape(bsz, seq, C_W)


def hier_moe(h, w_group, b_group, w_router, b_router, w_gate, w_up, w_down):
    bsz, seq, d = h.shape
    t = h.reshape(-1, d)
    p_grp = jax.nn.softmax((t @ w_group).astype(jnp.float32) + b_group.astype(jnp.float32), axis=-1)
    pg, gsel = lax.top_k(p_grp, 1)
    e_logits = ((t @ w_router).astype(jnp.float32) + b_router.astype(jnp.float32)).reshape(-1, N_GROUPS, EXPERTS_PER_GROUP)
    e_in = jnp.take_along_axis(e_logits, gsel[:, :, None], axis=1)[:, 0]
    pe, esel = lax.top_k(jax.nn.softmax(e_in, axis=-1), TOP_K_EXPERT)
    wts = pg * pe / jnp.sum(pe, axis=-1, keepdims=True)
    gidx = gsel * EXPERTS_PER_GROUP + esel
    combine = jnp.sum(jax.nn.one_hot(gidx, N_EXPERTS, dtype=jnp.float32) * wts[..., None], axis=1)
    a = jnp.einsum('td,edf->tef', t, w_gate)
    u = jnp.einsum('td,edf->tef', t, w_up)
    hh = jax.nn.silu(a) * u * combine[:, :, None].astype(t.dtype)
    y = jnp.einsum('tef,efd->td', hh, w_down)
    return y.reshape(bsz, seq, d)


def setup_inputs(seed: int = 0) -> dict:
    key = jax.random.key(seed)
    ks = jax.random.split(key, 24)
    L = DEPTH
    f32 = jnp.float32

    def nrm(k, shape, fan):
        return jax.random.normal(k, shape, f32) * (fan ** -0.5)

    def gain(k, shape):
        return 1.0 + 0.05 * jax.random.normal(k, shape, f32)

    return {
        "x": jax.random.normal(ks[0], (BATCH, SEQ, D_MODEL), f32),
        "attn_norm_g": gain(ks[1], (L, D_MODEL)),
        "w_in": nrm(ks[2], (L, D_MODEL, N_IN), D_MODEL),
        "b_q_norm_g": gain(ks[3], (L, B_Q_RANK)),
        "b_w_uq": nrm(ks[4], (L, B_Q_RANK, B_HEADS * (B_NOPE + B_ROPE)), B_Q_RANK),
        "b_kv_norm_g": gain(ks[5], (L, B_KV_RANK)),
        "b_w_ukv": nrm(ks[6], (L, B_KV_RANK, B_HEADS * (B_NOPE + B_V)), B_KV_RANK),
        "c_rel_bias": 0.2 * jax.random.normal(ks[7], (L, C_HEADS, 2 * REL_CLIP + 1), f32),
        "w_proj_a": nrm(ks[8], (L, A_QW, D_MODEL), A_QW),
        "w_proj_b": nrm(ks[9], (L, B_OUT, D_MODEL), B_OUT),
        "w_proj_c": nrm(ks[10], (L, C_W, D_MODEL), C_W),
        "w_out": nrm(ks[11], (L, D_MODEL, D_MODEL), D_MODEL),
        "ffn_norm_g": gain(ks[12], (L, D_MODEL)),
        "w_group": nrm(ks[13], (L, D_MODEL, N_GROUPS), D_MODEL),
        "b_group": 0.01 * jax.random.normal(ks[14], (L, N_GROUPS), f32),
        "w_router": nrm(ks[15], (L, D_MODEL, N_EXPERTS), D_MODEL),
        "b_router": 0.01 * jax.random.normal(ks[16], (L, N_EXPERTS), f32),
        "w_gate": nrm(ks[17], (L, N_EXPERTS, D_MODEL, D_EXPERT), D_MODEL),
        "w_up": nrm(ks[18], (L, N_EXPERTS, D_MODEL, D_EXPERT), D_MODEL),
        "w_down": nrm(ks[19], (L, N_EXPERTS, D_EXPERT, D_MODEL), D_EXPERT),
        "final_norm_g": gain(ks[20], (D_MODEL,)),
    }


def reference(x, attn_norm_g, w_in, b_q_norm_g, b_w_uq, b_kv_norm_g, b_w_ukv, c_rel_bias,
              w_proj_a, w_proj_b, w_proj_c, w_out, ffn_norm_g, w_group, b_group,
              w_router, b_router, w_gate, w_up, w_down, final_norm_g):
    bsz, seq, d = x.shape
    cos_a, sin_a = rope_tables(seq, A_ROT)
    cos_i, sin_i = rope_tables(seq, IDX_ROT)
    cos_b, sin_b = rope_tables(seq, B_ROPE)
    for l in range(DEPTH):
        h = rmsnorm(x, attn_norm_g[l])
        z = h @ w_in[l]
        (aq, ak, av, aiq, aik, aiw, bcq, bckv, bkr, cq, ck, cv, gl) = split_cols(z, IN_SIZES)
        aq = partial_rope(aq.reshape(bsz, seq, A_HEADS, A_HEAD_DIM), cos_a, sin_a, A_ROT)
        ak = partial_rope(ak, cos_a, sin_a, A_ROT)
        aiq = partial_rope(aiq.reshape(bsz, seq, IDX_HEADS, IDX_DIM), cos_i, sin_i, IDX_ROT)
        aik = partial_rope(aik, cos_i, sin_i, IDX_ROT)
        o_a = dsa_mixer(aq, ak, av, aiq, aik, aiw)
        qb = (rmsnorm(bcq, b_q_norm_g[l]) @ b_w_uq[l]).reshape(bsz, seq, B_HEADS, B_NOPE + B_ROPE)
        q_nope = qb[..., :B_NOPE]
        q_rope = apply_rope(qb[..., B_NOPE:], cos_b, sin_b)
        kvb = (rmsnorm(bckv, b_kv_norm_g[l]) @ b_w_ukv[l]).reshape(bsz, seq, B_HEADS, B_NOPE + B_V)
        k_nope, vb = kvb[..., :B_NOPE], kvb[..., B_NOPE:]
        k_rope = apply_rope(bkr, cos_b, sin_b)
        o_b = mla_mixer(q_nope, q_rope, k_nope, k_rope, vb)
        hs = (bsz, seq, C_HEADS, C_HEAD_DIM)
        o_c = chunk_band_mixer(cq.reshape(hs), ck.reshape(hs), cv.reshape(hs), c_rel_bias[l])
        g = jax.nn.sigmoid(gl.astype(jnp.float32)).reshape(bsz, seq, N_BRANCH, d).astype(x.dtype)
        mix = (g[:, :, 0] * (o_a @ w_proj_a[l]) + g[:, :, 1] * (o_b @ w_proj_b[l])
               + g[:, :, 2] * (o_c @ w_proj_c[l]))
        x = x + mix @ w_out[l]
        x = x + hier_moe(rmsnorm(x, ffn_norm_g[l]), w_group[l], b_group[l], w_router[l], b_router[l],
                         w_gate[l], w_up[l], w_down[l])
    return rmsnorm(x, final_norm_g)
```

```cpp
#include <hip/hip_runtime.h>
#include <hip/hip_bf16.h>
#include <cstdint>
#include <cstdio>

typedef unsigned short bf16_t;
typedef unsigned long long u64;

constexpr int T = 16384, DM = 1024, SEQ = 2048, NB = 8;
constexpr int NIN = 6408, NZ = 6400;
constexpr float EPS = 1e-6f;

constexpr size_t MiB = (size_t)1 << 20;
constexpr size_t OFF_CTL = 0;
constexpr size_t OFF_WATT = 4 * MiB;
constexpr size_t OFF_XB = 23 * MiB;
constexpr size_t OFF_AQ = 55 * MiB;
constexpr size_t OFF_CQ = 71 * MiB;
constexpr size_t OFF_QB = 87 * MiB;
constexpr size_t OFF_ZA = 111 * MiB;
constexpr size_t OFF_AK = OFF_ZA;
constexpr size_t OFF_AV = OFF_AK + 4 * MiB;
constexpr size_t OFF_AIQ = OFF_AV + 4 * MiB;
constexpr size_t OFF_AIK = OFF_AIQ + 16 * MiB;
constexpr size_t OFF_BKR = OFF_AIK + 2 * MiB;
constexpr size_t OFF_BCKV = OFF_BKR + 2 * MiB;
constexpr size_t OFF_BCQ = OFF_BCKV + 4 * MiB;
constexpr size_t OFF_CK = OFF_BCQ + 8 * MiB;
constexpr size_t OFF_CV = OFF_CK + 16 * MiB;
constexpr size_t OFF_KVB = 183 * MiB;
constexpr size_t OFF_MASK = 215 * MiB;
constexpr size_t OFF_G = 219 * MiB;
constexpr size_t WS_END = 315 * MiB;
constexpr size_t OFF_MIX = OFF_KVB;
constexpr size_t OFF_WMOE = OFF_ZA;
constexpr size_t OFF_WGU = OFF_WMOE;
constexpr size_t OFF_WD = OFF_WMOE + 32 * MiB;
constexpr size_t OFF_Y = OFF_G;
constexpr size_t CTL_BAR = 0;
constexpr size_t CTL_CNT = 16 * 1024;
constexpr size_t CTL_ROPE = 64 * 1024;
constexpr size_t CTL_RSTD = 1 * MiB;
constexpr size_t CTL_RSTDQ = CTL_RSTD + 64 * 1024;
constexpr size_t CTL_RSTDKV = CTL_RSTDQ + 64 * 1024;
constexpr size_t CTL_AIW = CTL_RSTDKV + 64 * 1024;
constexpr size_t CTL_SSQ = 2 * MiB;
constexpr size_t CTL_TOKE = 3 * MiB;
constexpr size_t CTL_TOKW = CTL_TOKE + 128 * 1024;
constexpr size_t CTL_WIW = 3 * MiB + 512 * 1024;
constexpr size_t WA_IN = 0;
constexpr size_t WA_UQ = 13 * MiB;
constexpr size_t WA_UKV = WA_UQ + 512 * 1024;
constexpr size_t WA_P = 14 * MiB;
constexpr size_t WA_O = 17 * MiB;
constexpr int RT_COSA = 0, RT_SINA = 2048 * 16, RT_COSI = 2048 * 32, RT_SINI = 2048 * 40, RT_COSB = 2048 * 48, RT_SINB = 2048 * 80;

__device__ __forceinline__ float bf2f(bf16_t v) { return __uint_as_float(((unsigned)v) << 16); }
__device__ __forceinline__ bf16_t f2bf(float f) { unsigned u = __float_as_uint(f); return (bf16_t)((u + 0x7fffu + ((u >> 16) & 1u)) >> 16); }
__device__ __forceinline__ float sigmoidf_(float v) { return 1.f / (1.f + __expf(-v)); }
__device__ __forceinline__ float wave_sum(float v) {
  v += __shfl_xor(v, 32); v += __shfl_xor(v, 16); v += __shfl_xor(v, 8); v += __shfl_xor(v, 4); v += __shfl_xor(v, 2); v += __shfl_xor(v, 1); return v;
}
__device__ __forceinline__ void unpack8(const uint4 v, float (&f)[8]) {
  f[0] = __uint_as_float(v.x << 16); f[1] = __uint_as_float(v.x & 0xffff0000u); f[2] = __uint_as_float(v.y << 16); f[3] = __uint_as_float(v.y & 0xffff0000u);
  f[4] = __uint_as_float(v.z << 16); f[5] = __uint_as_float(v.z & 0xffff0000u); f[6] = __uint_as_float(v.w << 16); f[7] = __uint_as_float(v.w & 0xffff0000u);
}

struct Ptrs {
  const float* in[21];
  float* x;
  unsigned char* ws;
};

__host__ __device__ __forceinline__ int zmap(int c) {
  if (c < 1344) return c;
  if (c < 1408) { int n = c - 1344, g = n >> 5, r = n & 31; return 1736 + (r < 16 ? 16 * g + r : 32 + 16 * g + (r - 16)); }
  if (c < 1536) return 1608 + (c - 1408);
  if (c < 1792) return 1352 + (c - 1536);
  return c + 8;
}
__host__ __device__ __forceinline__ int uqmap(int c) {
  if (c < 512) { int h = c >> 7, d = c & 127; return h * 192 + d; }
  int n = c - 512, h = n >> 6, m = n & 63, g = m >> 5, r = m & 31;
  return h * 192 + 128 + (r < 16 ? 16 * g + r : 32 + 16 * g + (r - 16));
}
__host__ __device__ __forceinline__ int gumap(int n, int& isup) { int pn = n >> 8, j = n & 255; isup = j >= 128; return 128 * pn + (j & 127); }

struct TrDesc { const float* src; const float* src2; const float* scale; bf16_t* dst; int ld; int K; int N; int kind; };
__device__ __forceinline__ void transpose_tile(const TrDesc& d, int tn, int tk, float (*tile)[65]) {
  const int tid = threadIdx.x;
  const int n0 = tn * 64, k0 = tk * 64;
  {
    const int nn = tid & 63, kq = tid >> 6;
    const int n = n0 + nn;
    const float* s = d.src; int col;
    if (d.kind == 0) col = n; else if (d.kind == 1) col = zmap(n); else if (d.kind == 2) col = uqmap(n);
    else { int isup; col = gumap(n, isup); if (isup) s = d.src2; }
#pragma unroll 4
    for (int i = 0; i < 16; ++i) { int kk = kq + 4 * i; float v = s[(size_t)(k0 + kk) * d.ld + col]; if (d.scale) v *= d.scale[k0 + kk]; tile[kk][nn] = v; }
  }
  __syncthreads();
  {
    const int kk = tid & 63, nq = tid >> 6;
#pragma unroll 4
    for (int i = 0; i < 16; ++i) { int nn = nq + 4 * i; d.dst[(size_t)(n0 + nn) * d.K + k0 + kk] = f2bf(tile[kk][nn]); }
  }
  __syncthreads();
}
__global__ void __launch_bounds__(256) k_transpose(TrDesc d) {
  __shared__ float tile[64][65];
  const int ntn = d.N / 64, ntk = d.K / 64;
  for (int t = blockIdx.x; t < ntn * ntk; t += gridDim.x) transpose_tile(d, t / ntk, t % ntk, tile);
}
__global__ void __launch_bounds__(256) k_transpose_e(TrDesc d, size_t src_stride, size_t dst_stride) {
  __shared__ float tile[64][65];
  d.src += (size_t)blockIdx.y * src_stride; if (d.src2) d.src2 += (size_t)blockIdx.y * src_stride; d.dst += (size_t)blockIdx.y * dst_stride;
  const int ntn = d.N / 64, ntk = d.K / 64;
  for (int t = blockIdx.x; t < ntn * ntk; t += gridDim.x) transpose_tile(d, t / ntk, t % ntk, tile);
}
__global__ void k_prep_wiw(const float* w_in_l, const float* g, float* wiw) {
  int i = blockIdx.x * blockDim.x + threadIdx.x; if (i >= 8 * 1024) return;
  int h = i >> 10, k = i & 1023; wiw[i] = g[k] * w_in_l[(size_t)k * NIN + 1344 + h] * (0.35355339059327373f * 0.125f);
}
__global__ void k_rope_tables(float* rt) {
  int i = blockIdx.x * blockDim.x + threadIdx.x; if (i >= 2048 * 56) return;
  int pos = i / 56, j = i % 56; int rot, idx, oc, os;
  if (j < 16) { rot = 32; idx = j; oc = RT_COSA + pos * 16 + idx; os = RT_SINA + pos * 16 + idx; }
  else if (j < 24) { rot = 16; idx = j - 16; oc = RT_COSI + pos * 8 + idx; os = RT_SINI + pos * 8 + idx; }
  else { rot = 64; idx = j - 24; oc = RT_COSB + pos * 32 + idx; os = RT_SINB + pos * 32 + idx; }
  float inv = (float)pow(500000.0, -(double)(2 * idx) / (double)rot);
  float ang = (float)pos * inv;
  rt[oc] = (float)cos((double)ang); rt[os] = (float)sin((double)ang);
}
__global__ void __launch_bounds__(256) k_x_init(const float* xin, float* x, bf16_t* xb, float* rstd) {
  int row = blockIdx.x * 4 + (threadIdx.x >> 6), lane = threadIdx.x & 63;
  const float4* s = (const float4*)(xin + (size_t)row * DM); float4* d = (float4*)(x + (size_t)row * DM);
  float ss = 0.f;
#pragma unroll
  for (int i = 0; i < 4; ++i) { float4 v = s[lane + 64 * i]; d[lane + 64 * i] = v; ss += v.x * v.x + v.y * v.y + v.z * v.z + v.w * v.w;
    bf16_t* o = xb + (size_t)row * DM + (lane + 64 * i) * 4; o[0] = f2bf(v.x); o[1] = f2bf(v.y); o[2] = f2bf(v.z); o[3] = f2bf(v.w); }
  for (int o = 32; o; o >>= 1) ss += __shfl_xor(ss, o);
  if (lane == 0) rstd[row] = rsqrtf(ss * (1.f / DM) + EPS);
}

enum { EPI_IN = 0, EPI_UQ, EPI_UKV, EPI_PROJ0, EPI_PROJ1, EPI_PROJ2, EPI_OUT };
struct EpiP { unsigned char* ws; float* x; };
template <int EPI> __device__ __forceinline__ void epi_elem(const EpiP& p, int row, int col, float v) {
  unsigned char* ws = p.ws;
  if (EPI == EPI_IN) {
    v *= ((const float*)(ws + OFF_CTL + CTL_RSTD))[row];
    const size_t r = row;
    if (col < 512) ((bf16_t*)(ws + OFF_AQ))[r * 512 + col] = f2bf(v);
    else if (col < 640) ((bf16_t*)(ws + OFF_AK))[r * 128 + col - 512] = f2bf(v);
    else if (col < 768) ((bf16_t*)(ws + OFF_AV))[r * 128 + col - 640] = f2bf(v);
    else if (col < 1280) ((bf16_t*)(ws + OFF_AIQ))[r * 512 + col - 768] = f2bf(v);
    else if (col < 1344) ((bf16_t*)(ws + OFF_AIK))[r * 64 + col - 1280] = f2bf(v);
    else if (col < 1408) ((bf16_t*)(ws + OFF_BKR))[r * 64 + col - 1344] = f2bf(v);
    else if (col < 1536) ((bf16_t*)(ws + OFF_BCKV))[r * 128 + col - 1408] = f2bf(v);
    else if (col < 1792) ((bf16_t*)(ws + OFF_BCQ))[r * 256 + col - 1536] = f2bf(v);
    else if (col < 2304) ((bf16_t*)(ws + OFF_CQ))[r * 512 + col - 1792] = f2bf(v);
    else if (col < 2816) ((bf16_t*)(ws + OFF_CK))[r * 512 + col - 2304] = f2bf(v);
    else if (col < 3328) ((bf16_t*)(ws + OFF_CV))[r * 512 + col - 2816] = f2bf(v);
    else ((bf16_t*)(ws + OFF_G))[r * 3072 + col - 3328] = f2bf(sigmoidf_(v));
  } else if (EPI == EPI_UQ) {
    v *= ((const float*)(ws + OFF_CTL + CTL_RSTDQ))[row];
    ((bf16_t*)(ws + OFF_QB))[(size_t)row * 768 + col] = f2bf(v);
  } else if (EPI == EPI_UKV) {
    v *= ((const float*)(ws + OFF_CTL + CTL_RSTDKV))[row];
    ((bf16_t*)(ws + OFF_KVB))[(size_t)row * 1024 + col] = f2bf(v);
  } else if (EPI == EPI_PROJ0 || EPI == EPI_PROJ1 || EPI == EPI_PROJ2) {
    const int b = EPI - EPI_PROJ0;
    float g = bf2f(((const bf16_t*)(ws + OFF_G))[(size_t)row * 3072 + b * 1024 + col]);
    bf16_t* m = (bf16_t*)(ws + OFF_MIX) + (size_t)row * 1024 + col;
    float acc = g * v; if (b) acc += bf2f(*m); *m = f2bf(acc);
  } else if (EPI == EPI_OUT) {
    float* xp = p.x + (size_t)row * DM + col; float xn = *xp + v; *xp = xn;
    ((bf16_t*)(ws + OFF_XB))[(size_t)row * DM + col] = f2bf(xn);
  }
}
template <int EPI>
__global__ void __launch_bounds__(256) k_gemm_simple(const bf16_t* A, int lda, const bf16_t* Bt, int ldb, int M, int N, int K, EpiP p) {
  __shared__ float As[32][65], Bs[32][65];
  const int tid = threadIdx.x, tx = tid & 15, ty = tid >> 4;
  const int m0 = blockIdx.y * 64, n0 = blockIdx.x * 64;
  float acc[4][4] = {};
  const int lr = tid >> 2, lk = (tid & 3) * 8;
  for (int k0 = 0; k0 < K; k0 += 32) {
    const bf16_t* ap = A + (size_t)(m0 + lr) * lda + k0 + lk; const bf16_t* bp = Bt + (size_t)(n0 + lr) * ldb + k0 + lk;
    uint4 av = *(const uint4*)ap, bv = *(const uint4*)bp;
    float a8[8], b8[8]; unpack8(av, a8); unpack8(bv, b8);
#pragma unroll
    for (int j = 0; j < 8; ++j) { As[lk + j][lr] = a8[j]; Bs[lk + j][lr] = b8[j]; }
    __syncthreads();
#pragma unroll 8
    for (int k = 0; k < 32; ++k) {
      float a[4], b[4];
#pragma unroll
      for (int i = 0; i < 4; ++i) { a[i] = As[k][ty * 4 + i]; b[i] = Bs[k][tx * 4 + i]; }
#pragma unroll
      for (int i = 0; i < 4; ++i)
#pragma unroll
        for (int j = 0; j < 4; ++j) acc[i][j] += a[i] * b[j];
    }
    __syncthreads();
  }
#pragma unroll
  for (int i = 0; i < 4; ++i)
#pragma unroll
    for (int j = 0; j < 4; ++j) epi_elem<EPI>(p, m0 + ty * 4 + i, n0 + tx * 4 + j, acc[i][j]);
}

__global__ void __launch_bounds__(256) k_aiw(const bf16_t* xb, const float* rstd, const float* wiw, float* aiw) {
  int t = blockIdx.x * 4 + (threadIdx.x >> 6), lane = threadIdx.x & 63;
  float acc[8] = {};
  for (int k = lane; k < DM; k += 64) { float xv = bf2f(xb[(size_t)t * DM + k]);
#pragma unroll
    for (int h = 0; h < 8; ++h) acc[h] += xv * wiw[h * DM + k]; }
#pragma unroll
  for (int h = 0; h < 8; ++h) { float v = acc[h]; for (int o = 32; o; o >>= 1) v += __shfl_xor(v, o); if (lane == 0) aiw[t * 8 + h] = v * rstd[t]; }
}
__global__ void __launch_bounds__(256) k_rowstat_bf16(const bf16_t* src, int W, float* rstd) {
  int t = blockIdx.x * 4 + (threadIdx.x >> 6), lane = threadIdx.x & 63; float ss = 0.f;
  for (int k = lane; k < W; k += 64) { float v = bf2f(src[(size_t)t * W + k]); ss += v * v; }
  for (int o = 32; o; o >>= 1) ss += __shfl_xor(ss, o);
  if (lane == 0) rstd[t] = rsqrtf(ss / (float)W + EPS);
}
__device__ __forceinline__ void rope_pair(bf16_t* p1, bf16_t* p2, float c, float s) {
  float x1 = bf2f(*p1), x2 = bf2f(*p2); *p1 = f2bf(x1 * c - x2 * s); *p2 = f2bf(x1 * s + x2 * c);
}
__global__ void __launch_bounds__(256) k_rope_in(unsigned char* ws) {
  const float* rt = (const float*)(ws + OFF_CTL + CTL_ROPE);
  for (int i = threadIdx.x; i < 184; i += blockDim.x) {
    int t = blockIdx.x, pos = t & (SEQ - 1);
    if (i < 64) { int h = i >> 4, j = i & 15; bf16_t* q = (bf16_t*)(ws + OFF_AQ) + (size_t)t * 512 + h * 128; rope_pair(q + j, q + j + 16, rt[RT_COSA + pos * 16 + j], rt[RT_SINA + pos * 16 + j]); }
    else if (i < 80) { int j = i - 64; bf16_t* q = (bf16_t*)(ws + OFF_AK) + (size_t)t * 128; rope_pair(q + j, q + j + 16, rt[RT_COSA + pos * 16 + j], rt[RT_SINA + pos * 16 + j]); }
    else if (i < 144) { int n = i - 80, h = n >> 3, j = n & 7; bf16_t* q = (bf16_t*)(ws + OFF_AIQ) + (size_t)t * 512 + h * 64; rope_pair(q + j, q + j + 8, rt[RT_COSI + pos * 8 + j], rt[RT_SINI + pos * 8 + j]); }
    else if (i < 152) { int j = i - 144; bf16_t* q = (bf16_t*)(ws + OFF_AIK) + (size_t)t * 64; rope_pair(q + j, q + j + 8, rt[RT_COSI + pos * 8 + j], rt[RT_SINI + pos * 8 + j]); }
    else { int n = i - 152, g = n >> 4, j = n & 15, f = 16 * g + j; bf16_t* q = (bf16_t*)(ws + OFF_BKR) + (size_t)t * 64 + 32 * g; rope_pair(q + j, q + j + 16, rt[RT_COSB + pos * 32 + f], rt[RT_SINB + pos * 32 + f]); }
  }
}
__global__ void __launch_bounds__(128) k_rope_qb(unsigned char* ws) {
  const float* rt = (const float*)(ws + OFF_CTL + CTL_ROPE);
  int t = blockIdx.x, pos = t & (SEQ - 1), i = threadIdx.x;
  int h = i >> 5, n = i & 31, g = n >> 4, j = n & 15, f = 16 * g + j;
  bf16_t* q = (bf16_t*)(ws + OFF_QB) + (size_t)t * 768 + 512 + h * 64 + 32 * g;
  rope_pair(q + j, q + j + 16, rt[RT_COSB + pos * 32 + f], rt[RT_SINB + pos * 32 + f]);
}
__global__ void __launch_bounds__(256) k_indexer_simple(unsigned char* ws) {
  __shared__ float sc[2048]; __shared__ float q[8][64]; __shared__ float w[8]; __shared__ unsigned bits[64];
  const int t = blockIdx.x, b = t >> 11, pos = t & 2047, c = pos >> 6, nk = (c + 1) * 64, tid = threadIdx.x;
  const bf16_t* iq = (const bf16_t*)(ws + OFF_AIQ) + (size_t)t * 512;
  for (int i = tid; i < 512; i += 256) q[i >> 6][i & 63] = bf2f(iq[i]);
  if (tid < 8) w[tid] = ((const float*)(ws + OFF_CTL + CTL_AIW))[t * 8 + tid];
  if (tid < 64) bits[tid] = 0u;
  __syncthreads();
  const bf16_t* ik = (const bf16_t*)(ws + OFF_AIK) + (size_t)(b * SEQ) * 64;
  for (int k = tid; k < nk; k += 256) {
    float kv[64];
#pragma unroll
    for (int d = 0; d < 64; ++d) kv[d] = bf2f(ik[(size_t)k * 64 + d]);
    float s = 0.f;
#pragma unroll
    for (int h = 0; h < 8; ++h) { float dp = 0.f;
#pragma unroll
      for (int d = 0; d < 64; ++d) dp += q[h][d] * kv[d];
      s += fmaxf(dp, 0.f) * w[h]; }
    sc[k] = s;
  }
  __syncthreads();
  for (int k = tid; k < nk; k += 256) {
    bool sel = true;
    if (nk > 256) { float s = sc[k]; int cnt = 0; for (int j = 0; j < nk; ++j) { float o = sc[j]; cnt += (o > s) || (o == s && j < k); } sel = cnt < 256; }
    if (sel) atomicOr(&bits[k >> 5], 1u << (k & 31));
  }
  __syncthreads();
  if (tid < 64) ((unsigned*)(ws + OFF_MASK))[(size_t)t * 64 + tid] = bits[tid];
}
template <int MODE>
__global__ void __launch_bounds__(256) k_attn_simple(unsigned char* ws, const float* relb) {
  __shared__ float q[4][192]; __shared__ float lg[2048]; __shared__ float red[256]; __shared__ float osh[4][128]; __shared__ float part[2][128];
  const int t = blockIdx.x, b = t >> 11, pos = t & 2047, c = pos >> 6, tid = threadIdx.x;
  const size_t tb = (size_t)b * SEQ;
  if (MODE == 0) { const bf16_t* s = (const bf16_t*)(ws + OFF_AQ) + (size_t)t * 512; for (int i = tid; i < 512; i += 256) q[i >> 7][i & 127] = bf2f(s[i]); }
  else if (MODE == 1) { const bf16_t* s = (const bf16_t*)(ws + OFF_QB) + (size_t)t * 768;
    for (int i = tid; i < 512; i += 256) q[i >> 7][i & 127] = bf2f(s[i]);
    for (int i = tid; i < 256; i += 256) q[i >> 6][128 + (i & 63)] = bf2f(s[512 + i]); }
  else { const bf16_t* s = (const bf16_t*)(ws + OFF_CQ) + (size_t)t * 512; for (int i = tid; i < 512; i += 256) q[i >> 7][i & 127] = bf2f(s[i]); }
  __syncthreads();
  const int k_lo = (MODE == 2) ? (c >= 8 ? (c - 8) * 64 : 0) : 0, k_hi = (c + 1) * 64;
  const unsigned* mb = (const unsigned*)(ws + OFF_MASK) + (size_t)t * 64;
  for (int h = 0; h < 4; ++h) {
    float mx = -INFINITY;
    for (int k = k_lo + tid; k < k_hi; k += 256) {
      float s;
      if (MODE == 0) { const bf16_t* kp = (const bf16_t*)(ws + OFF_AK) + (tb + k) * 128; float dp = 0.f; for (int d = 0; d < 128; ++d) dp += q[h][d] * bf2f(kp[d]);
        s = dp * 0.088388347648318440f; if (!((mb[k >> 5] >> (k & 31)) & 1u)) s = -INFINITY; }
      else if (MODE == 1) { const bf16_t* kp = (const bf16_t*)(ws + OFF_KVB) + (tb + k) * 1024 + h * 256; const bf16_t* kr = (const bf16_t*)(ws + OFF_BKR) + (tb + k) * 64;
        float dp = 0.f; for (int d = 0; d < 128; ++d) dp += q[h][d] * bf2f(kp[d]); for (int d = 0; d < 64; ++d) dp += q[h][128 + d] * bf2f(kr[d]);
        s = dp * 0.07216878364870322f; }
      else { const bf16_t* kp = (const bf16_t*)(ws + OFF_CK) + (tb + k) * 512 + h * 128; float dp = 0.f; for (int d = 0; d < 128; ++d) dp += q[h][d] * bf2f(kp[d]);
        int dist = pos - k; dist = dist < -128 ? -128 : (dist > 128 ? 128 : dist); s = dp * 0.088388347648318440f + relb[h * 257 + dist + 128]; }
      lg[k] = s; mx = fmaxf(mx, s);
    }
    red[tid] = mx; __syncthreads();
    for (int o = 128; o; o >>= 1) { if (tid < o) red[tid] = fmaxf(red[tid], red[tid + o]); __syncthreads(); }
    mx = red[0]; __syncthreads();
    float sm = 0.f;
    for (int k = k_lo + tid; k < k_hi; k += 256) { float p = __expf(lg[k] - mx); lg[k] = p; sm += p; }
    red[tid] = sm; __syncthreads();
    for (int o = 128; o; o >>= 1) { if (tid < o) red[tid] += red[tid + o]; __syncthreads(); }
    sm = red[0]; __syncthreads();
    { const int d = tid & 127, hf = tid >> 7; float acc = 0.f;
      for (int k = k_lo + hf; k < k_hi; k += 2) { float p = lg[k]; if (p != 0.f) {
          float v;
          if (MODE == 0) v = bf2f(((const bf16_t*)(ws + OFF_AV))[(tb + k) * 128 + d]);
          else if (MODE == 1) v = bf2f(((const bf16_t*)(ws + OFF_KVB))[(tb + k) * 1024 + h * 256 + 128 + d]);
          else v = bf2f(((const bf16_t*)(ws + OFF_CV))[(tb + k) * 512 + h * 128 + d]);
          acc += p * v; } }
      part[hf][d] = acc; __syncthreads();
      if (tid < 128) osh[h][tid] = (part[0][tid] + part[1][tid]) / sm;
      __syncthreads(); }
  }
  bf16_t* o = (MODE == 0) ? (bf16_t*)(ws + OFF_AQ) + (size_t)t * 512 : (MODE == 1) ? (bf16_t*)(ws + OFF_QB) + (size_t)t * 768 : (bf16_t*)(ws + OFF_CQ) + (size_t)t * 512;
  for (int i = tid; i < 512; i += 256) o[i] = f2bf(osh[i >> 7][i & 127]);
}
__global__ void __launch_bounds__(256) k_router(const float* x, const float* g, const float* wg, const float* bg, const float* wr, const float* br, int* toke, float* tokw, float* rstd_out) {
  const int t = blockIdx.x * 4 + (threadIdx.x >> 6), lane = threadIdx.x & 63;
  float acc[36];
#pragma unroll
  for (int i = 0; i < 36; ++i) acc[i] = 0.f;
  float ss = 0.f;
  for (int k = lane; k < DM; k += 64) { float xv = x[(size_t)t * DM + k]; ss += xv * xv; float tv = xv * g[k];
    const float4 w4 = *(const float4*)(wg + k * 4); acc[0] += tv * w4.x; acc[1] += tv * w4.y; acc[2] += tv * w4.z; acc[3] += tv * w4.w;
#pragma unroll
    for (int j = 0; j < 8; ++j) { const float4 r4 = *(const float4*)(wr + k * 32 + j * 4); acc[4 + 4 * j] += tv * r4.x; acc[5 + 4 * j] += tv * r4.y; acc[6 + 4 * j] += tv * r4.z; acc[7 + 4 * j] += tv * r4.w; } }
  ss = wave_sum(ss);
  const float rs = rsqrtf(ss * (1.f / DM) + EPS);
#pragma unroll
  for (int i = 0; i < 36; ++i) acc[i] = wave_sum(acc[i]) * rs;
  float mx = -INFINITY;
#pragma unroll
  for (int j = 0; j < 4; ++j) { acc[j] += bg[j]; mx = fmaxf(mx, acc[j]); }
  float sm = 0.f, best = -1.f; int gs = 0;
#pragma unroll
  for (int j = 0; j < 4; ++j) { float p = __expf(acc[j] - mx); sm += p; if (p > best) { best = p; gs = j; } }
  const float pg = best / sm;
  float e[8];
  const float m0 = gs == 0 ? 1.f : 0.f, m1 = gs == 1 ? 1.f : 0.f, m2 = gs == 2 ? 1.f : 0.f, m3 = gs == 3 ? 1.f : 0.f;
#pragma unroll
  for (int j = 0; j < 8; ++j) e[j] = (acc[4 + j] * m0 + acc[12 + j] * m1) + (acc[20 + j] * m2 + acc[28 + j] * m3) + br[gs * 8 + j];
  float emx = -INFINITY;
#pragma unroll
  for (int j = 0; j < 8; ++j) emx = fmaxf(emx, e[j]);
  float es = 0.f, b0 = -1.f, b1 = -1.f; int i0 = 0, i1 = 0;
#pragma unroll
  for (int j = 0; j < 8; ++j) { float p = __expf(e[j] - emx); es += p;
    if (p > b0) { b1 = b0; i1 = i0; b0 = p; i0 = j; } else if (p > b1) { b1 = p; i1 = j; } }
  if (lane == 0) {
    rstd_out[t] = rs;
    const float p0 = b0 / es, p1 = b1 / es, ps = p0 + p1;
    toke[t * 2] = gs * 8 + i0; toke[t * 2 + 1] = gs * 8 + i1; tokw[t * 2] = pg * p0 / ps; tokw[t * 2 + 1] = pg * p1 / ps;
  }
}
__global__ void __launch_bounds__(256) k_moe_simple(unsigned char* ws) {
  __shared__ float xs[1024]; __shared__ float hs[256];
  const int t = blockIdx.x, tid = threadIdx.x;
  const float rs = ((const float*)(ws + OFF_CTL + CTL_RSTD))[t];
  for (int i = tid; i < 1024; i += 256) xs[i] = bf2f(((const bf16_t*)(ws + OFF_XB))[(size_t)t * DM + i]);
  __syncthreads();
  const int* toke = (const int*)(ws + OFF_CTL + CTL_TOKE); const float* tokw = (const float*)(ws + OFF_CTL + CTL_TOKW);
  for (int s = 0; s < 2; ++s) {
    const int e = toke[t * 2 + s]; const float w = tokw[t * 2 + s];
    const bf16_t* wgu = (const bf16_t*)(ws + OFF_WGU) + (size_t)e * 512 * 1024;
    const int f = tid, pn = f >> 7, j = f & 127;
    const bf16_t* gr = wgu + (size_t)(256 * pn + j) * 1024; const bf16_t* ur = wgu + (size_t)(256 * pn + 128 + j) * 1024;
    float a = 0.f, u = 0.f;
    for (int k = 0; k < 1024; k += 8) { uint4 gv = *(const uint4*)(gr + k), uv = *(const uint4*)(ur + k); float g8[8], u8[8]; unpack8(gv, g8); unpack8(uv, u8);
#pragma unroll
      for (int i = 0; i < 8; ++i) { a += xs[k + i] * g8[i]; u += xs[k + i] * u8[i]; } }
    a *= rs; u *= rs;
    hs[f] = bf2f(f2bf(a / (1.f + __expf(-a)) * u * w));
    __syncthreads();
    const bf16_t* wd = (const bf16_t*)(ws + OFF_WD) + (size_t)e * 1024 * 256;
    for (int d = tid; d < 1024; d += 256) { const bf16_t* r = wd + (size_t)d * 256; float acc = 0.f;
      for (int k = 0; k < 256; k += 8) { uint4 v = *(const uint4*)(r + k); float v8[8]; unpack8(v, v8);
#pragma unroll
        for (int i = 0; i < 8; ++i) acc += hs[k + i] * v8[i]; }
      ((bf16_t*)(ws + OFF_Y))[((size_t)t * 2 + s) * 1024 + d] = f2bf(acc); }
    __syncthreads();
  }
}
template <bool LAST>
__global__ void __launch_bounds__(256) k_finalize(float* x, unsigned char* ws, const float* gf) {
  const int row = blockIdx.x * 4 + (threadIdx.x >> 6), lane = threadIdx.x & 63;
  float4* xr = (float4*)(x + (size_t)row * DM);
  const bf16_t* y0 = (const bf16_t*)(ws + OFF_Y) + (size_t)row * 2048; const bf16_t* y1 = y0 + 1024;
  float4 v[4]; float ss = 0.f;
#pragma unroll
  for (int i = 0; i < 4; ++i) { const int c4 = lane + 64 * i; float4 a = xr[c4];
    uint2 p0 = *(const uint2*)(y0 + c4 * 4), p1 = *(const uint2*)(y1 + c4 * 4);
    a.x += __uint_as_float(p0.x << 16) + __uint_as_float(p1.x << 16); a.y += __uint_as_float(p0.x & 0xffff0000u) + __uint_as_float(p1.x & 0xffff0000u);
    a.z += __uint_as_float(p0.y << 16) + __uint_as_float(p1.y << 16); a.w += __uint_as_float(p0.y & 0xffff0000u) + __uint_as_float(p1.y & 0xffff0000u);
    v[i] = a; ss += a.x * a.x + a.y * a.y + a.z * a.z + a.w * a.w; }
  for (int o = 32; o; o >>= 1) ss += __shfl_xor(ss, o);
  const float rs = rsqrtf(ss * (1.f / DM) + EPS);
#pragma unroll
  for (int i = 0; i < 4; ++i) { const int c4 = lane + 64 * i; float4 a = v[i];
    if (LAST) { float4 g = ((const float4*)gf)[c4]; a.x *= rs * g.x; a.y *= rs * g.y; a.z *= rs * g.z; a.w *= rs * g.w; xr[c4] = a; }
    else { xr[c4] = a; bf16_t* o = (bf16_t*)(ws + OFF_XB) + (size_t)row * DM + c4 * 4; o[0] = f2bf(a.x); o[1] = f2bf(a.y); o[2] = f2bf(a.z); o[3] = f2bf(a.w); } }
  if (!LAST && lane == 0) ((float*)(ws + OFF_CTL + CTL_RSTD))[row] = rs;
}

static void launch_transpose(hipStream_t st, const float* src, const float* src2, const float* scale, bf16_t* dst, int ld, int K, int N, int kind) {
  TrDesc d{src, src2, scale, dst, ld, K, N, kind};
  int tiles = (N / 64) * (K / 64); int grid = tiles < 2048 ? tiles : 2048;
  hipLaunchKernelGGL(k_transpose, dim3(grid), dim3(256), 0, st, d);
}

extern "C" void kernel_launch(void* const* d_in, const int* in_sizes, int n_in, void* d_out, int out_size, void* d_ws, size_t ws_size, hipStream_t stream) {
  if (ws_size < WS_END) { fprintf(stderr, "kernel_launch: workspace too small: %zu < %zu\n", ws_size, WS_END); return; }
  const float* in[21]; for (int i = 0; i < 21; ++i) in[i] = (const float*)d_in[i];
  unsigned char* ws = (unsigned char*)d_ws; float* x = (float*)d_out;
  float* rstd = (float*)(ws + OFF_CTL + CTL_RSTD);
  EpiP ep{ws, x};
  hipLaunchKernelGGL(k_rope_tables, dim3((2048 * 56 + 255) / 256), dim3(256), 0, stream, (float*)(ws + OFF_CTL + CTL_ROPE));
  hipLaunchKernelGGL(k_x_init, dim3(T / 4), dim3(256), 0, stream, in[0], x, (bf16_t*)(ws + OFF_XB), rstd);
  for (int l = 0; l < 2; ++l) {
    const float* g_attn = in[1] + l * 1024; const float* w_in = in[2] + (size_t)l * 1024 * NIN;
    launch_transpose(stream, w_in, nullptr, g_attn, (bf16_t*)(ws + OFF_WATT + WA_IN), NIN, 1024, NZ, 1);
    hipLaunchKernelGGL(k_prep_wiw, dim3(32), dim3(256), 0, stream, w_in, g_attn, (float*)(ws + OFF_CTL + CTL_WIW));
    launch_transpose(stream, in[4] + (size_t)l * 256 * 768, nullptr, in[3] + l * 256, (bf16_t*)(ws + OFF_WATT + WA_UQ), 768, 256, 768, 2);
    launch_transpose(stream, in[6] + (size_t)l * 128 * 1024, nullptr, in[5] + l * 128, (bf16_t*)(ws + OFF_WATT + WA_UKV), 1024, 128, 1024, 0);
    for (int b = 0; b < 3; ++b)
      launch_transpose(stream, in[8 + b] + (size_t)l * 512 * 1024, nullptr, nullptr, (bf16_t*)(ws + OFF_WATT + WA_P) + (size_t)b * 1024 * 512, 1024, 512, 1024, 0);
    launch_transpose(stream, in[11] + (size_t)l * 1024 * 1024, nullptr, nullptr, (bf16_t*)(ws + OFF_WATT + WA_O), 1024, 1024, 1024, 0);
    hipLaunchKernelGGL(k_gemm_simple<EPI_IN>, dim3(NZ / 64, T / 64), dim3(256), 0, stream, (const bf16_t*)(ws + OFF_XB), 1024, (const bf16_t*)(ws + OFF_WATT + WA_IN), 1024, T, NZ, 1024, ep);
    hipLaunchKernelGGL(k_aiw, dim3(T / 4), dim3(256), 0, stream, (const bf16_t*)(ws + OFF_XB), rstd, (const float*)(ws + OFF_CTL + CTL_WIW), (float*)(ws + OFF_CTL + CTL_AIW));
    hipLaunchKernelGGL(k_rope_in, dim3(T), dim3(192), 0, stream, ws);
    hipLaunchKernelGGL(k_rowstat_bf16, dim3(T / 4), dim3(256), 0, stream, (const bf16_t*)(ws + OFF_BCQ), 256, (float*)(ws + OFF_CTL + CTL_RSTDQ));
    hipLaunchKernelGGL(k_rowstat_bf16, dim3(T / 4), dim3(256), 0, stream, (const bf16_t*)(ws + OFF_BCKV), 128, (float*)(ws + OFF_CTL + CTL_RSTDKV));
    hipLaunchKernelGGL(k_gemm_simple<EPI_UQ>, dim3(768 / 64, T / 64), dim3(256), 0, stream, (const bf16_t*)(ws + OFF_BCQ), 256, (const bf16_t*)(ws + OFF_WATT + WA_UQ), 256, T, 768, 256, ep);
    hipLaunchKernelGGL(k_rope_qb, dim3(T), dim3(128), 0, stream, ws);
    hipLaunchKernelGGL(k_gemm_simple<EPI_UKV>, dim3(1024 / 64, T / 64), dim3(256), 0, stream, (const bf16_t*)(ws + OFF_BCKV), 128, (const bf16_t*)(ws + OFF_WATT + WA_UKV), 128, T, 1024, 128, ep);
    hipLaunchKernelGGL(k_indexer_simple, dim3(T), dim3(256), 0, stream, ws);
    hipLaunchKernelGGL(k_attn_simple<0>, dim3(T), dim3(256), 0, stream, ws, (const float*)nullptr);
    hipLaunchKernelGGL(k_attn_simple<1>, dim3(T), dim3(256), 0, stream, ws, (const float*)nullptr);
    hipLaunchKernelGGL(k_attn_simple<2>, dim3(T), dim3(256), 0, stream, ws, in[7] + l * 4 * 257);
    const bf16_t* wp = (const bf16_t*)(ws + OFF_WATT + WA_P);
    hipLaunchKernelGGL(k_gemm_simple<EPI_PROJ0>, dim3(16, T / 64), dim3(256), 0, stream, (const bf16_t*)(ws + OFF_AQ), 512, wp, 512, T, 1024, 512, ep);
    hipLaunchKernelGGL(k_gemm_simple<EPI_PROJ1>, dim3(16, T / 64), dim3(256), 0, stream, (const bf16_t*)(ws + OFF_QB), 768, wp + (size_t)1024 * 512, 512, T, 1024, 512, ep);
    hipLaunchKernelGGL(k_gemm_simple<EPI_PROJ2>, dim3(16, T / 64), dim3(256), 0, stream, (const bf16_t*)(ws + OFF_CQ), 512, wp + (size_t)2 * 1024 * 512, 512, T, 1024, 512, ep);
    hipLaunchKernelGGL(k_gemm_simple<EPI_OUT>, dim3(16, T / 64), dim3(256), 0, stream, (const bf16_t*)(ws + OFF_MIX), 1024, (const bf16_t*)(ws + OFF_WATT + WA_O), 1024, T, 1024, 1024, ep);
    hipLaunchKernelGGL(k_router, dim3(T / 4), dim3(256), 0, stream, (const float*)x, in[12] + l * 1024, in[13] + (size_t)l * 1024 * 4, in[14] + l * 4, in[15] + (size_t)l * 1024 * 32, in[16] + l * 32,
                       (int*)(ws + OFF_CTL + CTL_TOKE), (float*)(ws + OFF_CTL + CTL_TOKW), rstd);
    { TrDesc d{in[17] + (size_t)l * 32 * 1024 * 256, in[18] + (size_t)l * 32 * 1024 * 256, in[12] + l * 1024, (bf16_t*)(ws + OFF_WGU), 256, 1024, 512, 3};
      hipLaunchKernelGGL(k_transpose_e, dim3(128, 32), dim3(256), 0, stream, d, (size_t)1024 * 256, (size_t)512 * 1024);
      TrDesc d2{in[19] + (size_t)l * 32 * 256 * 1024, nullptr, nullptr, (bf16_t*)(ws + OFF_WD), 1024, 256, 1024, 0};
      hipLaunchKernelGGL(k_transpose_e, dim3(64, 32), dim3(256), 0, stream, d2, (size_t)256 * 1024, (size_t)1024 * 256); }
    hipLaunchKernelGGL(k_moe_simple, dim3(T), dim3(256), 0, stream, ws);
    if (l == 0) hipLaunchKernelGGL(k_finalize<false>, dim3(T / 4), dim3(256), 0, stream, x, ws, (const float*)nullptr);
    else hipLaunchKernelGGL(k_finalize<true>, dim3(T / 4), dim3(256), 0, stream, x, ws, in[20]);
  }
}
```

```cpp
#include <hip/hip_runtime.h>
#include <hip/hip_bf16.h>
#include <cstdint>
#include <cstdio>

typedef unsigned short bf16_t;
typedef unsigned long long u64;

constexpr int T = 16384, DM = 1024, SEQ = 2048, NB = 8;
constexpr int NIN = 6408, NZ = 6400, NZP = 6656;
constexpr float EPS = 1e-6f;

constexpr size_t MiB = (size_t)1 << 20;
constexpr size_t OFF_CTL = 0;
constexpr size_t OFF_WATT = 4 * MiB;
constexpr size_t OFF_XB = 23 * MiB;
constexpr size_t OFF_AQ = 55 * MiB;
constexpr size_t OFF_CQ = 71 * MiB;
constexpr size_t OFF_QB = 87 * MiB;
constexpr size_t OFF_ZA = 111 * MiB;
constexpr size_t OFF_AK = OFF_ZA;
constexpr size_t OFF_AV = OFF_AK + 4 * MiB;
constexpr size_t OFF_AIQ = OFF_AV + 4 * MiB;
constexpr size_t OFF_AIK = OFF_AIQ + 16 * MiB;
constexpr size_t OFF_BKR = OFF_AIK + 2 * MiB;
constexpr size_t OFF_BCKV = OFF_BKR + 2 * MiB;
constexpr size_t OFF_BCQ = OFF_BCKV + 4 * MiB;
constexpr size_t OFF_BC = OFF_BCKV;
constexpr size_t OFF_CK = OFF_BCQ + 8 * MiB;
constexpr size_t OFF_CV = OFF_CK + 16 * MiB;
constexpr size_t OFF_KVB = 183 * MiB;
constexpr size_t OFF_MASK = 215 * MiB;
constexpr size_t OFF_G = 219 * MiB;
constexpr size_t WS_END = 315 * MiB;
constexpr size_t OFF_MIX = OFF_KVB;
constexpr size_t OFF_WMOE = OFF_ZA;
constexpr size_t OFF_WGU = OFF_WMOE;
constexpr size_t OFF_WD = OFF_WMOE + 32 * MiB;
constexpr size_t OFF_Y = OFF_G;
constexpr size_t OFF_LIST = OFF_MASK;
constexpr size_t OFF_H = OFF_AQ;
constexpr size_t CTL_BAR = 0;
constexpr size_t CTL_CNT = 16 * 1024;
constexpr size_t CTL_ROPE = 64 * 1024;
constexpr size_t CTL_RSTD = 1 * MiB;
constexpr size_t CTL_RSTDQ = CTL_RSTD + 64 * 1024;
constexpr size_t CTL_RSTDKV = CTL_RSTDQ + 64 * 1024;
constexpr size_t CTL_AIW = CTL_RSTDKV + 64 * 1024;
constexpr size_t CTL_SSQ = 2 * MiB;
constexpr size_t CTL_SSQQ = CTL_SSQ;
constexpr size_t CTL_SSQKV = CTL_SSQ + 512 * 1024;
constexpr size_t CTL_TOKE = 3 * MiB;
constexpr size_t CTL_TOKW = CTL_TOKE + 128 * 1024;
constexpr size_t CTL_WIW = 3 * MiB + 512 * 1024;
constexpr size_t WA_IN = 0;
constexpr size_t WA_UQ = 13 * MiB;
constexpr size_t WA_UKV = WA_UQ + 512 * 1024;
constexpr size_t WA_P = 14 * MiB;
constexpr size_t WA_O = 17 * MiB;
constexpr int RT_COSA = 0, RT_SINA = 2048 * 16, RT_COSI = 2048 * 32, RT_SINI = 2048 * 40, RT_COSB = 2048 * 48, RT_SINB = 2048 * 80;

template <class Tp> __device__ __forceinline__ Tp* as_global(Tp* p) { return (Tp*)(__attribute__((address_space(1))) Tp*)p; }
__device__ __forceinline__ float bf2f(bf16_t v) { return __uint_as_float(((unsigned)v) << 16); }
__device__ __forceinline__ bf16_t f2bf(float f) { unsigned u = __float_as_uint(f); return (bf16_t)((u + 0x7fffu + ((u >> 16) & 1u)) >> 16); }
__device__ __forceinline__ float shx(float v, int m, int lane) { return __int_as_float(__builtin_amdgcn_ds_bpermute((lane ^ m) << 2, __float_as_int(v))); }
__device__ __forceinline__ float wave_sum(float v, int lane) {
  v += shx(v, 32, lane); v += shx(v, 16, lane); v += shx(v, 8, lane); v += shx(v, 4, lane); v += shx(v, 2, lane); v += shx(v, 1, lane); return v;
}
__host__ __device__ __forceinline__ int zmap(int c) {
  if (c < 1344) return c;
  if (c < 1408) { int n = c - 1344, g = n >> 5, r = n & 31; return 1736 + (r < 16 ? 16 * g + r : 32 + 16 * g + (r - 16)); }
  if (c < 1536) return 1608 + (c - 1408);
  if (c < 1792) return 1352 + (c - 1536);
  return c + 8;
}
__host__ __device__ __forceinline__ int uqmap(int c) {
  if (c < 512) { int h = c >> 7, d = c & 127; return h * 192 + d; }
  int n = c - 512, h = n >> 6, m = n & 63, g = m >> 5, r = m & 31;
  return h * 192 + 128 + (r < 16 ? 16 * g + r : 32 + 16 * g + (r - 16));
}
__host__ __device__ __forceinline__ int gumap(int n, int& isup) { int pn = n >> 8, j = n & 255; isup = j >= 128; return 128 * pn + (j & 127); }

struct TrDesc { const float* src; const float* src2; const float* scale; bf16_t* dst; int ld; int K; int N; int kind; int dp = 0; };
struct TrRegs { float4 v[4]; float sc[4]; };
__device__ __forceinline__ void tt_load(const TrDesc& d, int tn, int tk, int tid, TrRegs& R) {
  const int n0 = tn * 64, k0 = tk * 64;
  const int n4 = (tid & 15) * 4, kq = tid >> 4;
  const int n = n0 + n4;
  const float* s = d.src; int col; float cs = 1.f;
  if (d.kind == 0) col = n; else if (d.kind == 1) { if (n >= NZ) { col = n < NZ + 8 ? 1344 + (n - NZ) : 0; cs = n < NZ + 8 ? 0.35355339059327373f * 0.125f : 0.f; } else col = zmap(n); } else if (d.kind == 2) col = uqmap(n);
  else { int isup; col = gumap(n, isup); if (isup) s = d.src2; }
  const bool vec = ((((size_t)d.ld * 4) & 15) == 0) && ((col & 3) == 0);
#pragma unroll
  for (int i = 0; i < 4; ++i) { const int kk = kq + 16 * i; const float* p = s + (size_t)(k0 + kk) * d.ld + col;
    if (vec) R.v[i] = *(const float4*)p; else { R.v[i].x = p[0]; R.v[i].y = p[1]; R.v[i].z = p[2]; R.v[i].w = p[3]; }
    R.sc[i] = (d.scale ? d.scale[k0 + kk] : 1.f) * cs; }
}
__device__ __forceinline__ void tt_lds(const TrRegs& R, float (*tile)[65], int tid) {
  const int n4 = (tid & 15) * 4, kq = tid >> 4;
#pragma unroll
  for (int i = 0; i < 4; ++i) { const int kk = kq + 16 * i; const float sc = R.sc[i];
    tile[kk][n4] = R.v[i].x * sc; tile[kk][n4 + 1] = R.v[i].y * sc; tile[kk][n4 + 2] = R.v[i].z * sc; tile[kk][n4 + 3] = R.v[i].w * sc; }
}
__device__ __forceinline__ void tt_store(const TrDesc& d, int tn, int tk, float (*tile)[65], int tid) {
  const int n0 = tn * 64, k0 = tk * 64;
  const int dp = d.dp ? d.dp : d.K;
#pragma unroll
  for (int i = 0; i < 2; ++i) { const int e = tid + 256 * i, nn = e >> 3, k8 = (e & 7) * 8;
    uint4 w;
    w.x = (unsigned)f2bf(tile[k8 + 0][nn]) | ((unsigned)f2bf(tile[k8 + 1][nn]) << 16); w.y = (unsigned)f2bf(tile[k8 + 2][nn]) | ((unsigned)f2bf(tile[k8 + 3][nn]) << 16);
    w.z = (unsigned)f2bf(tile[k8 + 4][nn]) | ((unsigned)f2bf(tile[k8 + 5][nn]) << 16); w.w = (unsigned)f2bf(tile[k8 + 6][nn]) | ((unsigned)f2bf(tile[k8 + 7][nn]) << 16);
    *(uint4*)(d.dst + (size_t)(n0 + nn) * dp + k0 + k8) = w; }
}
__device__ __forceinline__ void b_transpose2(TrDesc d, size_t src_stride, size_t dst_stride, int vb, int tid, char* sm) {
  float (*tileA)[65] = (float (*)[65])sm; float (*tileB)[65] = (float (*)[65])(sm + 64 * 65 * 4);
  const int ntk = d.K / 64, per = (d.N / 64) * ntk;
  TrDesc da = d, db = d;
  { const int e = vb / per; da.src += (size_t)e * src_stride; if (da.src2) da.src2 += (size_t)e * src_stride; da.dst += (size_t)e * dst_stride; }
  { const int e = (vb + 1) / per; db.src += (size_t)e * src_stride; if (db.src2) db.src2 += (size_t)e * src_stride; db.dst += (size_t)e * dst_stride; }
  const int ta = vb % per, tb = (vb + 1) % per;
  TrRegs ra, rb; tt_load(da, ta / ntk, ta % ntk, tid, ra); tt_load(db, tb / ntk, tb % ntk, tid, rb);
  tt_lds(ra, tileA, tid); tt_lds(rb, tileB, tid);
  __syncthreads();
  tt_store(da, ta / ntk, ta % ntk, tileA, tid); tt_store(db, tb / ntk, tb % ntk, tileB, tid);
  __syncthreads();
}
__device__ __forceinline__ void b_rope_tables(float* rt, int i) {
  int pos = i / 56, j = i % 56; int rot, idx, oc, os;
  if (j < 16) { rot = 32; idx = j; oc = RT_COSA + pos * 16 + idx; os = RT_SINA + pos * 16 + idx; }
  else if (j < 24) { rot = 16; idx = j - 16; oc = RT_COSI + pos * 8 + idx; os = RT_SINI + pos * 8 + idx; }
  else { rot = 64; idx = j - 24; oc = RT_COSB + pos * 32 + idx; os = RT_SINB + pos * 32 + idx; }
  float inv = (float)pow(500000.0, -(double)(2 * idx) / (double)rot);
  float ang = (float)pos * inv;
  rt[oc] = (float)cos((double)ang); rt[os] = (float)sin((double)ang);
}
__device__ __forceinline__ void b_x_init(const float* xin, float* x, bf16_t* xb, float* rstd, int row, int lane) {
  const float4* s = (const float4*)(xin + (size_t)row * DM);
  float ss = 0.f;
#pragma unroll
  for (int i = 0; i < 4; ++i) { float4 v = s[lane + 64 * i]; ss += v.x * v.x + v.y * v.y + v.z * v.z + v.w * v.w;
    *(uint2*)(xb + (size_t)row * DM + (lane + 64 * i) * 4) = make_uint2((unsigned)f2bf(v.x) | ((unsigned)f2bf(v.y) << 16), (unsigned)f2bf(v.z) | ((unsigned)f2bf(v.w) << 16)); }
  ss = wave_sum(ss, lane);
  if (lane == 0) rstd[row] = rsqrtf(ss * (1.f / DM) + EPS);
}

constexpr int RT_P = 1028;
constexpr int ROUTER_LDS = 36 * RT_P * 4;
__device__ __forceinline__ void router_stage(const float* g, const float* wg, const float* wr, float* wt, int tid) {
  for (int i = tid; i < 1024 * 32; i += 512) { const int k = i >> 5, j = i & 31; wt[(4 + j) * RT_P + k] = g[k] * wr[i]; }
  for (int i = tid; i < 1024 * 4; i += 512) { const int k = i >> 2, j = i & 3; wt[j * RT_P + k] = g[k] * wg[i]; }
}
__device__ __forceinline__ void router_select(const float (&acc)[36], const float rs, const float* bg, const float* br, int t, int* toke, float* tokw, float* rstd_out, unsigned* cnt, int* list, bool dry) {
  float lg[4]; float mx = -INFINITY;
#pragma unroll
  for (int j = 0; j < 4; ++j) { lg[j] = acc[j] * rs + bg[j]; mx = fmaxf(mx, lg[j]); }
  float sm = 0.f, best = -1.f; int gs = 0;
#pragma unroll
  for (int j = 0; j < 4; ++j) { const float p = __expf(lg[j] - mx); sm += p; if (p > best) { best = p; gs = j; } }
  const float pg = best / sm;
  const float m0 = gs == 0 ? 1.f : 0.f, m1 = gs == 1 ? 1.f : 0.f, m2 = gs == 2 ? 1.f : 0.f, m3 = gs == 3 ? 1.f : 0.f;
  float e[8]; float emx = -INFINITY;
#pragma unroll
  for (int j = 0; j < 8; ++j) { e[j] = ((acc[4 + j] * m0 + acc[12 + j] * m1) + (acc[20 + j] * m2 + acc[28 + j] * m3)) * rs + br[gs * 8 + j]; emx = fmaxf(emx, e[j]); }
  float es = 0.f, b0 = -1.f, b1 = -1.f; int i0 = 0, i1 = 0;
#pragma unroll
  for (int j = 0; j < 8; ++j) { const float p = __expf(e[j] - emx); es += p;
    if (p > b0) { b1 = b0; i1 = i0; b0 = p; i0 = j; } else if (p > b1) { b1 = p; i1 = j; } }
  const float p0 = b0 / es, p1 = b1 / es, ps = p0 + p1;
  const int e0 = gs * 8 + i0, e1 = gs * 8 + i1;
  if (dry) { asm volatile("" :: "v"(p0 + ps), "v"(e0 + e1)); return; }
  rstd_out[t] = rs;
  toke[t * 2] = e0; toke[t * 2 + 1] = e1; tokw[t * 2] = pg * p0 / ps; tokw[t * 2 + 1] = pg * p1 / ps;
  const unsigned s0 = atomicAdd(cnt + e0, 1u), s1 = atomicAdd(cnt + e1, 1u);
  list[(size_t)e0 * T + s0] = t * 2; list[(size_t)e1 * T + s1] = t * 2 + 1;
}
__device__ __forceinline__ void router_mfma(const float* x, const float* wt, char* scr  , const float* bg, const float* br, int* toke, float* tokw, float* rstd_out,
                                            unsigned* cnt, int* list, const int t0  , const int wave, const int lane, const bool dry) {
  typedef float f4 __attribute__((ext_vector_type(4)));
  const int i = lane & 15, g = lane >> 4, wp = wave & 3, kh = wave >> 2;
  const float* xr = x + (size_t)(t0 + i) * DM + kh * 512 + 4 * g;
  const float* w0 = wt + (size_t)i * RT_P + kh * 512 + 4 * g; const float* w1 = w0 + 16 * RT_P; const float* w2 = wt + (size_t)(32 + (i < 4 ? i : 3)) * RT_P + kh * 512 + 4 * g;
  f4 c0 = {0.f, 0.f, 0.f, 0.f}, c1 = c0, c2 = c0; float ssl = 0.f;
#pragma unroll 4
  for (int s = 0; s < 32; ++s) {
    const f4 xa = *(const f4*)(xr + 16 * s), b0 = *(const f4*)(w0 + 16 * s), b1 = *(const f4*)(w1 + 16 * s), b2 = *(const f4*)(w2 + 16 * s);
    ssl += (xa[0] * xa[0] + xa[1] * xa[1]) + (xa[2] * xa[2] + xa[3] * xa[3]);
#pragma unroll
    for (int e = 0; e < 4; ++e) { c0 = __builtin_amdgcn_mfma_f32_16x16x4f32(xa[e], b0[e], c0, 0, 0, 0); c1 = __builtin_amdgcn_mfma_f32_16x16x4f32(xa[e], b1[e], c1, 0, 0, 0); c2 = __builtin_amdgcn_mfma_f32_16x16x4f32(xa[e], b2[e], c2, 0, 0, 0); }
  }
  float* part = (float*)scr + (size_t)(wp * 64 + lane) * 12; float* pss = (float*)(scr + 4 * 3072) + wp * 64 + lane;
  if (kh == 1) { *(f4*)part = c0; *(f4*)(part + 4) = c1; *(f4*)(part + 8) = c2; *pss = ssl; }
  __syncthreads();
  if (kh == 0) {
    c0 += *(const f4*)part; c1 += *(const f4*)(part + 4); c2 += *(const f4*)(part + 8); ssl += *pss;
    asm volatile("s_waitcnt lgkmcnt(0)" ::: "memory");
    ssl += shx(ssl, 16, lane); ssl += shx(ssl, 32, lane);
    float* lg = (float*)(scr + wp * 3072);
#pragma unroll
    for (int r = 0; r < 4; ++r) { lg[(4 * g + r) * 48 + i] = c0[r]; lg[(4 * g + r) * 48 + 16 + i] = c1[r]; lg[(4 * g + r) * 48 + 32 + i] = c2[r]; }
    asm volatile("s_waitcnt lgkmcnt(0)" ::: "memory");
    if (lane < 16) { float acc[36];
#pragma unroll
      for (int j = 0; j < 36; ++j) acc[j] = lg[lane * 48 + j];
      router_select(acc, rsqrtf(ssl * (1.f / DM) + EPS), bg, br, t0 + lane, toke, tokw, rstd_out, cnt, list, dry); }
  }
  __syncthreads();
}
template <bool LAST>
__device__ __forceinline__ void b_finalize(float* x, unsigned char* ws, const float* gf, int row, int lane) {
  float4* xr = (float4*)(x + (size_t)row * DM);
  const bf16_t* y0 = (const bf16_t*)(ws + OFF_Y) + (size_t)row * 2048; const bf16_t* y1 = y0 + 1024;
  float4 v[4]; float ss = 0.f;
#pragma unroll
  for (int i = 0; i < 4; ++i) { const int c4 = lane + 64 * i; float4 a = xr[c4];
    uint2 p0 = *(const uint2*)(y0 + c4 * 4), p1 = *(const uint2*)(y1 + c4 * 4);
    a.x += __uint_as_float(p0.x << 16) + __uint_as_float(p1.x << 16); a.y += __uint_as_float(p0.x & 0xffff0000u) + __uint_as_float(p1.x & 0xffff0000u);
    a.z += __uint_as_float(p0.y << 16) + __uint_as_float(p1.y << 16); a.w += __uint_as_float(p0.y & 0xffff0000u) + __uint_as_float(p1.y & 0xffff0000u);
    v[i] = a; ss += a.x * a.x + a.y * a.y + a.z * a.z + a.w * a.w; }
  ss = wave_sum(ss, lane);
  const float rs = rsqrtf(ss * (1.f / DM) + EPS);
#pragma unroll
  for (int i = 0; i < 4; ++i) { const int c4 = lane + 64 * i; float4 a = v[i];
    if (LAST) { float4 g = ((const float4*)gf)[c4]; a.x *= rs * g.x; a.y *= rs * g.y; a.z *= rs * g.z; a.w *= rs * g.w; xr[c4] = a; }
    else { xr[c4] = a; *(uint2*)((bf16_t*)(ws + OFF_XB) + (size_t)row * DM + c4 * 4) = make_uint2((unsigned)f2bf(a.x) | ((unsigned)f2bf(a.y) << 16), (unsigned)f2bf(a.z) | ((unsigned)f2bf(a.w) << 16)); } }
  if (!LAST && lane == 0) ((float*)(ws + OFF_CTL + CTL_RSTD))[row] = rs;
}


namespace pg8 {
#define PG8_LAS __attribute__((address_space(3)))
typedef short bf16x8 __attribute__((ext_vector_type(8)));
typedef float f32x4 __attribute__((ext_vector_type(4)));
typedef unsigned u32x4 __attribute__((ext_vector_type(4)));
constexpr int BM = 256, BK = 64, HALF = 128, HTB = HALF * BK * 2, STAGE_BYTES = 8 * HTB, NXCD = 8, WGM = 8;
__host__ __device__ __forceinline__ int lds_byte(int r, int c) { const int st = (r >> 4) * 2 + (c >> 5), rr = r & 15, cc = c & 31, ob = rr * 64 + cc * 2; return st * 1024 + (ob ^ (((ob >> 9) & 1) << 5)); }
__host__ __device__ __forceinline__ void stage_rc(int b, int& R, int& C) { const int st = b / 1024, sb = b % 1024, swz = sb ^ (((sb >> 9) & 1) << 5); R = (st >> 1) * 16 + swz / 64; C = (st & 1) * 32 + (swz % 64) / 2; }
__host__ __device__ __forceinline__ int perm32(int rho) { const int n = rho >> 4, i = rho & 15; return 8 * (i >> 2) + 4 * n + (i & 3); }
__device__ __forceinline__ unsigned cvt_pk_bf16(float lo, float hi) { unsigned r; asm volatile("v_cvt_pk_bf16_f32 %0, %1, %2" : "=v"(r) : "v"(lo), "v"(hi)); return r; }

struct Unit { int pm, pn; const char* A; const char* B; const int* rows; int aux; int nt; };

__device__ __forceinline__ bool static_tile(int i, int G, int c, int nM, int nN, int& pm, int& pn) {
  const int nwg = nM * nN; const long L = (long)i * G + c; if (L >= nwg) return false;
  int wgid = (int)L; { const int q = nwg / NXCD, r = nwg % NXCD, xcd = wgid % NXCD, off = wgid / NXCD; wgid = (xcd < r ? xcd * (q + 1) : r * (q + 1) + (xcd - r) * q) + off; }
  const int nig = WGM * nN, gid = wgid / nig, fm = gid * WGM, gsz = (nM - fm) < WGM ? (nM - fm) : WGM;
  pm = fm + ((wgid % nig) % gsz); pn = (wgid % nig) / gsz; return true;
}
struct PlainOrder {
  const char* A; const char* Bt; int lda, ldb, nM, nN, G, c, nt;
  __device__ __forceinline__ bool next(int i, Unit& u) const {
    if (!static_tile(i, G, c, nM, nN, u.pm, u.pn)) return false;
    u.A = A + (size_t)u.pm * BM * lda * 2; u.B = Bt + (size_t)u.pn * BM * ldb * 2; u.rows = nullptr; u.aux = 0; u.nt = nt; return true; }
};

template <class Epi, class Sched, bool ALIGN_EPI, bool GATHER, int lda, int ldb, int K>
__device__ __forceinline__ void gemm_phase(const int tid, PG8_LAS unsigned char* lds, const Sched& S, const Epi& E, PG8_LAS unsigned char* xlds = nullptr) {
    const int wid = __builtin_amdgcn_readfirstlane(tid >> 6), lane = tid & 63, wr = wid >> 2, wc = wid & 3, fr = lane & 15, fq = lane >> 4;
    unsigned voffA[2][2], voffB[2];
#pragma unroll
    for (int i = 0; i < 2; ++i) { int R, C; stage_rc(tid * 16 + i * 8192, R, C); const int Rb = (R & ~31) + perm32(R & 31);
        voffB[i] = (unsigned)(Rb * ldb + C) * 2u;
#pragma unroll
        for (int h = 0; h < 2; ++h) { voffA[h][i] = (unsigned)((R + (GATHER ? h * HALF : 0)) * lda + C) * 2u; } }
    const size_t hstepA = GATHER ? (size_t)0 : (size_t)HALF * lda * 2;
    const size_t kstep = (size_t)(BK * 2);
    const size_t hstepB = (size_t)HALF * ldb * 2;
    const unsigned ldsw = (unsigned)wid * 1024u;
    const int aoff = lds_byte(wr * 64 + fr, fq * 8), boff = lds_byte(wc * 32 + fr, fq * 8);
#define PG8_SA(b, h) (((b) * 2 + (h)) * HTB)
#define PG8_SB(b, h) ((4 + (b) * 2 + (h)) * HTB)
#define PG8_STAGE(bufoff, gbase, voff) do { _Pragma("unroll") for (int _i = 0; _i < 2; ++_i) \
        __builtin_amdgcn_global_load_lds((const unsigned*)((const char*)(gbase) + (voff)[_i]), (PG8_LAS unsigned*)(lds + (bufoff) + ldsw + _i * 8192), 16, 0, 0); } while (0)
#define PG8_LDA(dst, b, h) do { _Pragma("unroll") for (int m = 0; m < 4; ++m) _Pragma("unroll") for (int k = 0; k < 2; ++k) dst[m][k] = *(const PG8_LAS bf16x8*)(lds + PG8_SA(b, h) + aoff + m * 2048 + k * 1024); } while (0)
#define PG8_LDB(dst, b, h) do { _Pragma("unroll") for (int n = 0; n < 2; ++n) _Pragma("unroll") for (int k = 0; k < 2; ++k) dst[n][k] = *(const PG8_LAS bf16x8*)(lds + PG8_SB(b, h) + boff + n * 2048 + k * 1024); } while (0)
#define PG8_MMA(ai, bj, At, Bt) do { __builtin_amdgcn_s_setprio(1); _Pragma("unroll") for (int m = 0; m < 4; ++m) _Pragma("unroll") for (int n = 0; n < 2; ++n) _Pragma("unroll") for (int k = 0; k < 2; ++k) \
        acc[ai][bj][m][n] = __builtin_amdgcn_mfma_f32_16x16x32_bf16(Bt[n][k], At[m][k], acc[ai][bj][m][n], 0, 0, 0); __builtin_amdgcn_s_setprio(0); } while (0)
#define PG8_WAIT_V(n) asm volatile("s_waitcnt vmcnt(" #n ")" ::: "memory")
#define PG8_WAIT_L(n) asm volatile("s_waitcnt lgkmcnt(" #n ")" ::: "memory")
#define PG8_BAR __builtin_amdgcn_s_barrier()
#define PG8_SCHED __builtin_amdgcn_sched_barrier(0)
#define PG8_GATHER_OFFS(dst, u) do { if (GATHER) { _Pragma("unroll") for (int _i = 0; _i < 2; ++_i) { int _R, _C; stage_rc(tid * 16 + _i * 8192, _R, _C); \
        _Pragma("unroll") for (int _h = 0; _h < 2; ++_h) { const int _r = _h * HALF + _R; const int _e = _r < (u).aux ? ((u).rows[_r] >> 1) : 0; dst[_h][_i] = (unsigned)(_e * lda + _C) * 2u; } } } } while (0)
    Unit cur, nxt; int ui = 0;
    if (!S.next(0, cur)) return;
    PG8_GATHER_OFFS(voffA, cur);
    f32x4 acc[2][2][4][2];
#pragma unroll
    for (int a = 0; a < 2; ++a)
#pragma unroll
        for (int b = 0; b < 2; ++b)
#pragma unroll
            for (int m = 0; m < 4; ++m)
#pragma unroll
                for (int n = 0; n < 2; ++n) acc[a][b][m][n] = (f32x4){0.f, 0.f, 0.f, 0.f};
    bf16x8 At[4][2], B0[2][2], B1[2][2];
    const char* cA = cur.A; const char* cB = cur.B;
    PG8_STAGE(PG8_SB(0, 0), cB, voffB); PG8_STAGE(PG8_SB(0, 1), cB + hstepB, voffB); PG8_STAGE(PG8_SA(0, 0), cA, voffA[0]); PG8_STAGE(PG8_SA(0, 1), cA + hstepA, voffA[1]);
    if (wr == 1) PG8_BAR;
    PG8_WAIT_V(2); PG8_BAR;
    PG8_STAGE(PG8_SB(1, 0), cB + kstep, voffB); PG8_STAGE(PG8_SA(1, 0), cA + kstep, voffA[0]); PG8_STAGE(PG8_SB(1, 1), cB + hstepB + kstep, voffB);
    PG8_WAIT_V(6); PG8_BAR;
    for (;;) {
        const bool has_next = S.next(ui + 1, nxt);
        const char* nA = has_next ? nxt.A : cA; const char* nB = has_next ? nxt.B : cB;
        if (GATHER) { unsigned nv[2][2];
#pragma unroll
            for (int h = 0; h < 2; ++h)
#pragma unroll
                for (int i = 0; i < 2; ++i) nv[h][i] = voffA[h][i];
            if (has_next) PG8_GATHER_OFFS(nv, nxt);
            *(PG8_LAS u32x4*)(xlds + tid * 16) = (u32x4){nv[0][0], nv[0][1], nv[1][0], nv[1][1]}; }
        const int nt = cur.nt;
#pragma unroll 1
        for (int t = 0; t < nt; t += 2) {
            const bool last = (t == nt - 2);
            const char* a1 = cA + (size_t)(t + 1) * kstep;
            const char* a2 = last ? nA : cA + (size_t)(t + 2) * kstep; const char* b2 = last ? nB : cB + (size_t)(t + 2) * kstep;
            const char* a3 = a2 + kstep; const char* b3 = b2 + kstep;

            PG8_LDB(B0, 0, 0); PG8_LDB(B1, 0, 1); PG8_SCHED; PG8_LDA(At, 0, 0); PG8_STAGE(PG8_SA(1, 1), a1 + hstepA, voffA[1]);
            if (GATHER && last) { const u32x4 q = *(const PG8_LAS u32x4*)(xlds + tid * 16); voffA[0][0] = q.x; voffA[0][1] = q.y; voffA[1][0] = q.z; voffA[1][1] = q.w; }
            PG8_WAIT_V(8); PG8_WAIT_L(0); PG8_BAR; PG8_MMA(0, 0, At, B0); PG8_MMA(0, 1, At, B1); PG8_BAR; PG8_SCHED;
            PG8_LDA(At, 0, 1); PG8_STAGE(PG8_SB(0, 0), b2, voffB); PG8_STAGE(PG8_SB(0, 1), b2 + hstepB, voffB); PG8_STAGE(PG8_SA(0, 0), a2, voffA[0]);
            PG8_WAIT_V(8); PG8_WAIT_L(0); PG8_BAR; PG8_MMA(1, 0, At, B0); PG8_MMA(1, 1, At, B1); PG8_BAR; PG8_SCHED;
            PG8_LDB(B0, 1, 0); PG8_LDB(B1, 1, 1); PG8_SCHED; PG8_LDA(At, 1, 0); PG8_STAGE(PG8_SA(0, 1), a2 + hstepA, voffA[1]);
            PG8_WAIT_V(8); PG8_WAIT_L(0); PG8_BAR; PG8_MMA(0, 0, At, B0); PG8_MMA(0, 1, At, B1); PG8_BAR; PG8_SCHED;
            PG8_LDA(At, 1, 1); PG8_STAGE(PG8_SB(1, 0), b3, voffB); PG8_STAGE(PG8_SB(1, 1), b3 + hstepB, voffB); PG8_STAGE(PG8_SA(1, 0), a3, voffA[0]);
            PG8_WAIT_V(8); PG8_WAIT_L(0); PG8_BAR; PG8_MMA(1, 0, At, B0); PG8_MMA(1, 1, At, B1); PG8_BAR; PG8_SCHED;
        }
        if constexpr (ALIGN_EPI) { if (wr == 0) PG8_BAR; }
        { int fr_e = fr, fq_e = fq; asm volatile("" : "+v"(fr_e), "+v"(fq_e)); E(acc, cur, wr, wc, fr_e, fq_e); }
        if (!has_next) break;
#pragma unroll
        for (int a = 0; a < 2; ++a)
#pragma unroll
            for (int b = 0; b < 2; ++b)
#pragma unroll
                for (int m = 0; m < 4; ++m)
#pragma unroll
                    for (int n = 0; n < 2; ++n) acc[a][b][m][n] = (f32x4){0.f, 0.f, 0.f, 0.f};
        cur = nxt; cA = nA; cB = nB; ++ui;

        if constexpr (ALIGN_EPI) { if (wr == 1) PG8_BAR; }
    }
    PG8_WAIT_V(0);
    if constexpr (!ALIGN_EPI) { if (wr == 0) PG8_BAR; }
    PG8_BAR;
#undef PG8_SA
#undef PG8_SB
#undef PG8_STAGE
#undef PG8_LDA
#undef PG8_LDB
#undef PG8_MMA
#undef PG8_WAIT_V
#undef PG8_WAIT_L
#undef PG8_BAR
#undef PG8_SCHED
#undef PG8_GATHER_OFFS
}

__device__ __forceinline__ u32x4 pack8(const f32x4 v0, const f32x4 v1) { u32x4 w; w.x = cvt_pk_bf16(v0[0], v0[1]); w.y = cvt_pk_bf16(v0[2], v0[3]); w.z = cvt_pk_bf16(v1[0], v1[1]); w.w = cvt_pk_bf16(v1[2], v1[3]); return w; }
__device__ __forceinline__ void unpack8v(const u32x4 w, f32x4& v0, f32x4& v1) {
  v0[0] = __uint_as_float(w.x << 16); v0[1] = __uint_as_float(w.x & 0xffff0000u); v0[2] = __uint_as_float(w.y << 16); v0[3] = __uint_as_float(w.y & 0xffff0000u);
  v1[0] = __uint_as_float(w.z << 16); v1[1] = __uint_as_float(w.z & 0xffff0000u); v1[2] = __uint_as_float(w.w << 16); v1[3] = __uint_as_float(w.w & 0xffff0000u); }

__device__ __forceinline__ void rope8(f32x4& v0, f32x4& v1, const float* ct, const float* st, int xorm, bool first, bool active, int lane) {
  f32x4 p0, p1;
#pragma unroll
  for (int j = 0; j < 4; ++j) { p0[j] = __int_as_float(__builtin_amdgcn_ds_bpermute((lane ^ xorm) << 2, __float_as_int(v0[j]))); p1[j] = __int_as_float(__builtin_amdgcn_ds_bpermute((lane ^ xorm) << 2, __float_as_int(v1[j]))); }
  const f32x4 c0 = *(const f32x4*)ct, c1 = *(const f32x4*)(ct + 4), s0 = *(const f32x4*)st, s1 = *(const f32x4*)(st + 4);
  const float sg = first ? -1.f : 1.f;
  const f32x4 n0 = v0 * c0 + (p0 * s0) * sg, n1 = v1 * c1 + (p1 * s1) * sg;
  if (active) { v0 = n0; v1 = n1; }
}
enum { K_PLAIN = 0, K_SIG, K_ROPE_A, K_ROPE_I, K_ROPE_B, K_SSQ };
struct EpiIn {
  unsigned char* ws;
  __device__ __forceinline__ void operator()(const f32x4 (&acc)[2][2][4][2], const Unit& u, int wr, int wc, int fr, int fq) const {
    const float* rstd = (const float*)(ws + OFF_CTL + CTL_RSTD); const float* rt = (const float*)(ws + OFF_CTL + CTL_ROPE);
    const int pn = u.pn, lane = fr + 16 * fq;
    float rsv[8];
#pragma unroll
    for (int k = 0; k < 8; ++k) rsv[k] = rstd[u.pm * BM + (k >> 2) * HALF + wr * 64 + (k & 3) * 16 + fr];
    if (pn == 25) {
      if (wc == 0 && fq == 0) {
#pragma unroll
        for (int ai = 0; ai < 2; ++ai)
#pragma unroll
          for (int m = 0; m < 4; ++m) { const int row = u.pm * BM + ai * HALF + wr * 64 + m * 16 + fr; const float rs = rsv[ai * 4 + m];
            float* o = (float*)(ws + OFF_CTL + CTL_AIW) + (size_t)row * 8; *(f32x4*)o = acc[ai][0][m][0] * rs; *(f32x4*)(o + 4) = acc[ai][0][m][1] * rs; } }
      return; }
#pragma unroll
    for (int bj = 0; bj < 2; ++bj) {
      bf16_t* base; int pitch, lc, kind = K_PLAIN, rg = 0; float* ssq = nullptr;
      const int gc = bj * 128 + wc * 32;
      if (pn < 2) { base = (bf16_t*)(ws + OFF_AQ); pitch = 512; lc = pn * 256 + gc; if (wc == 0) kind = K_ROPE_A; }
      else if (pn == 2) { base = (bf16_t*)(ws + (bj == 0 ? OFF_AK : OFF_AV)); pitch = 128; lc = wc * 32; if (bj == 0 && wc == 0) kind = K_ROPE_A; }
      else if (pn < 5) { base = (bf16_t*)(ws + OFF_AIQ); pitch = 512; lc = (pn - 3) * 256 + gc; if ((wc & 1) == 0) kind = K_ROPE_I; }
      else if (pn == 5) { if (bj == 0) { if (wc < 2) { base = (bf16_t*)(ws + OFF_AIK); pitch = 64; lc = wc * 32; if (wc == 0) kind = K_ROPE_I; }
                                         else { base = (bf16_t*)(ws + OFF_BKR); pitch = 64; lc = (wc - 2) * 32; kind = K_ROPE_B; rg = wc - 2; } }
                          else { base = (bf16_t*)(ws + OFF_BC); pitch = 384; lc = 256 + wc * 32; kind = K_SSQ; ssq = (float*)(ws + OFF_CTL + CTL_SSQKV); } }
      else if (pn == 6) { base = (bf16_t*)(ws + OFF_BC); pitch = 384; lc = gc; kind = K_SSQ; ssq = (float*)(ws + OFF_CTL + CTL_SSQQ) + bj * 4 * T; }
      else if (pn < 9) { base = (bf16_t*)(ws + OFF_CQ); pitch = 512; lc = (pn - 7) * 256 + gc; }
      else if (pn < 11) { base = (bf16_t*)(ws + OFF_CK); pitch = 512; lc = (pn - 9) * 256 + gc; }
      else if (pn < 13) { base = (bf16_t*)(ws + OFF_CV); pitch = 512; lc = (pn - 11) * 256 + gc; }
      else { base = (bf16_t*)(ws + OFF_G); pitch = 3072; lc = (pn - 13) * 256 + gc; kind = K_SIG; }
#pragma unroll
      for (int ai = 0; ai < 2; ++ai)
#pragma unroll
        for (int m = 0; m < 4; ++m) {
          const int row = u.pm * BM + ai * HALF + wr * 64 + m * 16 + fr; const float rs = rsv[ai * 4 + m]; const int pos = row & (SEQ - 1);
          f32x4 v0 = acc[ai][bj][m][0] * rs, v1 = acc[ai][bj][m][1] * rs;
          if (kind == K_SIG) {
#pragma unroll
            for (int j = 0; j < 4; ++j) { v0[j] = __builtin_amdgcn_rcpf(1.f + __expf(-v0[j])); v1[j] = __builtin_amdgcn_rcpf(1.f + __expf(-v1[j])); } }
          else if (kind == K_ROPE_A) rope8(v0, v1, rt + RT_COSA + pos * 16 + 8 * (fq & 1), rt + RT_SINA + pos * 16 + 8 * (fq & 1), 32, fq < 2, true, lane);
          else if (kind == K_ROPE_I) rope8(v0, v1, rt + RT_COSI + pos * 8, rt + RT_SINI + pos * 8, 16, fq == 0, fq < 2, lane);
          else if (kind == K_ROPE_B) rope8(v0, v1, rt + RT_COSB + pos * 32 + 16 * rg + 8 * (fq & 1), rt + RT_SINB + pos * 32 + 16 * rg + 8 * (fq & 1), 32, fq < 2, true, lane);
          else if (kind == K_SSQ) { float q = 0.f;
#pragma unroll
            for (int j = 0; j < 4; ++j) q += v0[j] * v0[j] + v1[j] * v1[j];
            q += __int_as_float(__builtin_amdgcn_ds_bpermute((lane ^ 16) << 2, __float_as_int(q))); q += __int_as_float(__builtin_amdgcn_ds_bpermute((lane ^ 32) << 2, __float_as_int(q)));
            if (fq == 0) ssq[(size_t)row * 4 + wc] = q; }
          *(u32x4*)(base + (size_t)row * pitch + lc + 8 * fq) = pack8(v0, v1);
        }
    }
  }
};
template <int NP, int W, bool ROPE>
struct EpiUp {
  unsigned char* ws; bf16_t* O; int pitch; const float* ssq;
  __device__ __forceinline__ void operator()(const f32x4 (&acc)[2][2][4][2], const Unit& u, int wr, int wc, int fr, int fq) const {
    const float* rt = (const float*)(ws + OFF_CTL + CTL_ROPE); const int lane = fr + 16 * fq;
#pragma unroll
    for (int ai = 0; ai < 2; ++ai) {
      float rsv[4];
#pragma unroll
      for (int k = 0; k < 4; ++k) { const int row = u.pm * BM + ai * HALF + wr * 64 + k * 16 + fr; float q = 0.f;
#pragma unroll
        for (int p = 0; p < NP; ++p) { const f32x4 s4 = *(const f32x4*)(ssq + (size_t)p * 4 * T + (size_t)row * 4); q += (s4[0] + s4[1]) + (s4[2] + s4[3]); }
        rsv[k] = rsqrtf(q * (1.f / W) + EPS); }
#pragma unroll
      for (int m = 0; m < 4; ++m) { const int row = u.pm * BM + ai * HALF + wr * 64 + m * 16 + fr; const int pos = row & (SEQ - 1);
        const float rs = rsv[m];
#pragma unroll
        for (int bj = 0; bj < 2; ++bj) { f32x4 v0 = acc[ai][bj][m][0] * rs, v1 = acc[ai][bj][m][1] * rs;
          if (ROPE && u.pn == 2) { const int rg = wc & 1; rope8(v0, v1, rt + RT_COSB + pos * 32 + 16 * rg + 8 * (fq & 1), rt + RT_SINB + pos * 32 + 16 * rg + 8 * (fq & 1), 32, fq < 2, true, lane); }
          *(u32x4*)(O + (size_t)row * pitch + u.pn * BM + bj * HALF + wc * 32 + 8 * fq) = pack8(v0, v1); } } }
  }
};
struct EpiProj {
  unsigned char* ws;
  __device__ __forceinline__ void operator()(const f32x4 (&acc)[2][2][4][2], const Unit& u, int wr, int wc, int fr, int fq) const {
    const int b = u.aux;
#pragma unroll
    for (int ai = 0; ai < 2; ++ai)
#pragma unroll
    for (int mh = 0; mh < 2; ++mh) {
      u32x4 gw[2][2], mw[2][2];
#pragma unroll
      for (int m2 = 0; m2 < 2; ++m2) { const int m = mh * 2 + m2, row = u.pm * BM + ai * HALF + wr * 64 + m * 16 + fr;
#pragma unroll
        for (int bj = 0; bj < 2; ++bj) { const int col = u.pn * BM + bj * HALF + wc * 32 + 8 * fq;
          gw[m2][bj] = *(const u32x4*)((const bf16_t*)(ws + OFF_G) + (size_t)row * 3072 + b * 1024 + col);
          if (b > 0) mw[m2][bj] = *(const u32x4*)((const bf16_t*)(ws + OFF_MIX) + (size_t)row * 1024 + col); } }
#pragma unroll
      for (int m2 = 0; m2 < 2; ++m2) { const int m = mh * 2 + m2, row = u.pm * BM + ai * HALF + wr * 64 + m * 16 + fr;
#pragma unroll
        for (int bj = 0; bj < 2; ++bj) { const int col = u.pn * BM + bj * HALF + wc * 32 + 8 * fq;
          f32x4 g0, g1; unpack8v(gw[m2][bj], g0, g1);
          f32x4 r0 = g0 * acc[ai][bj][m][0], r1 = g1 * acc[ai][bj][m][1];
          if (b > 0) { f32x4 o0, o1; unpack8v(mw[m2][bj], o0, o1); r0 += o0; r1 += o1; }
          *(u32x4*)((bf16_t*)(ws + OFF_MIX) + (size_t)row * 1024 + col) = pack8(r0, r1); } }
    }
  }
};
struct EpiOut {
  const float* xi; float* x; bf16_t* xb;
  __device__ __forceinline__ void operator()(const f32x4 (&acc)[2][2][4][2], const Unit& u, int wr, int wc, int fr, int fq) const {
#pragma unroll
    for (int ai = 0; ai < 2; ++ai)
#pragma unroll
    for (int mh = 0; mh < 2; ++mh) {
      f32x4 xv[2][2][2];
#pragma unroll
      for (int m2 = 0; m2 < 2; ++m2) { const int m = mh * 2 + m2, row = u.pm * BM + ai * HALF + wr * 64 + m * 16 + fr;
#pragma unroll
        for (int bj = 0; bj < 2; ++bj) { const size_t off = (size_t)row * DM + u.pn * BM + bj * HALF + wc * 32 + 8 * fq; xv[m2][bj][0] = *(const f32x4*)(xi + off); xv[m2][bj][1] = *(const f32x4*)(xi + off + 4); } }
#pragma unroll
      for (int m2 = 0; m2 < 2; ++m2) { const int m = mh * 2 + m2, row = u.pm * BM + ai * HALF + wr * 64 + m * 16 + fr;
#pragma unroll
        for (int bj = 0; bj < 2; ++bj) { const size_t off = (size_t)row * DM + u.pn * BM + bj * HALF + wc * 32 + 8 * fq;
          const f32x4 a0 = xv[m2][bj][0] + acc[ai][bj][m][0], a1 = xv[m2][bj][1] + acc[ai][bj][m][1];
          *(f32x4*)(x + off) = a0; *(f32x4*)(x + off + 4) = a1; *(u32x4*)(xb + off) = pack8(a0, a1); } }
    }
  }
};
struct EpiUpBoth {
  unsigned char* ws;
  __device__ __forceinline__ void operator()(const f32x4 (&acc)[2][2][4][2], const Unit& u, int wr, int wc, int fr, int fq) const {
    if (u.aux == 0) { EpiUp<2, 256, true> e{ws, (bf16_t*)(ws + OFF_QB), 768, (const float*)(ws + OFF_CTL + CTL_SSQQ)}; e(acc, u, wr, wc, fr, fq); }
    else { EpiUp<1, 128, false> e{ws, (bf16_t*)(ws + OFF_KVB), 1024, (const float*)(ws + OFF_CTL + CTL_SSQKV)}; e(acc, u, wr, wc, fr, fq); }
  }
};
struct UpOrder {
  unsigned char* ws; int G, c;
  __device__ __forceinline__ bool next(int i, Unit& u) const {
    const int L = i * G + c; if (L >= 448) return false;
    u.rows = nullptr;
    if (L < 192) { u.pm = L / 3; u.pn = L % 3; u.aux = 0; u.nt = 4; u.A = (const char*)(ws + OFF_BC) + (size_t)u.pm * BM * 384 * 2; u.B = (const char*)(ws + OFF_WATT + WA_UQ) + (size_t)u.pn * BM * 256 * 2; }
    else { const int k = L - 192; u.pm = k >> 2; u.pn = k & 3; u.aux = 1; u.nt = 2; u.A = (const char*)(ws + OFF_BC) + (size_t)u.pm * BM * 384 * 2 + 512; u.B = (const char*)(ws + OFF_WATT + WA_UKV) + (size_t)u.pn * BM * 256 * 2; }
    return true; }
};
struct ProjOrder {
  unsigned char* ws; int G, c;
  __device__ __forceinline__ bool next(int i, Unit& u) const {
    const int b = i % 3; if (!static_tile(i / 3, G, c, T / BM, 4, u.pm, u.pn)) return false;
    const size_t oa = b == 0 ? OFF_AQ : b == 1 ? OFF_AIQ : OFF_CQ;
    u.A = (const char*)(ws + oa) + (size_t)u.pm * BM * 512 * 2; u.B = (const char*)(ws + OFF_WATT + WA_P) + ((size_t)b * 1024 + (size_t)u.pn * BM) * 512 * 2; u.rows = nullptr; u.aux = b; u.nt = 8; return true; }
};

__device__ __forceinline__ void moe_build_map(unsigned* cntp, PG8_LAS unsigned* tab, int tid) {
  if (tid < 64) { const int lane = tid;
    const unsigned c = lane < 32 ? __hip_atomic_load(cntp + lane, __ATOMIC_RELAXED, __HIP_MEMORY_SCOPE_AGENT) : 0u;
    const unsigned nt = (c + 255u) >> 8; unsigned incl = nt;
#pragma unroll
    for (int o = 1; o < 32; o <<= 1) { const unsigned v = (unsigned)__builtin_amdgcn_ds_bpermute(((lane - o) & 63) << 2, (int)incl); if ((lane & 31) >= o) incl += v; }
    const unsigned start = incl - nt;
    if (lane < 32) for (unsigned j = 0; j < nt; ++j) { unsigned valid = c - j * 256u; valid = valid > 256u ? 256u : valid; tab[start + j] = (unsigned)lane | (j << 8) | (valid << 16); }
    if (lane == 31) tab[255] = incl; }
  __syncthreads();
}
template <int NPN, bool DOWN>
struct MoeOrder {
  unsigned char* ws; int G, c; const PG8_LAS unsigned* tab; int lo, hi;
  __device__ __forceinline__ bool next(int i, Unit& u) const {
    const int L = lo + i * G + c, tile = L / NPN, pn = L % NPN; const int total = __builtin_amdgcn_readfirstlane((int)tab[255]); if (c < 0 || L >= hi || tile >= total) return false;
    const unsigned rec = (unsigned)__builtin_amdgcn_readfirstlane((int)tab[tile]);
    const int e = rec & 255u, j = (rec >> 8) & 255u, valid = rec >> 16;
    u.pm = tile; u.pn = pn; u.aux = valid; u.nt = DOWN ? 4 : 16; u.rows = (const int*)(ws + OFF_LIST) + (size_t)e * T + j * 256;
    if (!DOWN) { u.A = (const char*)(ws + OFF_XB); u.B = (const char*)(ws + OFF_WGU) + ((size_t)e * 512 + (size_t)pn * 256) * 1024 * 2; }
    else { u.A = (const char*)(ws + OFF_H) + (size_t)tile * 256 * 256 * 2; u.B = (const char*)(ws + OFF_WD) + ((size_t)e * 1024 + (size_t)pn * 256) * 256 * 2; }
    return true; }
};
struct EpiGU {
  unsigned char* ws;
  __device__ __forceinline__ void operator()(const f32x4 (&acc)[2][2][4][2], const Unit& u, int wr, int wc, int fr, int fq) const {
    const float* rstd = (const float*)(ws + OFF_CTL + CTL_RSTD); const float* tokw = (const float*)(ws + OFF_CTL + CTL_TOKW);
    int ent[8]; float rs[8], wv[8];
#pragma unroll
    for (int k = 0; k < 8; ++k) { const int r = (k >> 2) * HALF + wr * 64 + (k & 3) * 16 + fr; ent[k] = u.rows[r < u.aux ? r : u.aux - 1]; }
#pragma unroll
    for (int k = 0; k < 8; ++k) { rs[k] = rstd[ent[k] >> 1]; wv[k] = tokw[ent[k]]; }
#pragma unroll
    for (int ai = 0; ai < 2; ++ai)
#pragma unroll
      for (int m = 0; m < 4; ++m) { const int r = ai * HALF + wr * 64 + m * 16 + fr; const int k = ai * 4 + m;
        if (r < u.aux) { const float rsk = rs[k], w = wv[k];
          f32x4 h0, h1;
#pragma unroll
          for (int j = 0; j < 4; ++j) { const float a0 = acc[ai][0][m][0][j] * rsk, a1 = acc[ai][0][m][1][j] * rsk;
            h0[j] = a0 * __builtin_amdgcn_rcpf(1.f + __expf(-a0)) * (acc[ai][1][m][0][j] * rsk) * w; h1[j] = a1 * __builtin_amdgcn_rcpf(1.f + __expf(-a1)) * (acc[ai][1][m][1][j] * rsk) * w; }
          *(u32x4*)((bf16_t*)(ws + OFF_H) + ((size_t)u.pm * 256 + r) * 256 + u.pn * 128 + wc * 32 + 8 * fq) = pack8(h0, h1); } }
  }
};
struct EpiDown {
  unsigned char* ws;
  __device__ __forceinline__ void operator()(const f32x4 (&acc)[2][2][4][2], const Unit& u, int wr, int wc, int fr, int fq) const {
    int ent[8];
#pragma unroll
    for (int k = 0; k < 8; ++k) { const int r = (k >> 2) * HALF + wr * 64 + (k & 3) * 16 + fr; ent[k] = u.rows[r < u.aux ? r : u.aux - 1]; }
#pragma unroll
    for (int ai = 0; ai < 2; ++ai)
#pragma unroll
      for (int m = 0; m < 4; ++m) { const int r = ai * HALF + wr * 64 + m * 16 + fr;
        if (r < u.aux) { const int entry = ent[ai * 4 + m];
#pragma unroll
          for (int bj = 0; bj < 2; ++bj) *(u32x4*)((bf16_t*)(ws + OFF_Y) + (size_t)entry * 1024 + u.pn * BM + bj * HALF + wc * 32 + 8 * fq) = pack8(acc[ai][bj][m][0], acc[ai][bj][m][1]); } }
  }
};
}

namespace att {
using bf16x8 = __attribute__((ext_vector_type(8))) short;
using s16x4  = __attribute__((ext_vector_type(4))) short;
using f32x16 = __attribute__((ext_vector_type(16))) float;
using u32x4  = __attribute__((ext_vector_type(4))) unsigned;
constexpr int KVBLK = 64;
constexpr float THR = 8.f, NEG = -1e30f, M_INIT = -1e6f;
#define ASBAR() __builtin_amdgcn_sched_barrier(0)
__device__ __forceinline__ constexpr int crow_c(int r) { return (r & 3) + 8 * (r >> 2); }
__device__ __forceinline__ unsigned cvtpk(float lo, float hi) { unsigned r; asm volatile("v_cvt_pk_bf16_f32 %0, %1, %2" : "=v"(r) : "v"(lo), "v"(hi)); return r; }
template <int MODE> struct Cfg {
  static constexpr int DQK = MODE == 1 ? 192 : 128, ND0 = DQK / 16, KP = DQK * 2, SHM_K = 64 * KP;
  static constexpr float SCALE = MODE == 1 ? 0.07216878364870322f : 0.088388347648318440f;
};
template <int MODE>
__device__ __forceinline__ void partialSM(f32x16& p0, f32x16& p1, float& m_reg, float& mn, float& alpha) {
  constexpr float SC = Cfg<MODE>::SCALE, C = SC * 1.4426950408889634f;
#pragma unroll
  for (int r = 0; r < 16; ++r) { p0[r] *= C; p1[r] *= C; }
  float pmax = p0[0];
#pragma unroll
  for (int r = 1; r < 16; ++r) pmax = fmaxf(pmax, p0[r]);
#pragma unroll
  for (int r = 0; r < 16; ++r) pmax = fmaxf(pmax, p1[r]);
  { auto rr = __builtin_amdgcn_permlane32_swap(__float_as_uint(pmax), __float_as_uint(pmax), false, false);
    pmax = fmaxf(__uint_as_float(rr[0]), __uint_as_float(rr[1])); }
  if (__builtin_expect(__all(pmax - m_reg <= THR * 1.4426950408889634f), 1)) { mn = m_reg; alpha = 1.f; }
  else { mn = fmaxf(m_reg, pmax); alpha = __builtin_amdgcn_exp2f(m_reg - mn); m_reg = mn; }
#pragma unroll
  for (int r = 0; r < 16; ++r) { p0[r] -= mn; p1[r] -= mn; }
#pragma unroll
  for (int r = 0; r < 16; ++r) p0[r] = __builtin_amdgcn_exp2f(p0[r]);
}
__device__ __forceinline__ void finishSM(f32x16& p0, f32x16& p1, float alpha, float& l_reg, bf16x8& pa0, bf16x8& pa1, bf16x8& pa2, bf16x8& pa3) {
#pragma unroll
  for (int r = 0; r < 16; ++r) p1[r] = __builtin_amdgcn_exp2f(p1[r]);
  float ps = 0;
#pragma unroll
  for (int r = 0; r < 16; ++r) ps += p0[r];
#pragma unroll
  for (int r = 0; r < 16; ++r) ps += p1[r];
  { auto rr = __builtin_amdgcn_permlane32_swap(__float_as_uint(ps), __float_as_uint(ps), false, false);
    ps = __uint_as_float(rr[0]) + __uint_as_float(rr[1]); }
  l_reg = l_reg * alpha + ps;
#define PK4(P, BASE, OUT) do { unsigned a0 = cvtpk(P[BASE + 0], P[BASE + 1]), a1 = cvtpk(P[BASE + 2], P[BASE + 3]);   \
    unsigned b0 = cvtpk(P[BASE + 4], P[BASE + 5]), b1 = cvtpk(P[BASE + 6], P[BASE + 7]);                              \
    auto r0 = __builtin_amdgcn_permlane32_swap(a0, b0, false, false); auto r1 = __builtin_amdgcn_permlane32_swap(a1, b1, false, false); \
    u32x4 w = {r0[0], r1[0], r0[1], r1[1]}; OUT = *reinterpret_cast<bf16x8*>(&w); } while (0)
  PK4(p0, 0, pa0); PK4(p0, 8, pa1); PK4(p1, 0, pa2); PK4(p1, 8, pa3);
#undef PK4
}
#define KSWZ(row, colB, KP) ((row) * (KP) + ((colB) ^ (((row) & 7) << 4)))
template <int MODE>
__device__ __forceinline__ void qkt(f32x16& p0, f32x16& p1, const char* Ks, const bf16x8* qr, const char* qx  , int r32, int hi) {
  constexpr int KP = Cfg<MODE>::KP;
  p0 = f32x16{}; p1 = f32x16{};
#pragma unroll
  for (int d0 = 0; d0 < Cfg<MODE>::ND0; ++d0) { const int cb = (d0 * 16 + hi * 8) * 2;
    bf16x8 b0 = *reinterpret_cast<const bf16x8*>(Ks + KSWZ(r32, cb, KP));
    bf16x8 b1 = *reinterpret_cast<const bf16x8*>(Ks + KSWZ(32 + r32, cb, KP));
    const bf16x8 q = d0 < 8 ? qr[d0 < 8 ? d0 : 0] : *reinterpret_cast<const bf16x8*>(qx + (d0 - 8) * 32);
    p0 = __builtin_amdgcn_mfma_f32_32x32x16_bf16(b0, q, p0, 0, 0, 0);
    p1 = __builtin_amdgcn_mfma_f32_32x32x16_bf16(b1, q, p1, 0, 0, 0); }
}
__device__ __forceinline__ int v_st(int k, int c) { const int kk = (k & ~0xC) | ((k & 4) << 1) | ((k & 8) >> 1); return ((kk >> 3) * 4 + (c >> 5)) * 512 + ((kk & 7) * 32 + (c & 31)) * 2; }
__device__ __forceinline__ int v_rd_base(int lane) { return ((lane & 3) << 3) | (((lane >> 2) & 3) << 6) | (((lane >> 4) & 1) << 5) | (((lane >> 5) & 1) << 8); }
constexpr int v_rd_off(int d0, int ks, int half) { return d0 * 512 + ks * 4096 + half * 2048; }
template <int OFF> __device__ __forceinline__ s16x4 tr_read(int vb) {
  s16x4 r; asm volatile("ds_read_b64_tr_b16 %0, %1 offset:%2" : "=&v"(r) : "v"(vb), "i"(OFF) : "memory"); return r;
}
template <int D0> __device__ __forceinline__ void pv_one(f32x16& od, int vb, bf16x8 pa0, bf16x8 pa1, bf16x8 pa2, bf16x8 pa3) {
  const s16x4 l0 = tr_read<v_rd_off(D0, 0, 0)>(vb), h0 = tr_read<v_rd_off(D0, 0, 1)>(vb), l1 = tr_read<v_rd_off(D0, 1, 0)>(vb), h1 = tr_read<v_rd_off(D0, 1, 1)>(vb);
  const s16x4 l2 = tr_read<v_rd_off(D0, 2, 0)>(vb), h2 = tr_read<v_rd_off(D0, 2, 1)>(vb), l3 = tr_read<v_rd_off(D0, 3, 0)>(vb), h3 = tr_read<v_rd_off(D0, 3, 1)>(vb);
  asm volatile("s_waitcnt lgkmcnt(0)" ::: "memory"); ASBAR();
#define PK(L, H) (bf16x8){L[0], L[1], L[2], L[3], H[0], H[1], H[2], H[3]}
  od = __builtin_amdgcn_mfma_f32_32x32x16_bf16(pa0, PK(l0, h0), od, 0, 0, 0);
  od = __builtin_amdgcn_mfma_f32_32x32x16_bf16(pa1, PK(l1, h1), od, 0, 0, 0);
  od = __builtin_amdgcn_mfma_f32_32x32x16_bf16(pa2, PK(l2, h2), od, 0, 0, 0);
  od = __builtin_amdgcn_mfma_f32_32x32x16_bf16(pa3, PK(l3, h3), od, 0, 0, 0);
#undef PK
}
__device__ __forceinline__ void pv_d0(f32x16* o, int vb, bf16x8 pa0, bf16x8 pa1, bf16x8 pa2, bf16x8 pa3) {
  pv_one<0>(o[0], vb, pa0, pa1, pa2, pa3); pv_one<1>(o[1], vb, pa0, pa1, pa2, pa3); pv_one<2>(o[2], vb, pa0, pa1, pa2, pa3); pv_one<3>(o[3], vb, pa0, pa1, pa2, pa3);
}
template <int MODE>
__device__ __forceinline__ void post_scores(f32x16& p0, f32x16& p1, int jt, int jlo_w, int jhi_w, int cw, const char* xl, int qloc, int hi) {
  if (MODE == 0) {
    const uint2 w = *reinterpret_cast<const uint2*>(xl + qloc * 264 + jt * 8);
    const unsigned wl = w.x >> (4 * hi), wh = w.y >> (4 * hi);
#pragma unroll
    for (int r = 0; r < 16; ++r) { const unsigned m0 = (unsigned)__builtin_amdgcn_sbfe((int)wl, crow_c(r), 1), m1 = (unsigned)__builtin_amdgcn_sbfe((int)wh, crow_c(r), 1);
      p0[r] = __uint_as_float((__float_as_uint(p0[r]) & m0) | (__float_as_uint(NEG) & ~m0)); p1[r] = __uint_as_float((__float_as_uint(p1[r]) & m1) | (__float_as_uint(NEG) & ~m1)); }
  } else {
    if (jt > jhi_w || jt < jlo_w) {
#pragma unroll
      for (int r = 0; r < 16; ++r) { p0[r] = NEG; p1[r] = NEG; }
    } else if (MODE == 2) {
      const float* tab = reinterpret_cast<const float*>(xl);
      const int dj = cw - jt;
      if (dj >= 3) { const float bf = tab[256];
#pragma unroll
        for (int r = 0; r < 16; ++r) { p0[r] += bf; p1[r] += bf; } }
      else { const int dbase = dj * 64 + qloc - 4 * hi;
#pragma unroll
        for (int r = 0; r < 16; ++r) { int d0 = dbase - crow_c(r), d1 = d0 - 32; d0 = d0 > 128 ? 128 : d0; d1 = d1 > 128 ? 128 : d1; p0[r] += tab[d0 + 128]; p1[r] += tab[d1 + 128]; } }
    }
  }
}
template <int MODE>
__device__ __forceinline__ void attn_unit(unsigned char* ws, const float* relb, const int tid, char* lds, const int b, const int hx, const int cg, const bool dry = false) {
  using C = Cfg<MODE>;
  constexpr int KP = C::KP, SHM_K = C::SHM_K, SHM_V = 16384, ND0 = C::ND0;
  const int wid = __builtin_amdgcn_readfirstlane(tid >> 6), lane = tid & 63, r32 = lane & 31, hi = lane >> 5;
  char* V_lds = lds; char* K_lds = lds + 2 * SHM_V;
  float* wsc = reinterpret_cast<float*>(lds + 2 * SHM_V + 2 * SHM_K) + wid * 64; float* li_l = wsc; float* al_l = wsc + 32;
  char* xl = lds + 2 * SHM_V + 2 * SHM_K + 2048;
  const size_t tb = (size_t)b * SEQ;
  const int cw = MODE == 0 ? cg : 4 * cg + (wid >> 1);
  const int qloc = (wid & 1) * 32 + r32;
  const size_t tok = tb + (size_t)cw * 64 + qloc;
  const int j0 = MODE == 2 ? (4 * cg - 8 > 0 ? 4 * cg - 8 : 0) : 0;
  const int NT = MODE == 0 ? ((cg + 2) & ~1) : (4 * cg + 4 - j0);
  const int jlo_w = MODE == 2 ? (cw - 8 > 0 ? cw - 8 : 0) : 0, jhi_w = cw;
  const bf16_t* Kh; const bf16_t* Vh; const bf16_t* Kr = nullptr; int LDK;
  if (MODE == 0) { Kh = (const bf16_t*)(ws + OFF_AK) + tb * 128; Vh = (const bf16_t*)(ws + OFF_AV) + tb * 128; LDK = 128; }
  else if (MODE == 1) { Kh = (const bf16_t*)(ws + OFF_KVB) + tb * 1024 + hx * 256; Vh = Kh + 128; Kr = (const bf16_t*)(ws + OFF_BKR) + tb * 64; LDK = 1024; }
  else { Kh = (const bf16_t*)(ws + OFF_CK) + tb * 512 + hx * 128; Vh = (const bf16_t*)(ws + OFF_CV) + tb * 512 + hx * 128; LDK = 512; }
  __syncthreads();
  if (MODE == 0) { const uint2* mb = (const uint2*)(ws + OFF_MASK) + (tb + (size_t)cg * 64) * 32;
    for (int i = tid; i < 64 * 32; i += 512) { const int q = i >> 5, j = i & 31; *reinterpret_cast<uint2*>(xl + q * 264 + j * 8) = mb[i]; } }
  if (MODE == 2) { for (int i = tid; i < 257; i += 512) reinterpret_cast<float*>(xl)[i] = relb[hx * 257 + i] * (1.f / C::SCALE); }
  float m_reg = M_INIT, l_reg = 0; f32x16 o[4] = {}; bf16x8 qr[8];
  const char* qx = xl + wid * 4608 + r32 * 144 + hi * 16;
  { const bf16_t* Qw;
    if (MODE == 0) Qw = (const bf16_t*)(ws + OFF_AQ) + tok * 512 + (wid >> 1) * 128 + hi * 8;
    else if (MODE == 1) Qw = (const bf16_t*)(ws + OFF_QB) + tok * 768 + hx * 128 + hi * 8;
    else Qw = (const bf16_t*)(ws + OFF_CQ) + tok * 512 + hx * 128 + hi * 8;
#pragma unroll
    for (int d0 = 0; d0 < 8; ++d0) qr[d0] = *reinterpret_cast<const bf16x8*>(Qw + d0 * 16);
    if (MODE == 1) { const bf16_t* Qr = (const bf16_t*)(ws + OFF_QB) + tok * 768 + 512 + hx * 64 + hi * 8;
#pragma unroll
      for (int d0 = 8; d0 < ND0; ++d0) *reinterpret_cast<bf16x8*>(const_cast<char*>(qx) + (d0 - 8) * 32) = *reinterpret_cast<const bf16x8*>(Qr + (d0 - 8) * 16); } }
  const int sr = tid >> 4, sc = (tid & 15) * 8, vst0 = v_st(sr, sc), vst1 = v_st(32 + sr, sc);
  const int vb0 = (int)(uintptr_t)V_lds + v_rd_base(lane);
  constexpr int NPI = SHM_K / 8192;
  unsigned koff[NPI], kstr[NPI];
#pragma unroll
  for (int i = 0; i < NPI; ++i) { const int L = (i * 8 + wid) * 1024 + lane * 16, row = L / KP, cs = L % KP, colB = cs ^ ((row & 7) << 4);
    if (MODE == 1 && colB >= 256) { koff[i] = (unsigned)(OFF_BKR + (tb + (size_t)j0 * 64 + row) * 128 + (colB - 256)); kstr[i] = 64 * 128; }
    else { koff[i] = (unsigned)((MODE == 0 ? OFF_AK : MODE == 1 ? OFF_KVB : OFF_CK) + (tb + (size_t)j0 * 64 + row) * (size_t)LDK * 2 + (MODE == 0 ? 0 : MODE == 1 ? hx * 512 : hx * 256) + colB); kstr[i] = 64 * LDK * 2; } }
  bf16x8 vs0, vs1;
#define SLOAD(jrel, bf) do { const int k0_ = kbase + (jrel) * KVBLK; \
    vs0 = *reinterpret_cast<const bf16x8*>(&Vh[(size_t)(k0_ + sr) * LDK + sc]); vs1 = *reinterpret_cast<const bf16x8*>(&Vh[(size_t)(k0_ + 32 + sr) * LDK + sc]); \
    _Pragma("unroll") for (int i_ = 0; i_ < NPI; ++i_) { __builtin_amdgcn_global_load_lds((const unsigned*)(ws + koff[i_]), \
        (__attribute__((address_space(3))) unsigned*)(K_lds + (bf) * SHM_K + (i_ * 8 + wid) * 1024), 16, 0, 0); koff[i_] += (MODE == 1 ? kstr[i_] : (unsigned)(64 * LDK * 2)); } } while (0)
#define SWRITE(bf) do { *reinterpret_cast<bf16x8*>(V_lds + (bf) * SHM_V + vst0) = vs0; *reinterpret_cast<bf16x8*>(V_lds + (bf) * SHM_V + vst1) = vs1; } while (0)
#define RESC(a) do { if (__any((a) < 1.f)) { if (hi == 0) al_l[r32] = (a); asm volatile("s_waitcnt lgkmcnt(0)" ::: "memory"); \
    _Pragma("unroll") for (int d = 0; d < 4; ++d) _Pragma("unroll") for (int r = 0; r < 16; ++r) o[d][r] *= al_l[crow_c(r) + 4 * hi]; } } while (0)
#define POST(P0, P1, jrel) post_scores<MODE>(P0, P1, j0 + (jrel), jlo_w, jhi_w, cw, xl, qloc, hi)
  const int kbase = j0 * KVBLK; (void)kbase;
  bf16x8 pa0, pa1, pa2, pa3;
  if (MODE != 2) {
    f32x16 p0, p1; float mn, al;
    SLOAD(0, 0); asm volatile("s_waitcnt vmcnt(0)" ::: "memory"); SWRITE(0); __syncthreads();
    for (int j = 0; j < NT; j += 2) {
      SLOAD(j + 1, 1); ASBAR();
      qkt<MODE>(p0, p1, K_lds, qr, qx, r32, hi); POST(p0, p1, j); partialSM<MODE>(p0, p1, m_reg, mn, al); RESC(al);
      finishSM(p0, p1, al, l_reg, pa0, pa1, pa2, pa3); ASBAR();
      pv_d0(o, vb0, pa0, pa1, pa2, pa3);
      asm volatile("s_waitcnt vmcnt(0)" ::: "memory"); SWRITE(1); __syncthreads();
      const bool more = j + 2 < NT;
      if (more) SLOAD(j + 2, 0);
      ASBAR();
      qkt<MODE>(p0, p1, K_lds + SHM_K, qr, qx, r32, hi); POST(p0, p1, j + 1); partialSM<MODE>(p0, p1, m_reg, mn, al); RESC(al);
      finishSM(p0, p1, al, l_reg, pa0, pa1, pa2, pa3); ASBAR();
      pv_d0(o, vb0 + SHM_V, pa0, pa1, pa2, pa3);
      asm volatile("s_waitcnt vmcnt(0)" ::: "memory"); if (more) SWRITE(0); __syncthreads();
    }
  } else {
    f32x16 pA0, pA1, pB0, pB1; float mnA, mnB, alA, alB;
    SLOAD(0, 0); asm volatile("s_waitcnt vmcnt(0)" ::: "memory"); SWRITE(0); __syncthreads();
    qkt<MODE>(pA0, pA1, K_lds, qr, qx, r32, hi); POST(pA0, pA1, 0); partialSM<MODE>(pA0, pA1, m_reg, mnA, alA);
    SLOAD(1, 1);
    asm volatile("s_waitcnt vmcnt(0)" ::: "memory"); SWRITE(1); __syncthreads();
    for (int j = 1; j + 1 < NT; j += 2) {
      ASBAR(); qkt<MODE>(pB0, pB1, K_lds + SHM_K, qr, qx, r32, hi); POST(pB0, pB1, j);
      finishSM(pA0, pA1, alA, l_reg, pa0, pa1, pa2, pa3); ASBAR();
      SLOAD(j + 1, 0); ASBAR();
      pv_d0(o, vb0, pa0, pa1, pa2, pa3); partialSM<MODE>(pB0, pB1, m_reg, mnB, alB);
      __syncthreads(); asm volatile("s_waitcnt vmcnt(0)" ::: "memory"); SWRITE(0);
      RESC(alB); __syncthreads();
      ASBAR(); qkt<MODE>(pA0, pA1, K_lds, qr, qx, r32, hi); POST(pA0, pA1, j + 1);
      finishSM(pB0, pB1, alB, l_reg, pa0, pa1, pa2, pa3); ASBAR();
      SLOAD(j + 2, 1); ASBAR();
      pv_d0(o, vb0 + SHM_V, pa0, pa1, pa2, pa3); partialSM<MODE>(pA0, pA1, m_reg, mnA, alA);
      __syncthreads(); asm volatile("s_waitcnt vmcnt(0)" ::: "memory"); SWRITE(1);
      RESC(alA); __syncthreads();
    }
    ASBAR(); qkt<MODE>(pB0, pB1, K_lds + SHM_K, qr, qx, r32, hi); POST(pB0, pB1, NT - 1);
    finishSM(pA0, pA1, alA, l_reg, pa0, pa1, pa2, pa3); ASBAR();
    pv_d0(o, vb0, pa0, pa1, pa2, pa3); partialSM<MODE>(pB0, pB1, m_reg, mnB, alB);
    __syncthreads(); RESC(alB);
    finishSM(pB0, pB1, alB, l_reg, pa0, pa1, pa2, pa3); ASBAR();
    pv_d0(o, vb0 + SHM_V, pa0, pa1, pa2, pa3);
  }
  int lane_e = lane; asm volatile("" : "+v"(lane_e));
  const int r32e = lane_e & 31, hie = lane_e >> 5;
  if (hi == 0) li_l[r32] = l_reg; asm volatile("s_waitcnt lgkmcnt(0)" ::: "memory");
  float rli[16];
#pragma unroll
  for (int r = 0; r < 16; ++r) rli[r] = __builtin_amdgcn_rcpf(li_l[crow_c(r) + 4 * hi]);
  __syncthreads();
  char* Ost = lds + wid * 8192;
#pragma unroll
  for (int r = 0; r < 16; ++r) { const int orow = crow_c(r) + 4 * hie;
#pragma unroll
    for (int d0 = 0; d0 < 4; ++d0) *reinterpret_cast<bf16_t*>(Ost + orow * 256 + (d0 * 32 + r32e) * 2) = f2bf(o[d0][r] * rli[r]); }
  asm volatile("s_waitcnt lgkmcnt(0)" ::: "memory");
  { bf16_t* Ob; int ldo;
    const size_t tok0 = tb + (size_t)cw * 64 + (wid & 1) * 32;
    if (MODE == 0) { Ob = (bf16_t*)(ws + OFF_AQ) + tok0 * 512 + (wid >> 1) * 128; ldo = 512; }
    else if (MODE == 1) { Ob = (bf16_t*)(ws + OFF_AIQ) + tok0 * 512 + hx * 128; ldo = 512; }
    else { Ob = (bf16_t*)(ws + OFF_CQ) + tok0 * 512 + hx * 128; ldo = 512; }
#pragma unroll
    for (int i = 0; i < 8; ++i) { const int ch = i * 64 + lane_e, row = ch >> 4, c16 = ch & 15;
      const u32x4 ov = *reinterpret_cast<const u32x4*>(Ost + row * 256 + c16 * 16); if (!dry) *reinterpret_cast<u32x4*>(Ob + (size_t)row * ldo + c16 * 8) = ov; } }
#undef SLOAD
#undef SWRITE
#undef RESC
#undef POST
}
}

namespace idx {
using bf16x8 = __attribute__((ext_vector_type(8))) short;
using f32x4 = __attribute__((ext_vector_type(4))) float;
__device__ __forceinline__ unsigned ordkey(float f) { const unsigned u = __float_as_uint(f); return (u & 0x80000000u) ? ~u : (u | 0x80000000u); }
__device__ __forceinline__ void select2(const unsigned (&key)[2][32], const int nw, unsigned* h0p, unsigned* h1p, const int lane_in, unsigned (&thr)[2], bool (&allsel)[2]) {
  unsigned prefix[2] = {0u, 0u}; int rneed[2] = {256, 256}; bool done[2] = {false, false};
  thr[0] = thr[1] = 0u; allsel[0] = allsel[1] = false;
#pragma unroll
  for (int pass = 0; pass < 3; ++pass) {
    if (!(done[0] && done[1])) {
      int lane = lane_in; asm volatile("" : "+v"(lane));
      const int sh = pass == 0 ? 21 : pass == 1 ? 10 : 0, bits = pass == 2 ? 10 : 11; const unsigned nbm = (1u << bits) - 1u;
#pragma unroll
      for (int i = 0; i < 32; ++i) { h0p[lane + 64 * i] = 0u; h1p[lane + 64 * i] = 0u; }
#pragma unroll
      for (int i = 0; i < 32; ++i) if (i < nw) {
#pragma unroll
        for (int q = 0; q < 2; ++q) { const bool match = pass == 0 ? true : (key[q][i] >> (sh + bits)) == prefix[q];
          if (match) { const unsigned d = (key[q][i] >> sh) & nbm; atomicAdd(&(q ? h1p : h0p)[(d & ~31u) | ((d & 31u) ^ ((d >> 5) & 31u))], 1u); } } }
      unsigned tl[2] = {0u, 0u};
#pragma unroll
      for (int i = 0; i < 32; ++i) { tl[0] += h0p[32 * lane + (i ^ (lane & 31))]; tl[1] += h1p[32 * lane + (i ^ (lane & 31))]; }
      unsigned S[2] = {tl[0], tl[1]};
#pragma unroll
      for (int o = 1; o < 64; o <<= 1) {
        const unsigned v0 = (unsigned)__builtin_amdgcn_ds_bpermute(((lane + o) & 63) << 2, (int)S[0]), v1 = (unsigned)__builtin_amdgcn_ds_bpermute(((lane + o) & 63) << 2, (int)S[1]);
        if (lane + o < 64) { S[0] += v0; S[1] += v1; } }
      int Ls[2], rls[2];
#pragma unroll
      for (int q = 0; q < 2; ++q) { const u64 mk = __ballot((int)S[q] >= rneed[q]); Ls[q] = __builtin_amdgcn_readfirstlane(63 - __clzll(mk));
        rls[q] = __builtin_amdgcn_readlane(rneed[q] - (int)(S[q] - tl[q]), Ls[q]); }
      const int li = lane & 31;
      unsigned hbv[2] = {h0p[32 * Ls[0] + (li ^ (Ls[0] & 31))], h1p[32 * Ls[1] + (li ^ (Ls[1] & 31))]};
      unsigned P[2] = {hbv[0], hbv[1]};
#pragma unroll
      for (int o = 1; o < 32; o <<= 1) {
        const unsigned v0 = (unsigned)__builtin_amdgcn_ds_bpermute(((lane + o) & 63) << 2, (int)P[0]), v1 = (unsigned)__builtin_amdgcn_ds_bpermute(((lane + o) & 63) << 2, (int)P[1]);
        if (li + o < 32) { P[0] += v0; P[1] += v1; } }
#pragma unroll
      for (int q = 0; q < 2; ++q) {
        const unsigned mk2 = (unsigned)__ballot((int)P[q] >= rls[q]);
        const int bi = __builtin_amdgcn_readfirstlane(31 - __clz(mk2));
        const int hbs = __builtin_amdgcn_readlane((int)hbv[q], bi), Pbi = __builtin_amdgcn_readlane((int)P[q], bi);
        const int rn = rls[q] - (Pbi - hbs);
        if (!done[q]) { rneed[q] = rn; prefix[q] = (prefix[q] << bits) | (unsigned)(32 * Ls[q] + bi); thr[q] = prefix[q] << sh;
          if (hbs == rn) { done[q] = true; allsel[q] = true; } }
      }
    }
  }
}
__device__ __forceinline__ u64 mask_words(const unsigned (&key)[32], const unsigned thr, const bool allsel, const int lane) {
  u64 myword = 0ull;
  if (allsel) {
#pragma unroll
    for (int i = 0; i < 32; ++i) { const u64 word = __ballot(key[i] >= thr); if (lane == i) myword = word; }
  } else {
    int cgt = 0;
#pragma unroll
    for (int i = 0; i < 32; ++i) cgt += __popcll(__ballot(key[i] > thr));
    const int need = 256 - cgt; int taken = 0;
#pragma unroll
    for (int i = 0; i < 32; ++i) {
      const bool gt = key[i] > thr, eq = key[i] == thr; const u64 em = __ballot(eq);
      const int before = taken + (int)__builtin_amdgcn_mbcnt_hi((unsigned)(em >> 32), __builtin_amdgcn_mbcnt_lo((unsigned)em, 0u));
      const u64 word = __ballot(gt || (eq && before < need)); taken += __popcll(em);
      if (lane == i) myword = word;
    }
  }
  return myword;
}
__device__ __forceinline__ void indexer_unit(unsigned char* ws, const int tid, char* lds, const int b, const int c, const int half) {
  const int wid = __builtin_amdgcn_readfirstlane(tid >> 6), lane = tid & 63, l15 = lane & 15, G = lane >> 4;
  const size_t tb = (size_t)b * SEQ;
  const int nk = (c + 1) * 64, nw = c + 1, nt16 = nk / 16;
  u64* mrow = (u64*)(ws + OFF_MASK) + (tb + (size_t)c * 64 + half * 32) * 32;
  if (c < 4) {
    for (int i = tid; i < 32 * 32; i += 512) mrow[i] = (i & 31) <= c ? ~0ull : 0ull;
    return;
  }
  float* sc = reinterpret_cast<float*>(lds);
  const bf16_t* aiq = (const bf16_t*)(ws + OFF_AIQ); const bf16_t* aik = (const bf16_t*)(ws + OFF_AIK) + tb * 64; const float* aiw = (const float*)(ws + OFF_CTL + CTL_AIW);
  for (int r = 0; r < 2; ++r) {
    for (int hh = 0; hh < 2; ++hh) {
      const int qbase = c * 64 + half * 32 + r * 16 + hh * 8;
      bf16x8 a[2][2][2]; f32x4 w[2][2];
#pragma unroll
      for (int p = 0; p < 2; ++p) { const size_t tq = tb + qbase + 4 * p + (l15 >> 2); const int h = l15 & 3;
#pragma unroll
        for (int hg = 0; hg < 2; ++hg)
#pragma unroll
          for (int ks = 0; ks < 2; ++ks) a[p][hg][ks] = *reinterpret_cast<const bf16x8*>(aiq + tq * 512 + (h + 4 * hg) * 64 + 8 * G + 32 * ks);
        w[p][0] = *reinterpret_cast<const f32x4*>(aiw + (tb + qbase + 4 * p + G) * 8); w[p][1] = *reinterpret_cast<const f32x4*>(aiw + (tb + qbase + 4 * p + G) * 8 + 4); }
      bf16x8 cb[4][2], nb[4][2];
#define IDX_LOADB(dst, t0) do { _Pragma("unroll") for (int k_ = 0; k_ < 4; ++k_) { int tk_ = (t0) + 8 * k_; tk_ = tk_ < nt16 ? tk_ : nt16 - 1; \
        const bf16_t* kp_ = aik + (size_t)(tk_ * 16 + l15) * 64 + 8 * G; dst[k_][0] = *reinterpret_cast<const bf16x8*>(kp_); dst[k_][1] = *reinterpret_cast<const bf16x8*>(kp_ + 32); } } while (0)
      IDX_LOADB(cb, wid);
      for (int t0 = wid; t0 < nt16; t0 += 32) {
        IDX_LOADB(nb, t0 + 32);
#pragma unroll
        for (int k = 0; k < 4; ++k) { const int tk = t0 + 8 * k;
          if (tk < nt16) {
#pragma unroll
            for (int p = 0; p < 2; ++p) {
              f32x4 c0 = {0.f, 0.f, 0.f, 0.f}, c1 = {0.f, 0.f, 0.f, 0.f};
              c0 = __builtin_amdgcn_mfma_f32_16x16x32_bf16(a[p][0][0], cb[k][0], c0, 0, 0, 0); c0 = __builtin_amdgcn_mfma_f32_16x16x32_bf16(a[p][0][1], cb[k][1], c0, 0, 0, 0);
              c1 = __builtin_amdgcn_mfma_f32_16x16x32_bf16(a[p][1][0], cb[k][0], c1, 0, 0, 0); c1 = __builtin_amdgcn_mfma_f32_16x16x32_bf16(a[p][1][1], cb[k][1], c1, 0, 0, 0);
              float sv = 0.f;
#pragma unroll
              for (int j = 0; j < 4; ++j) { const float r0 = __builtin_amdgcn_fmed3f(c0[j], 0.f, __builtin_inff()), r1 = __builtin_amdgcn_fmed3f(c1[j], 0.f, __builtin_inff());
                sv = __builtin_fmaf(r0, w[p][0][j], sv); sv = __builtin_fmaf(r1, w[p][1][j], sv); }
              sc[(8 * hh + 4 * p + G) * 2048 + tk * 16 + l15] = sv; } } }
#pragma unroll
        for (int k = 0; k < 4; ++k) { cb[k][0] = nb[k][0]; cb[k][1] = nb[k][1]; }
      }
#undef IDX_LOADB
    }
    __syncthreads();
    unsigned key[2][32];
#pragma unroll
    for (int i = 0; i < 32; ++i) { const unsigned k0 = ordkey(sc[wid * 2048 + i * 64 + lane]), k1 = ordkey(sc[(wid + 8) * 2048 + i * 64 + lane]);
      key[0][i] = i < nw ? k0 : 0u; key[1][i] = i < nw ? k1 : 0u; }
    asm volatile("s_waitcnt lgkmcnt(0)" ::: "memory");
    unsigned thr[2]; bool allsel[2];
    select2(key, nw, reinterpret_cast<unsigned*>(sc + wid * 2048), reinterpret_cast<unsigned*>(sc + (wid + 8) * 2048), lane, thr, allsel);
    const u64 w0 = mask_words(key[0], thr[0], allsel[0], lane), w1 = mask_words(key[1], thr[1], allsel[1], lane);
    if (lane < 32) { mrow[(size_t)(r * 16 + wid) * 32 + lane] = w0; mrow[(size_t)(r * 16 + wid + 8) * 32 + lane] = w1; }
    __syncthreads();
  }
}
}

#define XB_TMO      128
#define XB_XCNT(j)  (256  + 64 * (j))
#define XB_XSUB(j)  (1280 + 64 * (j))
#define XB_XGEN(j)  (2304 + 64 * (j))
#define XB_TOP      3328
#define XB_TOPGEN   3392
#define XCD_BAR_WORDS 3456
#define XB_SPIN_CAP (1u << 18)
#define LAS __attribute__((address_space(3)))

__device__ __forceinline__ unsigned xb_ld(unsigned* p)              { return __hip_atomic_load(p, __ATOMIC_RELAXED, __HIP_MEMORY_SCOPE_AGENT); }
__device__ __forceinline__ unsigned xb_add(unsigned* p, unsigned v) { return __hip_atomic_fetch_add(p, v, __ATOMIC_RELAXED, __HIP_MEMORY_SCOPE_AGENT); }
__device__ __forceinline__ unsigned xb_xcc_id() { return (unsigned)__builtin_amdgcn_s_getreg((3 << 11) | 20) & 0xFu; }
#define XB_SPIN(cond, bar) do { unsigned _sp = 0; while (cond) { __builtin_amdgcn_s_sleep(1); \
    if ((++_sp & 255u) == 0u) { if (xb_ld(&(bar)[XB_TMO])) break; if (_sp > XB_SPIN_CAP) { atomicAdd(&(bar)[XB_TMO], 1u); break; } } } } while (0)

struct XcdBarrier { unsigned* bar; unsigned x; volatile LAS unsigned* st; };

__device__ __forceinline__ XcdBarrier xcd_barrier_post(unsigned* bar, volatile LAS unsigned* st, int tid) {
    XcdBarrier b; b.bar = bar; b.x = xb_xcc_id(); b.st = st;
    if (tid == 0) (void)xb_add(&bar[XB_XCNT(b.x)], 1u);
    return b;
}
__device__ __forceinline__ void xcd_barrier_complete(unsigned* bar, unsigned x, unsigned& nloc, unsigned& nx) {
    const unsigned G = gridDim.x * gridDim.y * gridDim.z;
    unsigned sum, cnt, mine, sp = 0u;
    for (;;) {
        sum = 0u; cnt = 0u; mine = 0u;
#pragma unroll
        for (unsigned j = 0; j < 16; ++j) { const unsigned c = xb_ld(&bar[XB_XCNT(j)]); sum += c; cnt += (c > 0u) ? 1u : 0u; mine = (j == x) ? c : mine; }
        if (sum == G) break;
        __builtin_amdgcn_s_sleep(1);
        if ((++sp & 255u) == 0u) { if (xb_ld(&bar[XB_TMO])) break; if (sp > XB_SPIN_CAP) { atomicAdd(&bar[XB_TMO], 1u); break; } }
    }
    nloc = mine > 0u ? mine : 1u; nx = cnt > 0u ? cnt : 1u;
}
__device__ __forceinline__ void xcd_barrier(const XcdBarrier& b, int tid) {
    asm volatile("s_waitcnt vmcnt(0)" ::: "memory");
    __syncthreads();
    if (tid == 0) {
        unsigned* bar = b.bar;
        __builtin_amdgcn_s_waitcnt(0);
        unsigned nloc = b.st[0], nx = b.st[1];
        if (nloc == 0u) { xcd_barrier_complete(bar, b.x, nloc, nx); b.st[0] = nloc; b.st[1] = nx; }
        const unsigned old = xb_add(&bar[XB_XSUB(b.x)], 1u);
        const unsigned gen = old / nloc;
        if (old + 1u == (gen + 1u) * nloc) {
            __builtin_amdgcn_fence(__ATOMIC_RELEASE, "agent");
            asm volatile("s_waitcnt vmcnt(0)" ::: "memory");
            const unsigned og = xb_add(&bar[XB_TOP], 1u);
            const unsigned tg = og / nx;
            if (og + 1u == (tg + 1u) * nx) xb_add(&bar[XB_TOPGEN], 1u);
            else XB_SPIN(xb_ld(&bar[XB_TOPGEN]) == tg, bar);
            __builtin_amdgcn_fence(__ATOMIC_ACQUIRE, "agent");
            xb_add(&bar[XB_XGEN(b.x)], 1u);
            asm volatile("s_waitcnt vmcnt(0)" ::: "memory");
        } else {
            XB_SPIN(xb_ld(&bar[XB_XGEN(b.x)]) == gen, bar);
            __builtin_amdgcn_fence(__ATOMIC_ACQUIRE, "agent");
            asm volatile("s_waitcnt vmcnt(0)" ::: "memory");
        }
    }
    __syncthreads();
}

#ifndef RP_PREP
#define RP_PREP 1
#endif
#ifndef RP_P1
#define RP_P1 1
#endif
#ifndef RP_ATT
#define RP_ATT 1
#endif
#ifndef RP_MOE
#define RP_MOE 1
#endif
#ifndef RP_IDX
#define RP_IDX 1
#endif
#ifndef RP_RT
#define RP_RT 1
#endif
#ifndef RP_P4
#define RP_P4 1
#endif
#ifndef RP_UP
#define RP_UP 1
#endif
#ifndef RP_AIW
#define RP_AIW 1
#endif
#ifndef RP_BAR
#define RP_BAR 1
#endif
constexpr int NTHR = 512;
constexpr int LDS_BYTES = 163840;
constexpr int GEMM_LDS_OFF = 1024;
constexpr int XLDS_OFF = 1024 + 131072;
struct Args { const float* in[21]; float* x; unsigned char* ws; };

#define VB_LOOP2(NVB, BODY) do { for (int _i = blockIdx.x; _i < (NVB) / 4; _i += gridDim.x) { const int vb = 4 * _i + 2 * half; BODY; } } while (0)
#define VB_LOOP(NVB, BODY) do { for (int _i = blockIdx.x; _i < (NVB) / 2; _i += gridDim.x) { const int vb = 2 * _i + half; BODY; } } while (0)
#define ROW_LOOP(NROW, BODY) do { for (int row = blockIdx.x * 8 + wave; row < (NROW); row += gridDim.x * 8) { BODY; } } while (0)
#define ELEM_LOOP(N, BODY) do { for (int idx = blockIdx.x * NTHR + tid512; idx < (N); idx += gridDim.x * NTHR) { BODY; } } while (0)

#define AIN(k) as_global(a.in[k])
typedef const __attribute__((address_space(4))) Args* KArgs;
#define PH_BEGIN() KArgs ap_ = (KArgs)__builtin_amdgcn_kernarg_segment_ptr(); asm volatile("" : "+s"(ap_)); const __attribute__((address_space(4))) Args& a = *ap_; \
  int wv_ = wave_u; asm volatile("" : "+s"(wv_)); unsigned z_ = 0u; asm volatile("" : "+v"(z_)); int tid512 = wv_ * 64 + (int)__builtin_amdgcn_mbcnt_hi(~0u, __builtin_amdgcn_mbcnt_lo(~0u, z_)); asm volatile("" : "+v"(tid512)); \
  const int half = tid512 >> 8, tid = tid512 & 255, wave = tid512 >> 6, lane = tid512 & 63; (void)half; (void)tid; (void)wave; (void)lane; \
  size_t zo_ = 0; asm volatile("" : "+s"(zo_)); unsigned char* ws = as_global(a.ws) + zo_; float* x = as_global(a.x) + zo_; \
  char* sm = lds + 1024 + half * 36864; (void)sm; float* rstd = (float*)(ws + OFF_CTL + CTL_RSTD); (void)rstd;

__device__ __forceinline__ void prep_attn_weights(const __attribute__((address_space(4))) Args& a, unsigned char* ws, int l, int half, int tid, char* sm) {
  const float* g_attn = AIN(1) + l * 1024; const float* w_in = AIN(2) + (size_t)l * 1024 * NIN;
  { TrDesc d{w_in, nullptr, g_attn, (bf16_t*)(ws + OFF_WATT + WA_IN), NIN, 1024, NZP, 1}; VB_LOOP2(1664, b_transpose2(d, 0, 0, vb, tid, sm)); }
  { TrDesc d{AIN(4) + (size_t)l * 256 * 768, nullptr, AIN(3) + l * 256, (bf16_t*)(ws + OFF_WATT + WA_UQ), 768, 256, 768, 2}; VB_LOOP2(48, b_transpose2(d, 0, 0, vb, tid, sm)); }
  { TrDesc d{AIN(6) + (size_t)l * 128 * 1024, nullptr, AIN(5) + l * 128, (bf16_t*)(ws + OFF_WATT + WA_UKV), 1024, 128, 1024, 0, 256}; VB_LOOP2(32, b_transpose2(d, 0, 0, vb, tid, sm)); }
  { TrDesc d{AIN(8) + (size_t)l * 512 * 1024, nullptr, nullptr, (bf16_t*)(ws + OFF_WATT + WA_P), 1024, 512, 1024, 0}; VB_LOOP2(128, b_transpose2(d, 0, 0, vb, tid, sm)); }
  { TrDesc d{AIN(9) + (size_t)l * 512 * 1024, nullptr, nullptr, (bf16_t*)(ws + OFF_WATT + WA_P) + (size_t)1024 * 512, 1024, 512, 1024, 0}; VB_LOOP2(128, b_transpose2(d, 0, 0, vb, tid, sm)); }
  { TrDesc d{AIN(10) + (size_t)l * 512 * 1024, nullptr, nullptr, (bf16_t*)(ws + OFF_WATT + WA_P) + (size_t)2 * 1024 * 512, 1024, 512, 1024, 0}; VB_LOOP2(128, b_transpose2(d, 0, 0, vb, tid, sm)); }
  { TrDesc d{AIN(11) + (size_t)l * 1024 * 1024, nullptr, nullptr, (bf16_t*)(ws + OFF_WATT + WA_O), 1024, 1024, 1024, 0}; VB_LOOP2(256, b_transpose2(d, 0, 0, vb, tid, sm)); }
}

#define GRID_BAR() do { PH_BEGIN(); XcdBarrier bar_; bar_.bar = (unsigned*)(ws + OFF_CTL + CTL_BAR); bar_.x = xb_xcc_id(); bar_.st = (volatile LAS unsigned*)lds; xcd_barrier(bar_, tid512); } while (0)
template <int l>
__device__ __forceinline__ void layer_phases(const int wave_u, char* lds) {
#define PH_P1() { PH_BEGIN(); __syncthreads(); \
      { pg8::PlainOrder S{(const char*)(ws + OFF_XB), (const char*)(ws + OFF_WATT + WA_IN), 1024, 1024, T / 256, NZP / 256, (int)gridDim.x, (int)blockIdx.x, 16}; pg8::EpiIn E{ws}; \
        pg8::gemm_phase<pg8::EpiIn, pg8::PlainOrder, true, false, 1024, 1024, 1024>(tid512, (PG8_LAS unsigned char*)lds + GEMM_LDS_OFF, S, E); } }
    PH_P1();
#if RP_P1 > 1
    PH_P1();
#endif
#if RP_BAR > 1
    GRID_BAR(); GRID_BAR(); GRID_BAR(); GRID_BAR(); GRID_BAR(); GRID_BAR(); GRID_BAR(); GRID_BAR(); GRID_BAR(); GRID_BAR();
#endif
    GRID_BAR();
#define PH_UP() { PH_BEGIN(); __syncthreads(); pg8::UpOrder S{ws, (int)gridDim.x, (int)blockIdx.x}; pg8::EpiUpBoth E{ws}; \
      pg8::gemm_phase<pg8::EpiUpBoth, pg8::UpOrder, true, false, 384, 256, 256>(tid512, (PG8_LAS unsigned char*)lds + GEMM_LDS_OFF, S, E); }
    PH_UP();
#if RP_UP > 1
    PH_UP();
#endif
#define PH_IDX() { PH_BEGIN(); __syncthreads(); const int w = blockIdx.x, bb = w >> 5, i = w & 31;        \
      idx::indexer_unit(ws, tid512, lds + GEMM_LDS_OFF, bb, i, 0); idx::indexer_unit(ws, tid512, lds + GEMM_LDS_OFF, bb, 31 - i, 1); }
    PH_IDX();
#if RP_IDX > 1
    PH_IDX();
#endif
    GRID_BAR();
#define PH_ATT(dry) \
    { PH_BEGIN(); const int w = blockIdx.x, bb = w >> 5, i = w & 31; att::attn_unit<0>(ws, nullptr, tid512, lds + GEMM_LDS_OFF, bb, 0, i, dry); } \
    { PH_BEGIN(); const int w = blockIdx.x, bb = w >> 5, i = w & 31; att::attn_unit<1>(ws, nullptr, tid512, lds + GEMM_LDS_OFF, bb, i & 3, 7 - (i >> 2), dry); } \
    { PH_BEGIN(); const float* relb_ = AIN(7) + l * 4 * 257; const int w = blockIdx.x, bb = w >> 5, i = w & 31; att::attn_unit<2>(ws, relb_, tid512, lds + GEMM_LDS_OFF, bb, i & 3, i >> 2, dry); }
#if RP_ATT > 1
    PH_ATT(true);
#endif
    PH_ATT(false);
    GRID_BAR();
    { PH_BEGIN(); if (blockIdx.x == 0 && tid512 < 128) ((unsigned*)(ws + OFF_CTL + CTL_CNT))[tid512] = 0u; }
#define PH_P4()     { PH_BEGIN(); __syncthreads(); \
      pg8::ProjOrder S{ws, (int)gridDim.x, (int)blockIdx.x}; pg8::EpiProj E{ws}; \
      pg8::gemm_phase<pg8::EpiProj, pg8::ProjOrder, false, false, 512, 512, 512>(tid512, (PG8_LAS unsigned char*)lds + GEMM_LDS_OFF, S, E); }
    PH_P4();
#if RP_P4 > 1
    PH_P4();
#endif
    GRID_BAR();
    { PH_BEGIN(); __syncthreads();
      pg8::PlainOrder S{(const char*)(ws + OFF_MIX), (const char*)(ws + OFF_WATT + WA_O), 1024, 1024, T / 256, 4, (int)gridDim.x, (int)blockIdx.x, 16}; pg8::EpiOut E{l == 0 ? (const float*)AIN(0) : (const float*)x, x, (bf16_t*)(ws + OFF_XB)};
      pg8::gemm_phase<pg8::EpiOut, pg8::PlainOrder, false, false, 1024, 1024, 1024>(tid512, (PG8_LAS unsigned char*)lds + GEMM_LDS_OFF, S, E); }
    GRID_BAR();
#define PH_RT(DRY)     { PH_BEGIN(); const float* g_ = AIN(12) + l * 1024; const float* wg_ = AIN(13) + (size_t)l * 1024 * 4; const float* bg_ = AIN(14) + l * 4; const float* wr_ = AIN(15) + (size_t)l * 1024 * 32; const float* br_ = AIN(16) + l * 32; \
      __syncthreads(); float* wt_ = (float*)(lds + GEMM_LDS_OFF); router_stage(g_, wg_, wr_, wt_, tid512); __syncthreads(); \
      for (int t0 = blockIdx.x * 64; t0 < T; t0 += gridDim.x * 64) \
        router_mfma((const float*)x, wt_, lds + GEMM_LDS_OFF + ROUTER_LDS, bg_, br_, (int*)(ws + OFF_CTL + CTL_TOKE), (float*)(ws + OFF_CTL + CTL_TOKW), rstd, (unsigned*)(ws + OFF_CTL + CTL_CNT), (int*)(ws + OFF_LIST), t0 + (wave & 3) * 16, wave, lane, DRY); \
      __syncthreads(); }
#if RP_RT > 1
    PH_RT(true);
#endif
    PH_RT(false);
#if RP_PREP > 1
    { PH_BEGIN();
      { TrDesc d{AIN(17) + (size_t)l * 32 * 1024 * 256, AIN(18) + (size_t)l * 32 * 1024 * 256, AIN(12) + l * 1024, (bf16_t*)(ws + OFF_WGU), 256, 1024, 512, 3};
        VB_LOOP2(128 * 32, b_transpose2(d, (size_t)1024 * 256, (size_t)512 * 1024, vb, tid, sm)); }
      { TrDesc d{AIN(19) + (size_t)l * 32 * 256 * 1024, nullptr, nullptr, (bf16_t*)(ws + OFF_WD), 1024, 256, 1024, 0};
        VB_LOOP2(64 * 32, b_transpose2(d, (size_t)256 * 1024, (size_t)1024 * 256, vb, tid, sm)); } }
#endif
    { PH_BEGIN();
      { TrDesc d{AIN(17) + (size_t)l * 32 * 1024 * 256, AIN(18) + (size_t)l * 32 * 1024 * 256, AIN(12) + l * 1024, (bf16_t*)(ws + OFF_WGU), 256, 1024, 512, 3};
        VB_LOOP2(128 * 32, b_transpose2(d, (size_t)1024 * 256, (size_t)512 * 1024, vb, tid, sm)); }
      { TrDesc d{AIN(19) + (size_t)l * 32 * 256 * 1024, nullptr, nullptr, (bf16_t*)(ws + OFF_WD), 1024, 256, 1024, 0};
        VB_LOOP2(64 * 32, b_transpose2(d, (size_t)256 * 1024, (size_t)1024 * 256, vb, tid, sm)); } }
    GRID_BAR();
#define MOE_TAB ((PG8_LAS unsigned*)((PG8_LAS unsigned char*)lds + XLDS_OFF))
#define PH_MOE_A() { PH_BEGIN(); __syncthreads(); pg8::moe_build_map((unsigned*)(ws + OFF_CTL + CTL_CNT), MOE_TAB, tid512); \
      pg8::MoeOrder<2, false> S{ws, (int)gridDim.x, (int)blockIdx.x, MOE_TAB, 0, 256}; pg8::EpiGU E{ws}; \
      pg8::gemm_phase<pg8::EpiGU, pg8::MoeOrder<2, false>, true, true, 1024, 1024, 1024>(tid512, (PG8_LAS unsigned char*)lds + GEMM_LDS_OFF, S, E, (PG8_LAS unsigned char*)lds + XLDS_OFF + 1024); }
#define PH_MOE_B() \
    { PH_BEGIN(); __syncthreads(); pg8::moe_build_map((unsigned*)(ws + OFF_CTL + CTL_CNT), MOE_TAB, tid512); \
      pg8::MoeOrder<2, false> S{ws, (int)gridDim.x, (int)blockIdx.x, MOE_TAB, 256, 1 << 30}; pg8::EpiGU E{ws}; \
      pg8::gemm_phase<pg8::EpiGU, pg8::MoeOrder<2, false>, true, true, 1024, 1024, 1024>(tid512, (PG8_LAS unsigned char*)lds + GEMM_LDS_OFF, S, E, (PG8_LAS unsigned char*)lds + XLDS_OFF + 1024); \
      const int nt_ = __builtin_amdgcn_readfirstlane((int)MOE_TAB[255]); const int L_ = 256 + (int)blockIdx.x;       \
      asm volatile("s_waitcnt vmcnt(0)" ::: "memory"); __syncthreads(); \
      if (L_ < 2 * nt_ && tid512 == 0) { __builtin_amdgcn_fence(__ATOMIC_RELEASE, "agent"); asm volatile("s_waitcnt vmcnt(0)" ::: "memory"); \
        __hip_atomic_fetch_add((unsigned*)(ws + OFF_CTL + CTL_CNT) + 64 + (L_ / 2 - 128), 1u, __ATOMIC_RELAXED, __HIP_MEMORY_SCOPE_AGENT); } } \
    { PH_BEGIN(); __syncthreads(); const int nt_ = __builtin_amdgcn_readfirstlane((int)MOE_TAB[255]); const int nx_ = 2 * nt_ > 256 ? 2 * nt_ - 256 : 0; \
      pg8::MoeOrder<4, true> S{ws, (int)gridDim.x - nx_, (int)blockIdx.x - nx_, MOE_TAB, 0, 512}; pg8::EpiDown E{ws}; \
      pg8::gemm_phase<pg8::EpiDown, pg8::MoeOrder<4, true>, true, false, 256, 256, 256>(tid512, (PG8_LAS unsigned char*)lds + GEMM_LDS_OFF, S, E); } \
    { PH_BEGIN(); __syncthreads(); const int nt_ = __builtin_amdgcn_readfirstlane((int)MOE_TAB[255]); const int L_ = 512 + (int)blockIdx.x; \
      if (L_ < 4 * nt_) { if (tid512 == 0) { unsigned* fl_ = (unsigned*)(ws + OFF_CTL + CTL_CNT) + 64 + (L_ / 4 - 128); unsigned sp_ = 0; \
          while (__hip_atomic_load(fl_, __ATOMIC_RELAXED, __HIP_MEMORY_SCOPE_AGENT) < 2u && ++sp_ < (1u << 22)) __builtin_amdgcn_s_sleep(1); \
          __builtin_amdgcn_fence(__ATOMIC_ACQUIRE, "agent"); asm volatile("s_waitcnt vmcnt(0)" ::: "memory"); } } \
      __syncthreads(); \
      pg8::MoeOrder<4, true> S{ws, (int)gridDim.x, (int)blockIdx.x, MOE_TAB, 512, 1 << 30}; pg8::EpiDown E{ws}; \
      pg8::gemm_phase<pg8::EpiDown, pg8::MoeOrder<4, true>, true, false, 256, 256, 256>(tid512, (PG8_LAS unsigned char*)lds + GEMM_LDS_OFF, S, E); }
#if RP_MOE > 1
    PH_MOE_A(); GRID_BAR();
#endif
    PH_MOE_A();
    GRID_BAR();
    PH_MOE_B();
    GRID_BAR();
    if (l == 0) { { PH_BEGIN(); ROW_LOOP(T, b_finalize<false>(x, ws, nullptr, row, lane)); } { PH_BEGIN(); prep_attn_weights(a, ws, 1, half, tid, sm); } if (RP_PREP > 1) { PH_BEGIN(); prep_attn_weights(a, ws, 1, half, tid, sm); } GRID_BAR(); }
    else { PH_BEGIN(); const float* gf_ = AIN(20); ROW_LOOP(T, b_finalize<true>(x, ws, gf_, row, lane)); }
}

__global__ void __launch_bounds__(NTHR, 2) mk_fwd(Args a_in) {
  extern __shared__ __attribute__((aligned(16))) char lds[];
  const int wave_u = __builtin_amdgcn_readfirstlane((int)threadIdx.x >> 6);
  { PH_BEGIN();
    if (tid512 == 0) { ((volatile LAS unsigned*)lds)[0] = 0u; ((volatile LAS unsigned*)lds)[1] = 0u; ((volatile LAS unsigned*)lds)[2] = 0u; ((volatile LAS unsigned*)lds)[3] = 0u; }
    __syncthreads();
    (void)xcd_barrier_post((unsigned*)(ws + OFF_CTL + CTL_BAR), (volatile LAS unsigned*)lds, tid512); }
  { PH_BEGIN(); ELEM_LOOP(2048 * 56, b_rope_tables((float*)(ws + OFF_CTL + CTL_ROPE), idx)); }
  { PH_BEGIN(); const float* xin = AIN(0); ROW_LOOP(T, b_x_init(xin, x, (bf16_t*)(ws + OFF_XB), rstd, row, lane)); }
  { PH_BEGIN(); prep_attn_weights(a, ws, 0, half, tid, sm); }
  if (RP_PREP > 1) { PH_BEGIN(); prep_attn_weights(a, ws, 0, half, tid, sm); }
  GRID_BAR();
  layer_phases<0>(wave_u, lds);
  layer_phases<1>(wave_u, lds);
}

extern "C" void kernel_launch(void* const* d_in, const int* in_sizes, int n_in, void* d_out, int out_size, void* d_ws, size_t ws_size, hipStream_t stream) {
  if (ws_size < WS_END) { fprintf(stderr, "kernel_launch: workspace too small: %zu < %zu\n", ws_size, WS_END); return; }
  static int grid = 0;
  if (!grid) {
    int dev = 0, cus = 0, per_cu = 0;
    hipGetDevice(&dev);
    hipDeviceGetAttribute(&cus, hipDeviceAttributeMultiprocessorCount, dev);
    hipFuncSetAttribute((const void*)mk_fwd, hipFuncAttributeMaxDynamicSharedMemorySize, LDS_BYTES);
    hipOccupancyMaxActiveBlocksPerMultiprocessor(&per_cu, (const void*)mk_fwd, NTHR, LDS_BYTES);
    if (per_cu < 1) { fprintf(stderr, "kernel_launch: occupancy query says %d blocks per CU\n", per_cu); return; }
    if (cus < 256) { fprintf(stderr, "kernel_launch: this kernel is laid out for 256 workgroups, one per CU; the device reports %d CUs\n", cus); return; }
    grid = 256;
  }
  Args a{};
  for (int i = 0; i < 21; ++i) a.in[i] = (const float*)d_in[i];
  a.x = (float*)d_out; a.ws = (unsigned char*)d_ws;
  hipMemsetAsync((unsigned char*)d_ws + OFF_CTL + CTL_BAR, 0, XCD_BAR_WORDS * sizeof(unsigned), stream);
  hipLaunchKernelGGL(mk_fwd, dim3(grid), dim3(NTHR), LDS_BYTES, stream, a);
}
```

```cpp
#include <hip/hip_runtime.h>
#include <hip/hip_bf16.h>
#include <cstdint>
#include <cstdio>

typedef unsigned short bf16_t;
typedef unsigned long long u64;

constexpr int T = 16384, DM = 1024, SEQ = 2048, NB = 8;
constexpr int NIN = 6408, NZ = 6400, NZP = 6656;
constexpr float EPS = 1e-6f;

constexpr size_t MiB = (size_t)1 << 20;
constexpr size_t OFF_CTL = 0;
constexpr size_t OFF_WATT = 4 * MiB;
constexpr size_t OFF_XB = 23 * MiB;
constexpr size_t OFF_AQ = 55 * MiB;
constexpr size_t OFF_CQ = 71 * MiB;
constexpr size_t OFF_QB = 87 * MiB;
constexpr size_t OFF_ZA = 111 * MiB;
constexpr size_t OFF_AK = OFF_ZA;
constexpr size_t OFF_AV = OFF_AK + 4 * MiB;
constexpr size_t OFF_AIQ = OFF_AV + 4 * MiB;
constexpr size_t OFF_AIK = OFF_AIQ + 16 * MiB;
constexpr size_t OFF_BKR = OFF_AIK + 2 * MiB;
constexpr size_t OFF_BCKV = OFF_BKR + 2 * MiB;
constexpr size_t OFF_BCQ = OFF_BCKV + 4 * MiB;
constexpr size_t OFF_BC = OFF_BCKV;
constexpr size_t OFF_CK = OFF_BCQ + 8 * MiB;
constexpr size_t OFF_CV = OFF_CK + 16 * MiB;
constexpr size_t OFF_KVB = 183 * MiB;
constexpr size_t OFF_MASK = 215 * MiB;
constexpr size_t OFF_G = 219 * MiB;
constexpr size_t OFF_AIWB = 315 * MiB;
constexpr size_t WS_END = 323 * MiB;
constexpr size_t OFF_MIX = OFF_KVB;
constexpr size_t OFF_WMOE = OFF_ZA;
constexpr size_t OFF_WGU = OFF_WMOE;
constexpr size_t OFF_WD = OFF_WMOE + 32 * MiB;
constexpr size_t OFF_Y = OFF_G;
constexpr size_t OFF_LIST = OFF_MASK;
constexpr size_t OFF_H = OFF_AQ;
constexpr size_t CTL_BAR = 0;
constexpr size_t CTL_CNT = 16 * 1024;
constexpr size_t CTL_ROPE = 64 * 1024;
constexpr size_t CTL_RSTD = 1 * MiB;
constexpr size_t CTL_RSTDQ = CTL_RSTD + 64 * 1024;
constexpr size_t CTL_RSTDKV = CTL_RSTDQ + 64 * 1024;
constexpr size_t CTL_AIW = CTL_RSTDKV + 64 * 1024;
constexpr size_t CTL_SSQ = 2 * MiB;
constexpr size_t CTL_SSQQ = CTL_SSQ;
constexpr size_t CTL_SSQKV = CTL_SSQ + 512 * 1024;
constexpr size_t CTL_TOKE = 3 * MiB;
constexpr size_t CTL_TOKW = CTL_TOKE + 128 * 1024;
constexpr size_t CTL_WIW = 3 * MiB + 512 * 1024;
constexpr size_t WA_IN = 0;
constexpr size_t WA_UQ = 13 * MiB;
constexpr size_t WA_UKV = WA_UQ + 512 * 1024;
constexpr size_t WA_P = 14 * MiB;
constexpr size_t WA_O = 17 * MiB;
constexpr int RT_COSA = 0, RT_SINA = 2048 * 16, RT_COSI = 2048 * 32, RT_SINI = 2048 * 40, RT_COSB = 2048 * 48, RT_SINB = 2048 * 80;

template <class Tp> __device__ __forceinline__ Tp* as_global(Tp* p) { return (Tp*)(__attribute__((address_space(1))) Tp*)p; }
__device__ __forceinline__ float bf2f(bf16_t v) { return __uint_as_float(((unsigned)v) << 16); }
__device__ __forceinline__ bf16_t f2bf(float f) { unsigned u = __float_as_uint(f); return (bf16_t)((u + 0x7fffu + ((u >> 16) & 1u)) >> 16); }
__device__ __forceinline__ float shx(float v, int m, int lane) { return __int_as_float(__builtin_amdgcn_ds_bpermute((lane ^ m) << 2, __float_as_int(v))); }
__device__ __forceinline__ float wave_sum(float v, int lane) {
  v += shx(v, 32, lane); v += shx(v, 16, lane); v += shx(v, 8, lane); v += shx(v, 4, lane); v += shx(v, 2, lane); v += shx(v, 1, lane); return v;
}
__host__ __device__ __forceinline__ int zmap(int c) {
  if (c < 1344) return c;
  if (c < 1408) { int n = c - 1344, g = n >> 5, r = n & 31; return 1736 + (r < 16 ? 16 * g + r : 32 + 16 * g + (r - 16)); }
  if (c < 1536) return 1608 + (c - 1408);
  if (c < 1792) return 1352 + (c - 1536);
  return c + 8;
}
__host__ __device__ __forceinline__ int uqmap(int c) {
  if (c < 512) { int h = c >> 7, d = c & 127; return h * 192 + d; }
  int n = c - 512, h = n >> 6, m = n & 63, g = m >> 5, r = m & 31;
  return h * 192 + 128 + (r < 16 ? 16 * g + r : 32 + 16 * g + (r - 16));
}
__host__ __device__ __forceinline__ int gumap(int n, int& isup) { int pn = n >> 8, j = n & 255; isup = j >= 128; return 128 * pn + (j & 127); }

struct TrDesc { const float* src; const float* src2; const float* scale; bf16_t* dst; int ld; int K; int N; int kind; int dp = 0; };
struct TrRegs { float4 v[4]; float sc[4]; };
__device__ __forceinline__ void tt_load(const TrDesc& d, int tn, int tk, int tid, TrRegs& R) {
  const int n0 = tn * 64, k0 = tk * 64;
  const int n4 = (tid & 15) * 4, kq = tid >> 4;
  const int n = n0 + n4;
  const float* s = d.src; int col; float cs = 1.f;
  if (d.kind == 0) col = n; else if (d.kind == 1) { if (n >= NZ) { col = n < NZ + 8 ? 1344 + (n - NZ) : 0; cs = n < NZ + 8 ? 0.35355339059327373f * 0.125f : 0.f; } else col = zmap(n); } else if (d.kind == 2) col = uqmap(n);
  else { int isup; col = gumap(n, isup); if (isup) s = d.src2; }
  const bool vec = ((((size_t)d.ld * 4) & 15) == 0) && ((col & 3) == 0);
#pragma unroll
  for (int i = 0; i < 4; ++i) { const int kk = kq + 16 * i; const float* p = s + (size_t)(k0 + kk) * d.ld + col;
    if (vec) R.v[i] = *(const float4*)p; else { R.v[i].x = p[0]; R.v[i].y = p[1]; R.v[i].z = p[2]; R.v[i].w = p[3]; }
    R.sc[i] = (d.scale ? d.scale[k0 + kk] : 1.f) * cs; }
}
__device__ __forceinline__ void tt_lds(const TrRegs& R, float (*tile)[65], int tid) {
  const int n4 = (tid & 15) * 4, kq = tid >> 4;
#pragma unroll
  for (int i = 0; i < 4; ++i) { const int kk = kq + 16 * i; const float sc = R.sc[i];
    tile[kk][n4] = R.v[i].x * sc; tile[kk][n4 + 1] = R.v[i].y * sc; tile[kk][n4 + 2] = R.v[i].z * sc; tile[kk][n4 + 3] = R.v[i].w * sc; }
}
__device__ __forceinline__ void tt_store(const TrDesc& d, int tn, int tk, float (*tile)[65], int tid) {
  const int n0 = tn * 64, k0 = tk * 64;
  const int dp = d.dp ? d.dp : d.K;
#pragma unroll
  for (int i = 0; i < 2; ++i) { const int e = tid + 256 * i, nn = e >> 3, k8 = (e & 7) * 8;
    uint4 w;
    w.x = (unsigned)f2bf(tile[k8 + 0][nn]) | ((unsigned)f2bf(tile[k8 + 1][nn]) << 16); w.y = (unsigned)f2bf(tile[k8 + 2][nn]) | ((unsigned)f2bf(tile[k8 + 3][nn]) << 16);
    w.z = (unsigned)f2bf(tile[k8 + 4][nn]) | ((unsigned)f2bf(tile[k8 + 5][nn]) << 16); w.w = (unsigned)f2bf(tile[k8 + 6][nn]) | ((unsigned)f2bf(tile[k8 + 7][nn]) << 16);
    *(uint4*)(d.dst + (size_t)(n0 + nn) * dp + k0 + k8) = w; }
}
__device__ __forceinline__ void b_transpose2(TrDesc d, size_t src_stride, size_t dst_stride, int vb, int tid, char* sm) {
  float (*tileA)[65] = (float (*)[65])sm; float (*tileB)[65] = (float (*)[65])(sm + 64 * 65 * 4);
  const int ntk = d.K / 64, per = (d.N / 64) * ntk;
  TrDesc da = d, db = d;
  { const int e = vb / per; da.src += (size_t)e * src_stride; if (da.src2) da.src2 += (size_t)e * src_stride; da.dst += (size_t)e * dst_stride; }
  { const int e = (vb + 1) / per; db.src += (size_t)e * src_stride; if (db.src2) db.src2 += (size_t)e * src_stride; db.dst += (size_t)e * dst_stride; }
  const int ta = vb % per, tb = (vb + 1) % per;
  TrRegs ra, rb; tt_load(da, ta / ntk, ta % ntk, tid, ra); tt_load(db, tb / ntk, tb % ntk, tid, rb);
  tt_lds(ra, tileA, tid); tt_lds(rb, tileB, tid);
  __syncthreads();
  tt_store(da, ta / ntk, ta % ntk, tileA, tid); tt_store(db, tb / ntk, tb % ntk, tileB, tid);
  __syncthreads();
}
__device__ __forceinline__ void b_rope_tables(float* rt, int i) {
  int pos = i / 56, j = i % 56; int rot, idx, oc, os;
  if (j < 16) { rot = 32; idx = j; oc = RT_COSA + pos * 16 + idx; os = RT_SINA + pos * 16 + idx; }
  else if (j < 24) { rot = 16; idx = j - 16; oc = RT_COSI + pos * 8 + idx; os = RT_SINI + pos * 8 + idx; }
  else { rot = 64; idx = j - 24; oc = RT_COSB + pos * 32 + idx; os = RT_SINB + pos * 32 + idx; }
  float inv = (float)pow(500000.0, -(double)(2 * idx) / (double)rot);
  float ang = (float)pos * inv;
  rt[oc] = (float)cos((double)ang); rt[os] = (float)sin((double)ang);
}
__device__ __forceinline__ void b_x_init(const float* xin, float* x, bf16_t* xb, float* rstd, int row, int lane) {
  const float4* s = (const float4*)(xin + (size_t)row * DM); float4* d = (float4*)(x + (size_t)row * DM);
  float ss = 0.f;
#pragma unroll
  for (int i = 0; i < 4; ++i) { float4 v = s[lane + 64 * i]; d[lane + 64 * i] = v; ss += v.x * v.x + v.y * v.y + v.z * v.z + v.w * v.w;
    bf16_t* o = xb + (size_t)row * DM + (lane + 64 * i) * 4; o[0] = f2bf(v.x); o[1] = f2bf(v.y); o[2] = f2bf(v.z); o[3] = f2bf(v.w); }
  ss = wave_sum(ss, lane);
  if (lane == 0) rstd[row] = rsqrtf(ss * (1.f / DM) + EPS);
}

constexpr int RT_P = 1028;
constexpr int ROUTER_LDS = 36 * RT_P * 4;
__device__ __forceinline__ void router_stage(const float* g, const float* wg, const float* wr, float* wt, int tid) {
  for (int i = tid; i < 1024 * 32; i += 512) { const int k = i >> 5, j = i & 31; wt[(4 + j) * RT_P + k] = g[k] * wr[i]; }
  for (int i = tid; i < 1024 * 4; i += 512) { const int k = i >> 2, j = i & 3; wt[j * RT_P + k] = g[k] * wg[i]; }
}
__device__ __forceinline__ void router_select(const float (&acc)[36], const float rs, const float* bg, const float* br, int t, int* toke, float* tokw, float* rstd_out, unsigned* cnt, int* list, bool dry) {
  float lg[4]; float mx = -INFINITY;
#pragma unroll
  for (int j = 0; j < 4; ++j) { lg[j] = acc[j] * rs + bg[j]; mx = fmaxf(mx, lg[j]); }
  float sm = 0.f, best = -1.f; int gs = 0;
#pragma unroll
  for (int j = 0; j < 4; ++j) { const float p = __expf(lg[j] - mx); sm += p; if (p > best) { best = p; gs = j; } }
  const float pg = best / sm;
  const float m0 = gs == 0 ? 1.f : 0.f, m1 = gs == 1 ? 1.f : 0.f, m2 = gs == 2 ? 1.f : 0.f, m3 = gs == 3 ? 1.f : 0.f;
  float e[8]; float emx = -INFINITY;
#pragma unroll
  for (int j = 0; j < 8; ++j) { e[j] = ((acc[4 + j] * m0 + acc[12 + j] * m1) + (acc[20 + j] * m2 + acc[28 + j] * m3)) * rs + br[gs * 8 + j]; emx = fmaxf(emx, e[j]); }
  float es = 0.f, b0 = -1.f, b1 = -1.f; int i0 = 0, i1 = 0;
#pragma unroll
  for (int j = 0; j < 8; ++j) { const float p = __expf(e[j] - emx); es += p;
    if (p > b0) { b1 = b0; i1 = i0; b0 = p; i0 = j; } else if (p > b1) { b1 = p; i1 = j; } }
  const float p0 = b0 / es, p1 = b1 / es, ps = p0 + p1;
  const int e0 = gs * 8 + i0, e1 = gs * 8 + i1;
  if (dry) { asm volatile("" :: "v"(p0 + ps), "v"(e0 + e1)); return; }
  rstd_out[t] = rs;
  toke[t * 2] = e0; toke[t * 2 + 1] = e1; tokw[t * 2] = pg * p0 / ps; tokw[t * 2 + 1] = pg * p1 / ps;
  const unsigned s0 = atomicAdd(cnt + e0, 1u), s1 = atomicAdd(cnt + e1, 1u);
  list[(size_t)e0 * T + s0] = t * 2; list[(size_t)e1 * T + s1] = t * 2 + 1;
}
__device__ __forceinline__ void router_mfma(const float* x, const float* wt, char* scr  , const float* bg, const float* br, int* toke, float* tokw, float* rstd_out,
                                            unsigned* cnt, int* list, const int t0  , const int wave, const int lane, const bool dry) {
  typedef float f4 __attribute__((ext_vector_type(4)));
  const int i = lane & 15, g = lane >> 4, wp = wave & 3, kh = wave >> 2;
  const float* xr = x + (size_t)(t0 + i) * DM + kh * 512 + 4 * g;
  const float* w0 = wt + (size_t)i * RT_P + kh * 512 + 4 * g; const float* w1 = w0 + 16 * RT_P; const float* w2 = wt + (size_t)(32 + (i < 4 ? i : 3)) * RT_P + kh * 512 + 4 * g;
  f4 c0 = {0.f, 0.f, 0.f, 0.f}, c1 = c0, c2 = c0; float ssl = 0.f;
#pragma unroll 4
  for (int s = 0; s < 32; ++s) {
    const f4 xa = *(const f4*)(xr + 16 * s), b0 = *(const f4*)(w0 + 16 * s), b1 = *(const f4*)(w1 + 16 * s), b2 = *(const f4*)(w2 + 16 * s);
    ssl += (xa[0] * xa[0] + xa[1] * xa[1]) + (xa[2] * xa[2] + xa[3] * xa[3]);
#pragma unroll
    for (int e = 0; e < 4; ++e) { c0 = __builtin_amdgcn_mfma_f32_16x16x4f32(xa[e], b0[e], c0, 0, 0, 0); c1 = __builtin_amdgcn_mfma_f32_16x16x4f32(xa[e], b1[e], c1, 0, 0, 0); c2 = __builtin_amdgcn_mfma_f32_16x16x4f32(xa[e], b2[e], c2, 0, 0, 0); }
  }
  float* part = (float*)scr + (size_t)(wp * 64 + lane) * 12; float* pss = (float*)(scr + 4 * 3072) + wp * 64 + lane;
  if (kh == 1) { *(f4*)part = c0; *(f4*)(part + 4) = c1; *(f4*)(part + 8) = c2; *pss = ssl; }
  __syncthreads();
  if (kh == 0) {
    c0 += *(const f4*)part; c1 += *(const f4*)(part + 4); c2 += *(const f4*)(part + 8); ssl += *pss;
    asm volatile("s_waitcnt lgkmcnt(0)" ::: "memory");
    ssl += shx(ssl, 16, lane); ssl += shx(ssl, 32, lane);
    float* lg = (float*)(scr + wp * 3072);
#pragma unroll
    for (int r = 0; r < 4; ++r) { lg[(4 * g + r) * 48 + i] = c0[r]; lg[(4 * g + r) * 48 + 16 + i] = c1[r]; lg[(4 * g + r) * 48 + 32 + i] = c2[r]; }
    asm volatile("s_waitcnt lgkmcnt(0)" ::: "memory");
    if (lane < 16) { float acc[36];
#pragma unroll
      for (int j = 0; j < 36; ++j) acc[j] = lg[lane * 48 + j];
      router_select(acc, rsqrtf(ssl * (1.f / DM) + EPS), bg, br, t0 + lane, toke, tokw, rstd_out, cnt, list, dry); }
  }
  __syncthreads();
}
template <bool LAST>
__device__ __forceinline__ void b_finalize(float* x, unsigned char* ws, const float* gf, int row, int lane) {
  float4* xr = (float4*)(x + (size_t)row * DM);
  const bf16_t* y0 = (const bf16_t*)(ws + OFF_Y) + (size_t)row * 2048; const bf16_t* y1 = y0 + 1024;
  float4 v[4]; float ss = 0.f;
#pragma unroll
  for (int i = 0; i < 4; ++i) { const int c4 = lane + 64 * i; float4 a = xr[c4];
    uint2 p0 = *(const uint2*)(y0 + c4 * 4), p1 = *(const uint2*)(y1 + c4 * 4);
    a.x += __uint_as_float(p0.x << 16) + __uint_as_float(p1.x << 16); a.y += __uint_as_float(p0.x & 0xffff0000u) + __uint_as_float(p1.x & 0xffff0000u);
    a.z += __uint_as_float(p0.y << 16) + __uint_as_float(p1.y << 16); a.w += __uint_as_float(p0.y & 0xffff0000u) + __uint_as_float(p1.y & 0xffff0000u);
    v[i] = a; ss += a.x * a.x + a.y * a.y + a.z * a.z + a.w * a.w; }
  ss = wave_sum(ss, lane);
  const float rs = rsqrtf(ss * (1.f / DM) + EPS);
#pragma unroll
  for (int i = 0; i < 4; ++i) { const int c4 = lane + 64 * i; float4 a = v[i];
    if (LAST) { float4 g = ((const float4*)gf)[c4]; a.x *= rs * g.x; a.y *= rs * g.y; a.z *= rs * g.z; a.w *= rs * g.w; xr[c4] = a; }
    else { xr[c4] = a; bf16_t* o = (bf16_t*)(ws + OFF_XB) + (size_t)row * DM + c4 * 4; o[0] = f2bf(a.x); o[1] = f2bf(a.y); o[2] = f2bf(a.z); o[3] = f2bf(a.w); } }
  if (!LAST && lane == 0) ((float*)(ws + OFF_CTL + CTL_RSTD))[row] = rs;
}


namespace pg8 {
#define PG8_LAS __attribute__((address_space(3)))
typedef short bf16x8 __attribute__((ext_vector_type(8)));
typedef float f32x4 __attribute__((ext_vector_type(4)));
typedef unsigned u32x4 __attribute__((ext_vector_type(4)));
constexpr int BM = 256, BK = 64, HALF = 128, HTB = HALF * BK * 2, STAGE_BYTES = 8 * HTB, NXCD = 8, WGM = 8;
__host__ __device__ __forceinline__ int lds_byte(int r, int c) { const int st = (r >> 4) * 2 + (c >> 5), rr = r & 15, cc = c & 31, ob = rr * 64 + cc * 2; return st * 1024 + (ob ^ (((ob >> 9) & 1) << 5)); }
__host__ __device__ __forceinline__ void stage_rc(int b, int& R, int& C) { const int st = b / 1024, sb = b % 1024, swz = sb ^ (((sb >> 9) & 1) << 5); R = (st >> 1) * 16 + swz / 64; C = (st & 1) * 32 + (swz % 64) / 2; }
__host__ __device__ __forceinline__ int perm32(int rho) { const int n = rho >> 4, i = rho & 15; return 8 * (i >> 2) + 4 * n + (i & 3); }
__device__ __forceinline__ unsigned cvt_pk_bf16(float lo, float hi) { unsigned r; asm volatile("v_cvt_pk_bf16_f32 %0, %1, %2" : "=v"(r) : "v"(lo), "v"(hi)); return r; }

struct Unit { int pm, pn; const char* A; const char* B; const int* rows; int aux; int nt; };

__device__ __forceinline__ bool static_tile(int i, int G, int c, int nM, int nN, int& pm, int& pn) {
  const int nwg = nM * nN; const long L = (long)i * G + c; if (L >= nwg) return false;
  int wgid = (int)L; { const int q = nwg / NXCD, r = nwg % NXCD, xcd = wgid % NXCD, off = wgid / NXCD; wgid = (xcd < r ? xcd * (q + 1) : r * (q + 1) + (xcd - r) * q) + off; }
  const int nig = WGM * nN, gid = wgid / nig, fm = gid * WGM, gsz = (nM - fm) < WGM ? (nM - fm) : WGM;
  pm = fm + ((wgid % nig) % gsz); pn = (wgid % nig) / gsz; return true;
}
struct PlainOrder {
  const char* A; const char* Bt; int lda, ldb, nM, nN, G, c, nt;
  __device__ __forceinline__ bool next(int i, Unit& u) const {
    if (!static_tile(i, G, c, nM, nN, u.pm, u.pn)) return false;
    u.A = A + (size_t)u.pm * BM * lda * 2; u.B = Bt + (size_t)u.pn * BM * ldb * 2; u.rows = nullptr; u.aux = 0; u.nt = nt; return true; }
};

template <class Epi, class Sched, bool ALIGN_EPI, bool GATHER, int lda, int ldb, int K>
__device__ __forceinline__ void gemm_phase(const int tid, PG8_LAS unsigned char* lds, const Sched& S, const Epi& E, PG8_LAS unsigned char* xlds = nullptr) {
    const int wid = __builtin_amdgcn_readfirstlane(tid >> 6), lane = tid & 63, wr = wid >> 2, wc = wid & 3, fr = lane & 15, fq = lane >> 4;
    unsigned voffA[2][2], voffB[2];
#pragma unroll
    for (int i = 0; i < 2; ++i) { int R, C; stage_rc(tid * 16 + i * 8192, R, C); const int Rb = (R & ~31) + perm32(R & 31);
        voffB[i] = (unsigned)(Rb * ldb + C) * 2u;
#pragma unroll
        for (int h = 0; h < 2; ++h) { voffA[h][i] = (unsigned)((R + (GATHER ? h * HALF : 0)) * lda + C) * 2u; } }
    const size_t hstepA = GATHER ? (size_t)0 : (size_t)HALF * lda * 2;
    const size_t kstep = (size_t)(BK * 2);
    const size_t hstepB = (size_t)HALF * ldb * 2;
    const unsigned ldsw = (unsigned)wid * 1024u;
    const int aoff = lds_byte(wr * 64 + fr, fq * 8), boff = lds_byte(wc * 32 + fr, fq * 8);
#define PG8_SA(b, h) (((b) * 2 + (h)) * HTB)
#define PG8_SB(b, h) ((4 + (b) * 2 + (h)) * HTB)
#define PG8_STAGE(bufoff, gbase, voff) do { _Pragma("unroll") for (int _i = 0; _i < 2; ++_i) \
        __builtin_amdgcn_global_load_lds((const unsigned*)((const char*)(gbase) + (voff)[_i]), (PG8_LAS unsigned*)(lds + (bufoff) + ldsw + _i * 8192), 16, 0, 0); } while (0)
#define PG8_LDA(dst, b, h) do { _Pragma("unroll") for (int m = 0; m < 4; ++m) _Pragma("unroll") for (int k = 0; k < 2; ++k) dst[m][k] = *(const PG8_LAS bf16x8*)(lds + PG8_SA(b, h) + aoff + m * 2048 + k * 1024); } while (0)
#define PG8_LDB(dst, b, h) do { _Pragma("unroll") for (int n = 0; n < 2; ++n) _Pragma("unroll") for (int k = 0; k < 2; ++k) dst[n][k] = *(const PG8_LAS bf16x8*)(lds + PG8_SB(b, h) + boff + n * 2048 + k * 1024); } while (0)
#define PG8_MMA(ai, bj, At, Bt) do { __builtin_amdgcn_s_setprio(1); _Pragma("unroll") for (int m = 0; m < 4; ++m) _Pragma("unroll") for (int n = 0; n < 2; ++n) _Pragma("unroll") for (int k = 0; k < 2; ++k) \
        acc[ai][bj][m][n] = __builtin_amdgcn_mfma_f32_16x16x32_bf16(Bt[n][k], At[m][k], acc[ai][bj][m][n], 0, 0, 0); __builtin_amdgcn_s_setprio(0); } while (0)
#define PG8_WAIT_V(n) asm volatile("s_waitcnt vmcnt(" #n ")" ::: "memory")
#define PG8_WAIT_L(n) asm volatile("s_waitcnt lgkmcnt(" #n ")" ::: "memory")
#define PG8_BAR __builtin_amdgcn_s_barrier()
#define PG8_SCHED __builtin_amdgcn_sched_barrier(0)
#define PG8_GATHER_OFFS(dst, u) do { if (GATHER) { _Pragma("unroll") for (int _i = 0; _i < 2; ++_i) { int _R, _C; stage_rc(tid * 16 + _i * 8192, _R, _C); \
        _Pragma("unroll") for (int _h = 0; _h < 2; ++_h) { const int _r = _h * HALF + _R; const int _e = _r < (u).aux ? ((u).rows[_r] >> 1) : 0; dst[_h][_i] = (unsigned)(_e * lda + _C) * 2u; } } } } while (0)
    Unit cur, nxt; int ui = 0;
    if (!S.next(0, cur)) return;
    PG8_GATHER_OFFS(voffA, cur);
    f32x4 acc[2][2][4][2];
#pragma unroll
    for (int a = 0; a < 2; ++a)
#pragma unroll
        for (int b = 0; b < 2; ++b)
#pragma unroll
            for (int m = 0; m < 4; ++m)
#pragma unroll
                for (int n = 0; n < 2; ++n) acc[a][b][m][n] = (f32x4){0.f, 0.f, 0.f, 0.f};
    bf16x8 At[4][2], B0[2][2], B1[2][2];
    const char* cA = cur.A; const char* cB = cur.B;
    PG8_STAGE(PG8_SB(0, 0), cB, voffB); PG8_STAGE(PG8_SB(0, 1), cB + hstepB, voffB); PG8_STAGE(PG8_SA(0, 0), cA, voffA[0]); PG8_STAGE(PG8_SA(0, 1), cA + hstepA, voffA[1]);
    if (wr == 1) PG8_BAR;
    PG8_WAIT_V(2); PG8_BAR;
    PG8_STAGE(PG8_SB(1, 0), cB + kstep, voffB); PG8_STAGE(PG8_SA(1, 0), cA + kstep, voffA[0]); PG8_STAGE(PG8_SB(1, 1), cB + hstepB + kstep, voffB);
    PG8_WAIT_V(6); PG8_BAR;
    for (;;) {
        const bool has_next = S.next(ui + 1, nxt);
        const char* nA = has_next ? nxt.A : cA; const char* nB = has_next ? nxt.B : cB;

        const int nt = cur.nt;
#pragma unroll 1
        for (int t = 0; t < nt; t += 2) {
            const bool last = (t == nt - 2);
            const char* a1 = cA + (size_t)(t + 1) * kstep;
            const char* a2 = last ? nA : cA + (size_t)(t + 2) * kstep; const char* b2 = last ? nB : cB + (size_t)(t + 2) * kstep;
            const char* a3 = a2 + kstep; const char* b3 = b2 + kstep;

            PG8_LDB(B0, 0, 0); PG8_LDB(B1, 0, 1); PG8_SCHED; PG8_LDA(At, 0, 0); PG8_STAGE(PG8_SA(1, 1), a1 + hstepA, voffA[1]);
            if (GATHER && last && has_next) PG8_GATHER_OFFS(voffA, nxt);
            PG8_WAIT_V(8); PG8_WAIT_L(0); PG8_BAR; PG8_MMA(0, 0, At, B0); PG8_MMA(0, 1, At, B1); PG8_BAR; PG8_SCHED;
            PG8_LDA(At, 0, 1); PG8_STAGE(PG8_SB(0, 0), b2, voffB); PG8_STAGE(PG8_SB(0, 1), b2 + hstepB, voffB); PG8_STAGE(PG8_SA(0, 0), a2, voffA[0]);
            PG8_WAIT_V(8); PG8_WAIT_L(0); PG8_BAR; PG8_MMA(1, 0, At, B0); PG8_MMA(1, 1, At, B1); PG8_BAR; PG8_SCHED;
            PG8_LDB(B0, 1, 0); PG8_LDB(B1, 1, 1); PG8_SCHED; PG8_LDA(At, 1, 0); PG8_STAGE(PG8_SA(0, 1), a2 + hstepA, voffA[1]);
            PG8_WAIT_V(8); PG8_WAIT_L(0); PG8_BAR; PG8_MMA(0, 0, At, B0); PG8_MMA(0, 1, At, B1); PG8_BAR; PG8_SCHED;
            PG8_LDA(At, 1, 1); PG8_STAGE(PG8_SB(1, 0), b3, voffB); PG8_STAGE(PG8_SB(1, 1), b3 + hstepB, voffB); PG8_STAGE(PG8_SA(1, 0), a3, voffA[0]);
            PG8_WAIT_V(8); PG8_WAIT_L(0); PG8_BAR; PG8_MMA(1, 0, At, B0); PG8_MMA(1, 1, At, B1); PG8_BAR; PG8_SCHED;
        }
        if constexpr (ALIGN_EPI) { if (wr == 0) PG8_BAR; }
        { int fr_e = fr, fq_e = fq; asm volatile("" : "+v"(fr_e), "+v"(fq_e)); E(acc, cur, wr, wc, fr_e, fq_e); }
        if (!has_next) break;
#pragma unroll
        for (int a = 0; a < 2; ++a)
#pragma unroll
            for (int b = 0; b < 2; ++b)
#pragma unroll
                for (int m = 0; m < 4; ++m)
#pragma unroll
                    for (int n = 0; n < 2; ++n) acc[a][b][m][n] = (f32x4){0.f, 0.f, 0.f, 0.f};
        cur = nxt; cA = nA; cB = nB; ++ui;

        if constexpr (ALIGN_EPI) { if (wr == 1) PG8_BAR; }
    }
    PG8_WAIT_V(0);
    if constexpr (!ALIGN_EPI) { if (wr == 0) PG8_BAR; }
    PG8_BAR;
#undef PG8_SA
#undef PG8_SB
#undef PG8_STAGE
#undef PG8_LDA
#undef PG8_LDB
#undef PG8_MMA
#undef PG8_WAIT_V
#undef PG8_WAIT_L
#undef PG8_BAR
#undef PG8_SCHED
#undef PG8_GATHER_OFFS
}

__device__ __forceinline__ u32x4 pack8(const f32x4 v0, const f32x4 v1) { u32x4 w; w.x = cvt_pk_bf16(v0[0], v0[1]); w.y = cvt_pk_bf16(v0[2], v0[3]); w.z = cvt_pk_bf16(v1[0], v1[1]); w.w = cvt_pk_bf16(v1[2], v1[3]); return w; }
__device__ __forceinline__ void unpack8v(const u32x4 w, f32x4& v0, f32x4& v1) {
  v0[0] = __uint_as_float(w.x << 16); v0[1] = __uint_as_float(w.x & 0xffff0000u); v0[2] = __uint_as_float(w.y << 16); v0[3] = __uint_as_float(w.y & 0xffff0000u);
  v1[0] = __uint_as_float(w.z << 16); v1[1] = __uint_as_float(w.z & 0xffff0000u); v1[2] = __uint_as_float(w.w << 16); v1[3] = __uint_as_float(w.w & 0xffff0000u); }

__device__ __forceinline__ void rope8(f32x4& v0, f32x4& v1, const float* ct, const float* st, int xorm, bool first, bool active, int lane) {
  f32x4 p0, p1;
#pragma unroll
  for (int j = 0; j < 4; ++j) { p0[j] = __int_as_float(__builtin_amdgcn_ds_bpermute((lane ^ xorm) << 2, __float_as_int(v0[j]))); p1[j] = __int_as_float(__builtin_amdgcn_ds_bpermute((lane ^ xorm) << 2, __float_as_int(v1[j]))); }
  const f32x4 c0 = *(const f32x4*)ct, c1 = *(const f32x4*)(ct + 4), s0 = *(const f32x4*)st, s1 = *(const f32x4*)(st + 4);
  const float sg = first ? -1.f : 1.f;
  const f32x4 n0 = v0 * c0 + (p0 * s0) * sg, n1 = v1 * c1 + (p1 * s1) * sg;
  if (active) { v0 = n0; v1 = n1; }
}
enum { K_PLAIN = 0, K_SIG, K_ROPE_A, K_ROPE_I, K_ROPE_B, K_SSQ };
struct EpiIn {
  unsigned char* ws;
  __device__ __forceinline__ void operator()(const f32x4 (&acc)[2][2][4][2], const Unit& u, int wr, int wc, int fr, int fq) const {
    const float* rstd = (const float*)(ws + OFF_CTL + CTL_RSTD); const float* rt = (const float*)(ws + OFF_CTL + CTL_ROPE);
    const int pn = u.pn, lane = fr + 16 * fq;
    float rsv[8];
#pragma unroll
    for (int k = 0; k < 8; ++k) rsv[k] = rstd[u.pm * BM + (k >> 2) * HALF + wr * 64 + (k & 3) * 16 + fr];
#pragma unroll
    for (int bj = 0; bj < 2; ++bj) {
      bf16_t* base; int pitch, lc, kind = K_PLAIN, rg = 0; float* ssq = nullptr;
      const int gc = bj * 128 + wc * 32;
      if (pn < 2) { base = (bf16_t*)(ws + OFF_AQ); pitch = 512; lc = pn * 256 + gc; if (wc == 0) kind = K_ROPE_A; }
      else if (pn == 2) { base = (bf16_t*)(ws + (bj == 0 ? OFF_AK : OFF_AV)); pitch = 128; lc = wc * 32; if (bj == 0 && wc == 0) kind = K_ROPE_A; }
      else if (pn < 5) { base = (bf16_t*)(ws + OFF_AIQ); pitch = 512; lc = (pn - 3) * 256 + gc; if ((wc & 1) == 0) kind = K_ROPE_I; }
      else if (pn == 5) { if (bj == 0) { if (wc < 2) { base = (bf16_t*)(ws + OFF_AIK); pitch = 64; lc = wc * 32; if (wc == 0) kind = K_ROPE_I; }
                                         else { base = (bf16_t*)(ws + OFF_BKR); pitch = 64; lc = (wc - 2) * 32; kind = K_ROPE_B; rg = wc - 2; } }
                          else { base = (bf16_t*)(ws + OFF_BC); pitch = 384; lc = 256 + wc * 32; kind = K_SSQ; ssq = (float*)(ws + OFF_CTL + CTL_SSQKV); } }
      else if (pn == 6) { base = (bf16_t*)(ws + OFF_BC); pitch = 384; lc = gc; kind = K_SSQ; ssq = (float*)(ws + OFF_CTL + CTL_SSQQ) + bj * 4 * T; }
      else if (pn < 9) { base = (bf16_t*)(ws + OFF_CQ); pitch = 512; lc = (pn - 7) * 256 + gc; }
      else if (pn < 11) { base = (bf16_t*)(ws + OFF_CK); pitch = 512; lc = (pn - 9) * 256 + gc; }
      else if (pn < 13) { base = (bf16_t*)(ws + OFF_CV); pitch = 512; lc = (pn - 11) * 256 + gc; }
      else if (pn < 25) { base = (bf16_t*)(ws + OFF_G); pitch = 3072; lc = (pn - 13) * 256 + gc; kind = K_SIG; }
      else { base = (bf16_t*)(ws + OFF_AIWB); pitch = 256; lc = gc; }
#pragma unroll
      for (int ai = 0; ai < 2; ++ai)
#pragma unroll
        for (int m = 0; m < 4; ++m) {
          const int row = u.pm * BM + ai * HALF + wr * 64 + m * 16 + fr; const float rs = rsv[ai * 4 + m]; const int pos = row & (SEQ - 1);
          f32x4 v0 = acc[ai][bj][m][0] * rs, v1 = acc[ai][bj][m][1] * rs;
          if (kind == K_SIG) {
#pragma unroll
            for (int j = 0; j < 4; ++j) { v0[j] = __builtin_amdgcn_rcpf(1.f + __expf(-v0[j])); v1[j] = __builtin_amdgcn_rcpf(1.f + __expf(-v1[j])); } }
          else if (kind == K_ROPE_A) rope8(v0, v1, rt + RT_COSA + pos * 16 + 8 * (fq & 1), rt + RT_SINA + pos * 16 + 8 * (fq & 1), 32, fq < 2, true, lane);
          else if (kind == K_ROPE_I) rope8(v0, v1, rt + RT_COSI + pos * 8, rt + RT_SINI + pos * 8, 16, fq == 0, fq < 2, lane);
          else if (kind == K_ROPE_B) rope8(v0, v1, rt + RT_COSB + pos * 32 + 16 * rg + 8 * (fq & 1), rt + RT_SINB + pos * 32 + 16 * rg + 8 * (fq & 1), 32, fq < 2, true, lane);
          else if (kind == K_SSQ) { float q = 0.f;
#pragma unroll
            for (int j = 0; j < 4; ++j) q += v0[j] * v0[j] + v1[j] * v1[j];
            q += __int_as_float(__builtin_amdgcn_ds_bpermute((lane ^ 16) << 2, __float_as_int(q))); q += __int_as_float(__builtin_amdgcn_ds_bpermute((lane ^ 32) << 2, __float_as_int(q)));
            if (fq == 0) ssq[(size_t)row * 4 + wc] = q; }
          *(u32x4*)(base + (size_t)row * pitch + lc + 8 * fq) = pack8(v0, v1);
        }
    }
  }
};
template <int NP, int W, bool ROPE>
struct EpiUp {
  unsigned char* ws; bf16_t* O; int pitch; const float* ssq;
  __device__ __forceinline__ void operator()(const f32x4 (&acc)[2][2][4][2], const Unit& u, int wr, int wc, int fr, int fq) const {
    const float* rt = (const float*)(ws + OFF_CTL + CTL_ROPE); const int lane = fr + 16 * fq;
#pragma unroll
    for (int ai = 0; ai < 2; ++ai) {
      float rsv[4];
#pragma unroll
      for (int k = 0; k < 4; ++k) { const int row = u.pm * BM + ai * HALF + wr * 64 + k * 16 + fr; float q = 0.f;
#pragma unroll
        for (int p = 0; p < NP; ++p) { const f32x4 s4 = *(const f32x4*)(ssq + (size_t)p * 4 * T + (size_t)row * 4); q += (s4[0] + s4[1]) + (s4[2] + s4[3]); }
        rsv[k] = rsqrtf(q * (1.f / W) + EPS); }
#pragma unroll
      for (int m = 0; m < 4; ++m) { const int row = u.pm * BM + ai * HALF + wr * 64 + m * 16 + fr; const int pos = row & (SEQ - 1);
        const float rs = rsv[m];
#pragma unroll
        for (int bj = 0; bj < 2; ++bj) { f32x4 v0 = acc[ai][bj][m][0] * rs, v1 = acc[ai][bj][m][1] * rs;
          if (ROPE && u.pn == 2) { const int rg = wc & 1; rope8(v0, v1, rt + RT_COSB + pos * 32 + 16 * rg + 8 * (fq & 1), rt + RT_SINB + pos * 32 + 16 * rg + 8 * (fq & 1), 32, fq < 2, true, lane); }
          *(u32x4*)(O + (size_t)row * pitch + u.pn * BM + bj * HALF + wc * 32 + 8 * fq) = pack8(v0, v1); } } }
  }
};
struct EpiProj {
  unsigned char* ws;
  __device__ __forceinline__ void operator()(const f32x4 (&acc)[2][2][4][2], const Unit& u, int wr, int wc, int fr, int fq) const {
    const int b = u.aux;
#pragma unroll
    for (int ai = 0; ai < 2; ++ai)
#pragma unroll
    for (int mh = 0; mh < 2; ++mh) {
      u32x4 gw[2][2], mw[2][2];
#pragma unroll
      for (int m2 = 0; m2 < 2; ++m2) { const int m = mh * 2 + m2, row = u.pm * BM + ai * HALF + wr * 64 + m * 16 + fr;
#pragma unroll
        for (int bj = 0; bj < 2; ++bj) { const int col = u.pn * BM + bj * HALF + wc * 32 + 8 * fq;
          gw[m2][bj] = *(const u32x4*)((const bf16_t*)(ws + OFF_G) + (size_t)row * 3072 + b * 1024 + col);
          if (b > 0) mw[m2][bj] = *(const u32x4*)((const bf16_t*)(ws + OFF_MIX) + (size_t)row * 1024 + col); } }
#pragma unroll
      for (int m2 = 0; m2 < 2; ++m2) { const int m = mh * 2 + m2, row = u.pm * BM + ai * HALF + wr * 64 + m * 16 + fr;
#pragma unroll
        for (int bj = 0; bj < 2; ++bj) { const int col = u.pn * BM + bj * HALF + wc * 32 + 8 * fq;
          f32x4 g0, g1; unpack8v(gw[m2][bj], g0, g1);
          f32x4 r0 = g0 * acc[ai][bj][m][0], r1 = g1 * acc[ai][bj][m][1];
          if (b > 0) { f32x4 o0, o1; unpack8v(mw[m2][bj], o0, o1); r0 += o0; r1 += o1; }
          *(u32x4*)((bf16_t*)(ws + OFF_MIX) + (size_t)row * 1024 + col) = pack8(r0, r1); } }
    }
  }
};
struct EpiOut {
  float* x; bf16_t* xb;
  __device__ __forceinline__ void operator()(const f32x4 (&acc)[2][2][4][2], const Unit& u, int wr, int wc, int fr, int fq) const {
#pragma unroll
    for (int ai = 0; ai < 2; ++ai)
#pragma unroll
    for (int mh = 0; mh < 2; ++mh) {
      f32x4 xv[2][2][2];
#pragma unroll
      for (int m2 = 0; m2 < 2; ++m2) { const int m = mh * 2 + m2, row = u.pm * BM + ai * HALF + wr * 64 + m * 16 + fr;
#pragma unroll
        for (int bj = 0; bj < 2; ++bj) { const size_t off = (size_t)row * DM + u.pn * BM + bj * HALF + wc * 32 + 8 * fq; xv[m2][bj][0] = *(const f32x4*)(x + off); xv[m2][bj][1] = *(const f32x4*)(x + off + 4); } }
#pragma unroll
      for (int m2 = 0; m2 < 2; ++m2) { const int m = mh * 2 + m2, row = u.pm * BM + ai * HALF + wr * 64 + m * 16 + fr;
#pragma unroll
        for (int bj = 0; bj < 2; ++bj) { const size_t off = (size_t)row * DM + u.pn * BM + bj * HALF + wc * 32 + 8 * fq;
          const f32x4 a0 = xv[m2][bj][0] + acc[ai][bj][m][0], a1 = xv[m2][bj][1] + acc[ai][bj][m][1];
          *(f32x4*)(x + off) = a0; *(f32x4*)(x + off + 4) = a1; *(u32x4*)(xb + off) = pack8(a0, a1); } }
    }
  }
};
struct EpiUpBoth {
  unsigned char* ws;
  __device__ __forceinline__ void operator()(const f32x4 (&acc)[2][2][4][2], const Unit& u, int wr, int wc, int fr, int fq) const {
    if (u.aux == 0) { EpiUp<2, 256, true> e{ws, (bf16_t*)(ws + OFF_QB), 768, (const float*)(ws + OFF_CTL + CTL_SSQQ)}; e(acc, u, wr, wc, fr, fq); }
    else { EpiUp<1, 128, false> e{ws, (bf16_t*)(ws + OFF_KVB), 1024, (const float*)(ws + OFF_CTL + CTL_SSQKV)}; e(acc, u, wr, wc, fr, fq); }
  }
};
struct UpOrder {
  unsigned char* ws; int G, c;
  __device__ __forceinline__ bool next(int i, Unit& u) const {
    const int L = i * G + c; if (L >= 448) return false;
    u.rows = nullptr;
    if (L < 192) { u.pm = L / 3; u.pn = L % 3; u.aux = 0; u.nt = 4; u.A = (const char*)(ws + OFF_BC) + (size_t)u.pm * BM * 384 * 2; u.B = (const char*)(ws + OFF_WATT + WA_UQ) + (size_t)u.pn * BM * 256 * 2; }
    else { const int k = L - 192; u.pm = k >> 2; u.pn = k & 3; u.aux = 1; u.nt = 2; u.A = (const char*)(ws + OFF_BC) + (size_t)u.pm * BM * 384 * 2 + 512; u.B = (const char*)(ws + OFF_WATT + WA_UKV) + (size_t)u.pn * BM * 256 * 2; }
    return true; }
};
struct ProjOrder {
  unsigned char* ws; int G, c;
  __device__ __forceinline__ bool next(int i, Unit& u) const {
    const int b = i % 3; if (!static_tile(i / 3, G, c, T / BM, 4, u.pm, u.pn)) return false;
    const size_t oa = b == 0 ? OFF_AQ : b == 1 ? OFF_AIQ : OFF_CQ;
    u.A = (const char*)(ws + oa) + (size_t)u.pm * BM * 512 * 2; u.B = (const char*)(ws + OFF_WATT + WA_P) + ((size_t)b * 1024 + (size_t)u.pn * BM) * 512 * 2; u.rows = nullptr; u.aux = b; u.nt = 8; return true; }
};

__device__ __forceinline__ void moe_build_map(unsigned* cntp, PG8_LAS unsigned* tab, int tid) {
  if (tid < 64) { const int lane = tid;
    const unsigned c = lane < 32 ? __hip_atomic_load(cntp + lane, __ATOMIC_RELAXED, __HIP_MEMORY_SCOPE_AGENT) : 0u;
    const unsigned nt = (c + 255u) >> 8; unsigned incl = nt;
#pragma unroll
    for (int o = 1; o < 32; o <<= 1) { const unsigned v = (unsigned)__builtin_amdgcn_ds_bpermute(((lane - o) & 63) << 2, (int)incl); if ((lane & 31) >= o) incl += v; }
    const unsigned start = incl - nt;
    if (lane < 32) for (unsigned j = 0; j < nt; ++j) { unsigned valid = c - j * 256u; valid = valid > 256u ? 256u : valid; tab[start + j] = (unsigned)lane | (j << 8) | (valid << 16); }
    if (lane == 31) tab[255] = incl; }
  __syncthreads();
}
template <int NPN, bool DOWN>
struct MoeOrder {
  unsigned char* ws; int G, c; const PG8_LAS unsigned* tab; int lo, hi;
  __device__ __forceinline__ bool next(int i, Unit& u) const {
    const int L = lo + i * G + c, tile = L / NPN, pn = L % NPN; const int total = __builtin_amdgcn_readfirstlane((int)tab[255]); if (c < 0 || L >= hi || tile >= total) return false;
    const unsigned rec = (unsigned)__builtin_amdgcn_readfirstlane((int)tab[tile]);
    const int e = rec & 255u, j = (rec >> 8) & 255u, valid = rec >> 16;
    u.pm = tile; u.pn = pn; u.aux = valid; u.nt = DOWN ? 4 : 16; u.rows = (const int*)(ws + OFF_LIST) + (size_t)e * T + j * 256;
    if (!DOWN) { u.A = (const char*)(ws + OFF_XB); u.B = (const char*)(ws + OFF_WGU) + ((size_t)e * 512 + (size_t)pn * 256) * 1024 * 2; }
    else { u.A = (const char*)(ws + OFF_H) + (size_t)tile * 256 * 256 * 2; u.B = (const char*)(ws + OFF_WD) + ((size_t)e * 1024 + (size_t)pn * 256) * 256 * 2; }
    return true; }
};
struct EpiGU {
  unsigned char* ws;
  __device__ __forceinline__ void operator()(const f32x4 (&acc)[2][2][4][2], const Unit& u, int wr, int wc, int fr, int fq) const {
    const float* rstd = (const float*)(ws + OFF_CTL + CTL_RSTD); const float* tokw = (const float*)(ws + OFF_CTL + CTL_TOKW);
    int ent[8]; float rs[8], wv[8];
#pragma unroll
    for (int k = 0; k < 8; ++k) { const int r = (k >> 2) * HALF + wr * 64 + (k & 3) * 16 + fr; ent[k] = u.rows[r < u.aux ? r : u.aux - 1]; }
#pragma unroll
    for (int k = 0; k < 8; ++k) { rs[k] = rstd[ent[k] >> 1]; wv[k] = tokw[ent[k]]; }
#pragma unroll
    for (int ai = 0; ai < 2; ++ai)
#pragma unroll
      for (int m = 0; m < 4; ++m) { const int r = ai * HALF + wr * 64 + m * 16 + fr; const int k = ai * 4 + m;
        { const float rsk = rs[k], w = wv[k];
          f32x4 h0, h1;
#pragma unroll
          for (int j = 0; j < 4; ++j) { const float a0 = acc[ai][0][m][0][j] * rsk, a1 = acc[ai][0][m][1][j] * rsk;
            h0[j] = a0 * __builtin_amdgcn_rcpf(1.f + __expf(-a0)) * (acc[ai][1][m][0][j] * rsk) * w; h1[j] = a1 * __builtin_amdgcn_rcpf(1.f + __expf(-a1)) * (acc[ai][1][m][1][j] * rsk) * w; }
          *(u32x4*)((bf16_t*)(ws + OFF_H) + ((size_t)u.pm * 256 + r) * 256 + u.pn * 128 + wc * 32 + 8 * fq) = pack8(h0, h1); } }
  }
};
struct EpiDown {
  unsigned char* ws;
  __device__ __forceinline__ void operator()(const f32x4 (&acc)[2][2][4][2], const Unit& u, int wr, int wc, int fr, int fq) const {
    int ent[8];
#pragma unroll
    for (int k = 0; k < 8; ++k) { const int r = (k >> 2) * HALF + wr * 64 + (k & 3) * 16 + fr; ent[k] = u.rows[r < u.aux ? r : u.aux - 1]; }
#pragma unroll
    for (int ai = 0; ai < 2; ++ai)
#pragma unroll
      for (int m = 0; m < 4; ++m) { const int r = ai * HALF + wr * 64 + m * 16 + fr;
        { const int entry = r < u.aux ? ent[ai * 4 + m] : 2 * T;
#pragma unroll
          for (int bj = 0; bj < 2; ++bj) *(u32x4*)((bf16_t*)(ws + OFF_Y) + (size_t)entry * 1024 + u.pn * BM + bj * HALF + wc * 32 + 8 * fq) = pack8(acc[ai][bj][m][0], acc[ai][bj][m][1]); } }
  }
};
}

namespace att {
using bf16x8 = __attribute__((ext_vector_type(8))) short;
using s16x4  = __attribute__((ext_vector_type(4))) short;
using f32x16 = __attribute__((ext_vector_type(16))) float;
using u32x4  = __attribute__((ext_vector_type(4))) unsigned;
constexpr int KVBLK = 64;
constexpr float THR = 8.f, NEG = -1e30f, M_INIT = -1e6f;
#define ASBAR() __builtin_amdgcn_sched_barrier(0)
__device__ __forceinline__ constexpr int crow_c(int r) { return (r & 3) + 8 * (r >> 2); }
__device__ __forceinline__ unsigned cvtpk(float lo, float hi) { unsigned r; asm volatile("v_cvt_pk_bf16_f32 %0, %1, %2" : "=v"(r) : "v"(lo), "v"(hi)); return r; }
template <int MODE> struct Cfg {
  static constexpr int DQK = MODE == 1 ? 192 : 128, ND0 = DQK / 16, KP = DQK * 2, SHM_K = 64 * KP;
  static constexpr float SCALE = MODE == 1 ? 0.07216878364870322f : 0.088388347648318440f;
};
template <int MODE>
__device__ __forceinline__ void partialSM(f32x16& p0, f32x16& p1, float& m_reg, float& mn, float& alpha) {
  constexpr float SC = Cfg<MODE>::SCALE, C = SC * 1.4426950408889634f;
#pragma unroll
  for (int r = 0; r < 16; ++r) { p0[r] *= C; p1[r] *= C; }
  float pmax = p0[0];
#pragma unroll
  for (int r = 1; r < 16; ++r) pmax = fmaxf(pmax, p0[r]);
#pragma unroll
  for (int r = 0; r < 16; ++r) pmax = fmaxf(pmax, p1[r]);
  { auto rr = __builtin_amdgcn_permlane32_swap(__float_as_uint(pmax), __float_as_uint(pmax), false, false);
    pmax = fmaxf(__uint_as_float(rr[0]), __uint_as_float(rr[1])); }
  if (__builtin_expect(__all(pmax - m_reg <= THR * 1.4426950408889634f), 1)) { mn = m_reg; alpha = 1.f; }
  else { mn = fmaxf(m_reg, pmax); alpha = __builtin_amdgcn_exp2f(m_reg - mn); m_reg = mn; }
#pragma unroll
  for (int r = 0; r < 16; ++r) { p0[r] -= mn; p1[r] -= mn; }
#pragma unroll
  for (int r = 0; r < 16; ++r) p0[r] = __builtin_amdgcn_exp2f(p0[r]);
}
__device__ __forceinline__ void finishSM(f32x16& p0, f32x16& p1, float alpha, float& l_reg, bf16x8& pa0, bf16x8& pa1, bf16x8& pa2, bf16x8& pa3) {
#pragma unroll
  for (int r = 0; r < 16; ++r) p1[r] = __builtin_amdgcn_exp2f(p1[r]);
  float ps = 0;
#pragma unroll
  for (int r = 0; r < 16; ++r) ps += p0[r];
#pragma unroll
  for (int r = 0; r < 16; ++r) ps += p1[r];
  { auto rr = __builtin_amdgcn_permlane32_swap(__float_as_uint(ps), __float_as_uint(ps), false, false);
    ps = __uint_as_float(rr[0]) + __uint_as_float(rr[1]); }
  l_reg = l_reg * alpha + ps;
#define PK4(P, BASE, OUT) do { unsigned a0 = cvtpk(P[BASE + 0], P[BASE + 1]), a1 = cvtpk(P[BASE + 2], P[BASE + 3]);   \
    unsigned b0 = cvtpk(P[BASE + 4], P[BASE + 5]), b1 = cvtpk(P[BASE + 6], P[BASE + 7]);                              \
    auto r0 = __builtin_amdgcn_permlane32_swap(a0, b0, false, false); auto r1 = __builtin_amdgcn_permlane32_swap(a1, b1, false, false); \
    u32x4 w = {r0[0], r1[0], r0[1], r1[1]}; OUT = *reinterpret_cast<bf16x8*>(&w); } while (0)
  PK4(p0, 0, pa0); PK4(p0, 8, pa1); PK4(p1, 0, pa2); PK4(p1, 8, pa3);
#undef PK4
}
#define KSWZ(row, colB, KP) ((row) * (KP) + ((colB) ^ (((row) & 7) << 4)))
template <int MODE>
__device__ __forceinline__ void qkt(f32x16& p0, f32x16& p1, const char* Ks, const bf16x8* qr, const char* qx  , int r32, int hi) {
  constexpr int KP = Cfg<MODE>::KP;
  p0 = f32x16{}; p1 = f32x16{};
#pragma unroll
  for (int d0 = 0; d0 < Cfg<MODE>::ND0; ++d0) { const int cb = (d0 * 16 + hi * 8) * 2;
    bf16x8 b0 = *reinterpret_cast<const bf16x8*>(Ks + KSWZ(r32, cb, KP));
    bf16x8 b1 = *reinterpret_cast<const bf16x8*>(Ks + KSWZ(32 + r32, cb, KP));
    const bf16x8 q = d0 < 8 ? qr[d0 < 8 ? d0 : 0] : *reinterpret_cast<const bf16x8*>(qx + (d0 - 8) * 32);
    p0 = __builtin_amdgcn_mfma_f32_32x32x16_bf16(b0, q, p0, 0, 0, 0);
    p1 = __builtin_amdgcn_mfma_f32_32x32x16_bf16(b1, q, p1, 0, 0, 0); }
}
__device__ __forceinline__ int v_st(int k, int c) { const int kk = (k & ~0xC) | ((k & 4) << 1) | ((k & 8) >> 1); return ((kk >> 3) * 4 + (c >> 5)) * 512 + ((kk & 7) * 32 + (c & 31)) * 2; }
__device__ __forceinline__ int v_rd_base(int lane) { return ((lane & 3) << 3) | (((lane >> 2) & 3) << 6) | (((lane >> 4) & 1) << 5) | (((lane >> 5) & 1) << 8); }
constexpr int v_rd_off(int d0, int ks, int half) { return d0 * 512 + ks * 4096 + half * 2048; }
template <int OFF> __device__ __forceinline__ s16x4 tr_read(int vb) {
  s16x4 r; asm volatile("ds_read_b64_tr_b16 %0, %1 offset:%2" : "=&v"(r) : "v"(vb), "i"(OFF) : "memory"); return r;
}
template <int D0> __device__ __forceinline__ void pv_one(f32x16& od, int vb, bf16x8 pa0, bf16x8 pa1, bf16x8 pa2, bf16x8 pa3) {
  const s16x4 l0 = tr_read<v_rd_off(D0, 0, 0)>(vb), h0 = tr_read<v_rd_off(D0, 0, 1)>(vb), l1 = tr_read<v_rd_off(D0, 1, 0)>(vb), h1 = tr_read<v_rd_off(D0, 1, 1)>(vb);
  const s16x4 l2 = tr_read<v_rd_off(D0, 2, 0)>(vb), h2 = tr_read<v_rd_off(D0, 2, 1)>(vb), l3 = tr_read<v_rd_off(D0, 3, 0)>(vb), h3 = tr_read<v_rd_off(D0, 3, 1)>(vb);
  asm volatile("s_waitcnt lgkmcnt(0)" ::: "memory"); ASBAR();
#define PK(L, H) (bf16x8){L[0], L[1], L[2], L[3], H[0], H[1], H[2], H[3]}
  od = __builtin_amdgcn_mfma_f32_32x32x16_bf16(pa0, PK(l0, h0), od, 0, 0, 0);
  od = __builtin_amdgcn_mfma_f32_32x32x16_bf16(pa1, PK(l1, h1), od, 0, 0, 0);
  od = __builtin_amdgcn_mfma_f32_32x32x16_bf16(pa2, PK(l2, h2), od, 0, 0, 0);
  od = __builtin_amdgcn_mfma_f32_32x32x16_bf16(pa3, PK(l3, h3), od, 0, 0, 0);
#undef PK
}
__device__ __forceinline__ void pv_d0(f32x16* o, int vb, bf16x8 pa0, bf16x8 pa1, bf16x8 pa2, bf16x8 pa3) {
  pv_one<0>(o[0], vb, pa0, pa1, pa2, pa3); pv_one<1>(o[1], vb, pa0, pa1, pa2, pa3); pv_one<2>(o[2], vb, pa0, pa1, pa2, pa3); pv_one<3>(o[3], vb, pa0, pa1, pa2, pa3);
}
template <int MODE>
__device__ __forceinline__ void post_scores(f32x16& p0, f32x16& p1, int jt, int jlo_w, int jhi_w, int cw, const char* xl, int qloc, int hi) {
  if (MODE == 0) {
    const uint2 w = *reinterpret_cast<const uint2*>(xl + qloc * 264 + jt * 8);
    const unsigned wl = w.x >> (4 * hi), wh = w.y >> (4 * hi);
#pragma unroll
    for (int r = 0; r < 16; ++r) { const unsigned m0 = (unsigned)__builtin_amdgcn_sbfe((int)wl, crow_c(r), 1), m1 = (unsigned)__builtin_amdgcn_sbfe((int)wh, crow_c(r), 1);
      p0[r] = __uint_as_float((__float_as_uint(p0[r]) & m0) | (__float_as_uint(NEG) & ~m0)); p1[r] = __uint_as_float((__float_as_uint(p1[r]) & m1) | (__float_as_uint(NEG) & ~m1)); }
  } else {
    if (jt > jhi_w || jt < jlo_w) {
#pragma unroll
      for (int r = 0; r < 16; ++r) { p0[r] = NEG; p1[r] = NEG; }
    } else if (MODE == 2) {
      const float* tab = reinterpret_cast<const float*>(xl);
      const int dj = cw - jt;
      if (dj >= 3) { const float bf = tab[256];
#pragma unroll
        for (int r = 0; r < 16; ++r) { p0[r] += bf; p1[r] += bf; } }
      else { const int dbase = dj * 64 + qloc - 4 * hi;
#pragma unroll
        for (int r = 0; r < 16; ++r) { int d0 = dbase - crow_c(r), d1 = d0 - 32; d0 = d0 > 128 ? 128 : d0; d1 = d1 > 128 ? 128 : d1; p0[r] += tab[d0 + 128]; p1[r] += tab[d1 + 128]; } }
    }
  }
}
template <int MODE>
__device__ __forceinline__ void attn_unit(unsigned char* ws, const float* relb, const int tid, char* lds, const int b, const int hx, const int cg, const bool dry = false) {
  using C = Cfg<MODE>;
  constexpr int KP = C::KP, SHM_K = C::SHM_K, SHM_V = 16384, ND0 = C::ND0;
  const int wid = __builtin_amdgcn_readfirstlane(tid >> 6), lane = tid & 63, r32 = lane & 31, hi = lane >> 5;
  char* V_lds = lds; char* K_lds = lds + 2 * SHM_V;
  float* wsc = reinterpret_cast<float*>(lds + 2 * SHM_V + 2 * SHM_K) + wid * 64; float* li_l = wsc; float* al_l = wsc + 32;
  char* xl = lds + 2 * SHM_V + 2 * SHM_K + 2048;
  const size_t tb = (size_t)b * SEQ;
  const int cw = MODE == 0 ? cg : 4 * cg + (wid >> 1);
  const int qloc = (wid & 1) * 32 + r32;
  const size_t tok = tb + (size_t)cw * 64 + qloc;
  const int j0 = MODE == 2 ? (4 * cg - 8 > 0 ? 4 * cg - 8 : 0) : 0;
  const int NT = MODE == 0 ? ((cg + 2) & ~1) : (4 * cg + 4 - j0);
  const int jlo_w = MODE == 2 ? (cw - 8 > 0 ? cw - 8 : 0) : 0, jhi_w = cw;
  const bf16_t* Kh; const bf16_t* Vh; const bf16_t* Kr = nullptr; int LDK;
  if (MODE == 0) { Kh = (const bf16_t*)(ws + OFF_AK) + tb * 128; Vh = (const bf16_t*)(ws + OFF_AV) + tb * 128; LDK = 128; }
  else if (MODE == 1) { Kh = (const bf16_t*)(ws + OFF_KVB) + tb * 1024 + hx * 256; Vh = Kh + 128; Kr = (const bf16_t*)(ws + OFF_BKR) + tb * 64; LDK = 1024; }
  else { Kh = (const bf16_t*)(ws + OFF_CK) + tb * 512 + hx * 128; Vh = (const bf16_t*)(ws + OFF_CV) + tb * 512 + hx * 128; LDK = 512; }
  __syncthreads();
  if (MODE == 0) { const uint2* mb = (const uint2*)(ws + OFF_MASK) + (tb + (size_t)cg * 64) * 32;
    for (int i = tid; i < 64 * 32; i += 512) { const int q = i >> 5, j = i & 31; *reinterpret_cast<uint2*>(xl + q * 264 + j * 8) = mb[i]; } }
  if (MODE == 2) { for (int i = tid; i < 257; i += 512) reinterpret_cast<float*>(xl)[i] = relb[hx * 257 + i] * (1.f / C::SCALE); }
  float m_reg = M_INIT, l_reg = 0; f32x16 o[4] = {}; bf16x8 qr[8];
  const char* qx = xl + wid * 4608 + r32 * 144 + hi * 16;
  { const bf16_t* Qw;
    if (MODE == 0) Qw = (const bf16_t*)(ws + OFF_AQ) + tok * 512 + (wid >> 1) * 128 + hi * 8;
    else if (MODE == 1) Qw = (const bf16_t*)(ws + OFF_QB) + tok * 768 + hx * 128 + hi * 8;
    else Qw = (const bf16_t*)(ws + OFF_CQ) + tok * 512 + hx * 128 + hi * 8;
#pragma unroll
    for (int d0 = 0; d0 < 8; ++d0) qr[d0] = *reinterpret_cast<const bf16x8*>(Qw + d0 * 16);
    if (MODE == 1) { const bf16_t* Qr = (const bf16_t*)(ws + OFF_QB) + tok * 768 + 512 + hx * 64 + hi * 8;
#pragma unroll
      for (int d0 = 8; d0 < ND0; ++d0) *reinterpret_cast<bf16x8*>(const_cast<char*>(qx) + (d0 - 8) * 32) = *reinterpret_cast<const bf16x8*>(Qr + (d0 - 8) * 16); } }
  const int sr = tid >> 4, sc = (tid & 15) * 8, vst0 = v_st(sr, sc), vst1 = v_st(32 + sr, sc);
  const int vb0 = (int)(uintptr_t)V_lds + v_rd_base(lane);
  constexpr int NPI = SHM_K / 8192;
  unsigned koff[NPI], kstr[NPI];
#pragma unroll
  for (int i = 0; i < NPI; ++i) { const int L = (i * 8 + wid) * 1024 + lane * 16, row = L / KP, cs = L % KP, colB = cs ^ ((row & 7) << 4);
    if (MODE == 1 && colB >= 256) { koff[i] = (unsigned)(OFF_BKR + (tb + (size_t)j0 * 64 + row) * 128 + (colB - 256)); kstr[i] = 64 * 128; }
    else { koff[i] = (unsigned)((MODE == 0 ? OFF_AK : MODE == 1 ? OFF_KVB : OFF_CK) + (tb + (size_t)j0 * 64 + row) * (size_t)LDK * 2 + (MODE == 0 ? 0 : MODE == 1 ? hx * 512 : hx * 256) + colB); kstr[i] = 64 * LDK * 2; } }
  bf16x8 vs0, vs1;
#define SLOAD(jrel, bf) do { const int k0_ = kbase + (jrel) * KVBLK; \
    vs0 = *reinterpret_cast<const bf16x8*>(&Vh[(size_t)(k0_ + sr) * LDK + sc]); vs1 = *reinterpret_cast<const bf16x8*>(&Vh[(size_t)(k0_ + 32 + sr) * LDK + sc]); \
    _Pragma("unroll") for (int i_ = 0; i_ < NPI; ++i_) { __builtin_amdgcn_global_load_lds((const unsigned*)(ws + koff[i_]), \
        (__attribute__((address_space(3))) unsigned*)(K_lds + (bf) * SHM_K + (i_ * 8 + wid) * 1024), 16, 0, 0); koff[i_] += (MODE == 1 ? kstr[i_] : (unsigned)(64 * LDK * 2)); } } while (0)
#define SWRITE(bf) do { *reinterpret_cast<bf16x8*>(V_lds + (bf) * SHM_V + vst0) = vs0; *reinterpret_cast<bf16x8*>(V_lds + (bf) * SHM_V + vst1) = vs1; } while (0)
#define RESC(a) do { if (__any((a) < 1.f)) { if (hi == 0) al_l[r32] = (a); asm volatile("s_waitcnt lgkmcnt(0)" ::: "memory"); \
    _Pragma("unroll") for (int d = 0; d < 4; ++d) _Pragma("unroll") for (int r = 0; r < 16; ++r) o[d][r] *= al_l[crow_c(r) + 4 * hi]; } } while (0)
#define POST(P0, P1, jrel) post_scores<MODE>(P0, P1, j0 + (jrel), jlo_w, jhi_w, cw, xl, qloc, hi)
  const int kbase = j0 * KVBLK; (void)kbase;
  bf16x8 pa0, pa1, pa2, pa3;
  if (MODE != 2) {
    f32x16 p0, p1; float mn, al;
    SLOAD(0, 0); asm volatile("s_waitcnt vmcnt(0)" ::: "memory"); SWRITE(0); __syncthreads();
    for (int j = 0; j < NT; j += 2) {
      SLOAD(j + 1, 1); ASBAR();
      qkt<MODE>(p0, p1, K_lds, qr, qx, r32, hi); POST(p0, p1, j); partialSM<MODE>(p0, p1, m_reg, mn, al); RESC(al);
      finishSM(p0, p1, al, l_reg, pa0, pa1, pa2, pa3); ASBAR();
      pv_d0(o, vb0, pa0, pa1, pa2, pa3);
      asm volatile("s_waitcnt vmcnt(0)" ::: "memory"); SWRITE(1); __syncthreads();
      const bool more = j + 2 < NT;
      if (more) SLOAD(j + 2, 0);
      ASBAR();
      qkt<MODE>(p0, p1, K_lds + SHM_K, qr, qx, r32, hi); POST(p0, p1, j + 1); partialSM<MODE>(p0, p1, m_reg, mn, al); RESC(al);
      finishSM(p0, p1, al, l_reg, pa0, pa1, pa2, pa3); ASBAR();
      pv_d0(o, vb0 + SHM_V, pa0, pa1, pa2, pa3);
      asm volatile("s_waitcnt vmcnt(0)" ::: "memory"); if (more) SWRITE(0); __syncthreads();
    }
  } else {
    f32x16 pA0, pA1, pB0, pB1; float mnA, mnB, alA, alB;
    SLOAD(0, 0); asm volatile("s_waitcnt vmcnt(0)" ::: "memory"); SWRITE(0); __syncthreads();
    qkt<MODE>(pA0, pA1, K_lds, qr, qx, r32, hi); POST(pA0, pA1, 0); partialSM<MODE>(pA0, pA1, m_reg, mnA, alA);
    SLOAD(1, 1);
    asm volatile("s_waitcnt vmcnt(0)" ::: "memory"); SWRITE(1); __syncthreads();
    for (int j = 1; j + 1 < NT; j += 2) {
      ASBAR(); qkt<MODE>(pB0, pB1, K_lds + SHM_K, qr, qx, r32, hi); POST(pB0, pB1, j);
      finishSM(pA0, pA1, alA, l_reg, pa0, pa1, pa2, pa3); ASBAR();
      SLOAD(j + 1, 0); ASBAR();
      pv_d0(o, vb0, pa0, pa1, pa2, pa3); partialSM<MODE>(pB0, pB1, m_reg, mnB, alB);
      __syncthreads(); asm volatile("s_waitcnt vmcnt(0)" ::: "memory"); SWRITE(0);
      RESC(alB); __syncthreads();
      ASBAR(); qkt<MODE>(pA0, pA1, K_lds, qr, qx, r32, hi); POST(pA0, pA1, j + 1);
      finishSM(pB0, pB1, alB, l_reg, pa0, pa1, pa2, pa3); ASBAR();
      SLOAD(j + 2, 1); ASBAR();
      pv_d0(o, vb0 + SHM_V, pa0, pa1, pa2, pa3); partialSM<MODE>(pA0, pA1, m_reg, mnA, alA);
      __syncthreads(); asm volatile("s_waitcnt vmcnt(0)" ::: "memory"); SWRITE(1);
      RESC(alA); __syncthreads();
    }
    ASBAR(); qkt<MODE>(pB0, pB1, K_lds + SHM_K, qr, qx, r32, hi); POST(pB0, pB1, NT - 1);
    finishSM(pA0, pA1, alA, l_reg, pa0, pa1, pa2, pa3); ASBAR();
    pv_d0(o, vb0, pa0, pa1, pa2, pa3); partialSM<MODE>(pB0, pB1, m_reg, mnB, alB);
    __syncthreads(); RESC(alB);
    finishSM(pB0, pB1, alB, l_reg, pa0, pa1, pa2, pa3); ASBAR();
    pv_d0(o, vb0 + SHM_V, pa0, pa1, pa2, pa3);
  }
  int lane_e = lane; asm volatile("" : "+v"(lane_e));
  const int r32e = lane_e & 31, hie = lane_e >> 5;
  if (hi == 0) li_l[r32] = l_reg; asm volatile("s_waitcnt lgkmcnt(0)" ::: "memory");
  float rli[16];
#pragma unroll
  for (int r = 0; r < 16; ++r) rli[r] = __builtin_amdgcn_rcpf(li_l[crow_c(r) + 4 * hi]);
  __syncthreads();
  char* Ost = lds + wid * 8192;
#pragma unroll
  for (int r = 0; r < 16; ++r) { const int orow = crow_c(r) + 4 * hie;
#pragma unroll
    for (int d0 = 0; d0 < 4; ++d0) *reinterpret_cast<bf16_t*>(Ost + orow * 256 + (d0 * 32 + r32e) * 2) = f2bf(o[d0][r] * rli[r]); }
  asm volatile("s_waitcnt lgkmcnt(0)" ::: "memory");
  { bf16_t* Ob; int ldo;
    const size_t tok0 = tb + (size_t)cw * 64 + (wid & 1) * 32;
    if (MODE == 0) { Ob = (bf16_t*)(ws + OFF_AQ) + tok0 * 512 + (wid >> 1) * 128; ldo = 512; }
    else if (MODE == 1) { Ob = (bf16_t*)(ws + OFF_AIQ) + tok0 * 512 + hx * 128; ldo = 512; }
    else { Ob = (bf16_t*)(ws + OFF_CQ) + tok0 * 512 + hx * 128; ldo = 512; }
#pragma unroll
    for (int i = 0; i < 8; ++i) { const int ch = i * 64 + lane_e, row = ch >> 4, c16 = ch & 15;
      const u32x4 ov = *reinterpret_cast<const u32x4*>(Ost + row * 256 + c16 * 16); if (!dry) *reinterpret_cast<u32x4*>(Ob + (size_t)row * ldo + c16 * 8) = ov; } }
#undef SLOAD
#undef SWRITE
#undef RESC
#undef POST
}
}

namespace idx {
using bf16x8 = __attribute__((ext_vector_type(8))) short;
using f32x4 = __attribute__((ext_vector_type(4))) float;
__device__ __forceinline__ unsigned ordkey(float f) { const unsigned u = __float_as_uint(f); return (u & 0x80000000u) ? ~u : (u | 0x80000000u); }
__device__ __forceinline__ void select2(const unsigned (&key)[2][32], const int nw, unsigned* h0p, unsigned* h1p, const int lane_in, unsigned (&thr)[2], bool (&allsel)[2]) {
  unsigned prefix[2] = {0u, 0u}; int rneed[2] = {256, 256}; bool done[2] = {false, false};
  thr[0] = thr[1] = 0u; allsel[0] = allsel[1] = false;
#pragma unroll
  for (int pass = 0; pass < 3; ++pass) {
    if (!(done[0] && done[1])) {
      int lane = lane_in; asm volatile("" : "+v"(lane));
      const int sh = pass == 0 ? 21 : pass == 1 ? 10 : 0, bits = pass == 2 ? 10 : 11; const unsigned nbm = (1u << bits) - 1u;
#pragma unroll
      for (int i = 0; i < 32; ++i) { h0p[lane + 64 * i] = 0u; h1p[lane + 64 * i] = 0u; }
#pragma unroll
      for (int i = 0; i < 32; ++i) if (i < nw) {
#pragma unroll
        for (int q = 0; q < 2; ++q) { const bool match = pass == 0 ? true : (key[q][i] >> (sh + bits)) == prefix[q];
          if (match) { const unsigned d = (key[q][i] >> sh) & nbm; atomicAdd(&(q ? h1p : h0p)[(d & ~31u) | ((d & 31u) ^ ((d >> 5) & 31u))], 1u); } } }
      unsigned tl[2] = {0u, 0u};
#pragma unroll
      for (int i = 0; i < 32; ++i) { tl[0] += h0p[32 * lane + (i ^ (lane & 31))]; tl[1] += h1p[32 * lane + (i ^ (lane & 31))]; }
      unsigned S[2] = {tl[0], tl[1]};
#pragma unroll
      for (int o = 1; o < 64; o <<= 1) {
        const unsigned v0 = (unsigned)__builtin_amdgcn_ds_bpermute(((lane + o) & 63) << 2, (int)S[0]), v1 = (unsigned)__builtin_amdgcn_ds_bpermute(((lane + o) & 63) << 2, (int)S[1]);
        if (lane + o < 64) { S[0] += v0; S[1] += v1; } }
      int Ls[2], rls[2];
#pragma unroll
      for (int q = 0; q < 2; ++q) { const u64 mk = __ballot((int)S[q] >= rneed[q]); Ls[q] = __builtin_amdgcn_readfirstlane(63 - __clzll(mk));
        rls[q] = __builtin_amdgcn_readlane(rneed[q] - (int)(S[q] - tl[q]), Ls[q]); }
      const int li = lane & 31;
      unsigned hbv[2] = {h0p[32 * Ls[0] + (li ^ (Ls[0] & 31))], h1p[32 * Ls[1] + (li ^ (Ls[1] & 31))]};
      unsigned P[2] = {hbv[0], hbv[1]};
#pragma unroll
      for (int o = 1; o < 32; o <<= 1) {
        const unsigned v0 = (unsigned)__builtin_amdgcn_ds_bpermute(((lane + o) & 63) << 2, (int)P[0]), v1 = (unsigned)__builtin_amdgcn_ds_bpermute(((lane + o) & 63) << 2, (int)P[1]);
        if (li + o < 32) { P[0] += v0; P[1] += v1; } }
#pragma unroll
      for (int q = 0; q < 2; ++q) {
        const unsigned mk2 = (unsigned)__ballot((int)P[q] >= rls[q]);
        const int bi = __builtin_amdgcn_readfirstlane(31 - __clz(mk2));
        const int hbs = __builtin_amdgcn_readlane((int)hbv[q], bi), Pbi = __builtin_amdgcn_readlane((int)P[q], bi);
        const int rn = rls[q] - (Pbi - hbs);
        if (!done[q]) { rneed[q] = rn; prefix[q] = (prefix[q] << bits) | (unsigned)(32 * Ls[q] + bi); thr[q] = prefix[q] << sh;
          if (hbs == rn) { done[q] = true; allsel[q] = true; } }
      }
    }
  }
}
__device__ __forceinline__ u64 mask_words(const unsigned (&key)[32], const unsigned thr, const bool allsel, const int lane) {
  u64 myword = 0ull;
  if (allsel) {
#pragma unroll
    for (int i = 0; i < 32; ++i) { const u64 word = __ballot(key[i] >= thr); if (lane == i) myword = word; }
  } else {
    int cgt = 0;
#pragma unroll
    for (int i = 0; i < 32; ++i) cgt += __popcll(__ballot(key[i] > thr));
    const int need = 256 - cgt; int taken = 0;
#pragma unroll
    for (int i = 0; i < 32; ++i) {
      const bool gt = key[i] > thr, eq = key[i] == thr; const u64 em = __ballot(eq);
      const int before = taken + (int)__builtin_amdgcn_mbcnt_hi((unsigned)(em >> 32), __builtin_amdgcn_mbcnt_lo((unsigned)em, 0u));
      const u64 word = __ballot(gt || (eq && before < need)); taken += __popcll(em);
      if (lane == i) myword = word;
    }
  }
  return myword;
}
__device__ __forceinline__ void indexer_unit(unsigned char* ws, const int tid, char* lds, const int b, const int c, const int half) {
  const int wid = __builtin_amdgcn_readfirstlane(tid >> 6), lane = tid & 63, l15 = lane & 15, G = lane >> 4;
  const size_t tb = (size_t)b * SEQ;
  const int nk = (c + 1) * 64, nw = c + 1, nt16 = nk / 16;
  u64* mrow = (u64*)(ws + OFF_MASK) + (tb + (size_t)c * 64 + half * 32) * 32;
  if (c < 4) {
    for (int i = tid; i < 32 * 32; i += 512) mrow[i] = (i & 31) <= c ? ~0ull : 0ull;
    return;
  }
  float* sc = reinterpret_cast<float*>(lds);
  const bf16_t* aiq = (const bf16_t*)(ws + OFF_AIQ); const bf16_t* aik = (const bf16_t*)(ws + OFF_AIK) + tb * 64; const bf16_t* aiwb = (const bf16_t*)(ws + OFF_AIWB);
  for (int r = 0; r < 2; ++r) {
    for (int hh = 0; hh < 2; ++hh) {
      const int qbase = c * 64 + half * 32 + r * 16 + hh * 8;
      bf16x8 a[2][2][2]; f32x4 w[2][2];
#pragma unroll
      for (int p = 0; p < 2; ++p) { const size_t tq = tb + qbase + 4 * p + (l15 >> 2); const int h = l15 & 3;
#pragma unroll
        for (int hg = 0; hg < 2; ++hg)
#pragma unroll
          for (int ks = 0; ks < 2; ++ks) a[p][hg][ks] = *reinterpret_cast<const bf16x8*>(aiq + tq * 512 + (h + 4 * hg) * 64 + 8 * G + 32 * ks);
        { const uint4 wq = *reinterpret_cast<const uint4*>(aiwb + (tb + qbase + 4 * p + G) * 256);
          w[p][0] = (f32x4){__uint_as_float(wq.x << 16), __uint_as_float(wq.x & 0xffff0000u), __uint_as_float(wq.y << 16), __uint_as_float(wq.y & 0xffff0000u)};
          w[p][1] = (f32x4){__uint_as_float(wq.z << 16), __uint_as_float(wq.z & 0xffff0000u), __uint_as_float(wq.w << 16), __uint_as_float(wq.w & 0xffff0000u)}; } }
      bf16x8 cb[4][2], nb[4][2];
#define IDX_LOADB(dst, t0) do { _Pragma("unroll") for (int k_ = 0; k_ < 4; ++k_) { int tk_ = (t0) + 8 * k_; tk_ = tk_ < nt16 ? tk_ : nt16 - 1; \
        const bf16_t* kp_ = aik + (size_t)(tk_ * 16 + l15) * 64 + 8 * G; dst[k_][0] = *reinterpret_cast<const bf16x8*>(kp_); dst[k_][1] = *reinterpret_cast<const bf16x8*>(kp_ + 32); } } while (0)
      IDX_LOADB(cb, wid);
      for (int t0 = wid; t0 < nt16; t0 += 32) {
        IDX_LOADB(nb, t0 + 32);
#pragma unroll
        for (int k = 0; k < 4; ++k) { const int tk = t0 + 8 * k;
          if (tk < nt16) {
#pragma unroll
            for (int p = 0; p < 2; ++p) {
              f32x4 c0 = {0.f, 0.f, 0.f, 0.f}, c1 = {0.f, 0.f, 0.f, 0.f};
              c0 = __builtin_amdgcn_mfma_f32_16x16x32_bf16(a[p][0][0], cb[k][0], c0, 0, 0, 0); c0 = __builtin_amdgcn_mfma_f32_16x16x32_bf16(a[p][0][1], cb[k][1], c0, 0, 0, 0);
              c1 = __builtin_amdgcn_mfma_f32_16x16x32_bf16(a[p][1][0], cb[k][0], c1, 0, 0, 0); c1 = __builtin_amdgcn_mfma_f32_16x16x32_bf16(a[p][1][1], cb[k][1], c1, 0, 0, 0);
              float sv = 0.f;
#pragma unroll
              for (int j = 0; j < 4; ++j) { const float r0 = __builtin_amdgcn_fmed3f(c0[j], 0.f, __builtin_inff()), r1 = __builtin_amdgcn_fmed3f(c1[j], 0.f, __builtin_inff());
                sv = __builtin_fmaf(r0, w[p][0][j], sv); sv = __builtin_fmaf(r1, w[p][1][j], sv); }
              sc[(8 * hh + 4 * p + G) * 2048 + tk * 16 + l15] = sv; } } }
#pragma unroll
        for (int k = 0; k < 4; ++k) { cb[k][0] = nb[k][0]; cb[k][1] = nb[k][1]; }
      }
#undef IDX_LOADB
    }
    __syncthreads();
    unsigned key[2][32];
#pragma unroll
    for (int i = 0; i < 32; ++i) { const unsigned k0 = ordkey(sc[wid * 2048 + i * 64 + lane]), k1 = ordkey(sc[(wid + 8) * 2048 + i * 64 + lane]);
      key[0][i] = i < nw ? k0 : 0u; key[1][i] = i < nw ? k1 : 0u; }
    asm volatile("s_waitcnt lgkmcnt(0)" ::: "memory");
    unsigned thr[2]; bool allsel[2];
    select2(key, nw, reinterpret_cast<unsigned*>(sc + wid * 2048), reinterpret_cast<unsigned*>(sc + (wid + 8) * 2048), lane, thr, allsel);
    const u64 w0 = mask_words(key[0], thr[0], allsel[0], lane), w1 = mask_words(key[1], thr[1], allsel[1], lane);
    if (lane < 32) { mrow[(size_t)(r * 16 + wid) * 32 + lane] = w0; mrow[(size_t)(r * 16 + wid + 8) * 32 + lane] = w1; }
    __syncthreads();
  }
}
}

#define XB_TMO      128
#define XB_XCNT(j)  (256  + 64 * (j))
#define XB_XSUB(j)  (1280 + 64 * (j))
#define XB_XGEN(j)  (2304 + 64 * (j))
#define XB_TOP      3328
#define XB_TOPGEN   3392
#define XCD_BAR_WORDS 3456
#define XB_SPIN_CAP (1u << 18)
#define LAS __attribute__((address_space(3)))

__device__ __forceinline__ unsigned xb_ld(unsigned* p)              { return __hip_atomic_load(p, __ATOMIC_RELAXED, __HIP_MEMORY_SCOPE_AGENT); }
__device__ __forceinline__ unsigned xb_add(unsigned* p, unsigned v) { return __hip_atomic_fetch_add(p, v, __ATOMIC_RELAXED, __HIP_MEMORY_SCOPE_AGENT); }
__device__ __forceinline__ unsigned xb_xcc_id() { return (unsigned)__builtin_amdgcn_s_getreg((3 << 11) | 20) & 0xFu; }
#define XB_SPIN(cond, bar) do { unsigned _sp = 0; while (cond) { __builtin_amdgcn_s_sleep(1); \
    if ((++_sp & 255u) == 0u) { if (xb_ld(&(bar)[XB_TMO])) break; if (_sp > XB_SPIN_CAP) { atomicAdd(&(bar)[XB_TMO], 1u); break; } } } } while (0)

struct XcdBarrier { unsigned* bar; unsigned x; volatile LAS unsigned* st; };

__device__ __forceinline__ XcdBarrier xcd_barrier_post(unsigned* bar, volatile LAS unsigned* st, int tid) {
    XcdBarrier b; b.bar = bar; b.x = xb_xcc_id(); b.st = st;
    if (tid == 0) (void)xb_add(&bar[XB_XCNT(b.x)], 1u);
    return b;
}
__device__ __forceinline__ void xcd_barrier_complete(unsigned* bar, unsigned x, unsigned& nloc, unsigned& nx) {
    const unsigned G = gridDim.x * gridDim.y * gridDim.z;
    unsigned sum, cnt, mine, sp = 0u;
    for (;;) {
        sum = 0u; cnt = 0u; mine = 0u;
#pragma unroll
        for (unsigned j = 0; j < 16; ++j) { const unsigned c = xb_ld(&bar[XB_XCNT(j)]); sum += c; cnt += (c > 0u) ? 1u : 0u; mine = (j == x) ? c : mine; }
        if (sum == G) break;
        __builtin_amdgcn_s_sleep(1);
        if ((++sp & 255u) == 0u) { if (xb_ld(&bar[XB_TMO])) break; if (sp > XB_SPIN_CAP) { atomicAdd(&bar[XB_TMO], 1u); break; } }
    }
    nloc = mine > 0u ? mine : 1u; nx = cnt > 0u ? cnt : 1u;
}
__device__ __forceinline__ void xcd_barrier(const XcdBarrier& b, int tid) {
    asm volatile("s_waitcnt vmcnt(0)" ::: "memory");
    __syncthreads();
    if (tid == 0) {
        unsigned* bar = b.bar;
        __builtin_amdgcn_s_waitcnt(0);
        unsigned nloc = b.st[0], nx = b.st[1];
        if (nloc == 0u) { xcd_barrier_complete(bar, b.x, nloc, nx); b.st[0] = nloc; b.st[1] = nx; }
        const unsigned old = xb_add(&bar[XB_XSUB(b.x)], 1u);
        const unsigned gen = old / nloc;
        if (old + 1u == (gen + 1u) * nloc) {
            __builtin_amdgcn_fence(__ATOMIC_RELEASE, "agent");
            asm volatile("s_waitcnt vmcnt(0)" ::: "memory");
            const unsigned og = xb_add(&bar[XB_TOP], 1u);
            const unsigned tg = og / nx;
            if (og + 1u == (tg + 1u) * nx) xb_add(&bar[XB_TOPGEN], 1u);
            else XB_SPIN(xb_ld(&bar[XB_TOPGEN]) == tg, bar);
            __builtin_amdgcn_fence(__ATOMIC_ACQUIRE, "agent");
            xb_add(&bar[XB_XGEN(b.x)], 1u);
            asm volatile("s_waitcnt vmcnt(0)" ::: "memory");
        } else {
            XB_SPIN(xb_ld(&bar[XB_XGEN(b.x)]) == gen, bar);
            __builtin_amdgcn_fence(__ATOMIC_ACQUIRE, "agent");
            asm volatile("s_waitcnt vmcnt(0)" ::: "memory");
        }
    }
    __syncthreads();
}

#ifndef RP_PREP
#define RP_PREP 1
#endif
#ifndef RP_P1
#define RP_P1 1
#endif
#ifndef RP_ATT
#define RP_ATT 1
#endif
#ifndef RP_MOE
#define RP_MOE 1
#endif
#ifndef RP_IDX
#define RP_IDX 1
#endif
#ifndef RP_RT
#define RP_RT 1
#endif
#ifndef RP_P4
#define RP_P4 1
#endif
#ifndef RP_UP
#define RP_UP 1
#endif
#ifndef RP_AIW
#define RP_AIW 1
#endif
#ifndef RP_BAR
#define RP_BAR 1
#endif
constexpr int NTHR = 512;
constexpr int LDS_BYTES = 163840;
constexpr int GEMM_LDS_OFF = 1024;
constexpr int XLDS_OFF = 1024 + 131072;
struct Args { const float* in[21]; float* x; unsigned char* ws; };

#define VB_LOOP2(NVB, BODY) do { for (int _i = blockIdx.x; _i < (NVB) / 4; _i += gridDim.x) { const int vb = 4 * _i + 2 * half; BODY; } } while (0)
#define VB_LOOP(NVB, BODY) do { for (int _i = blockIdx.x; _i < (NVB) / 2; _i += gridDim.x) { const int vb = 2 * _i + half; BODY; } } while (0)
#define ROW_LOOP(NROW, BODY) do { for (int row = blockIdx.x * 8 + wave; row < (NROW); row += gridDim.x * 8) { BODY; } } while (0)
#define ELEM_LOOP(N, BODY) do { for (int idx = blockIdx.x * NTHR + tid512; idx < (N); idx += gridDim.x * NTHR) { BODY; } } while (0)

#define AIN(k) as_global(a.in[k])
typedef const __attribute__((address_space(4))) Args* KArgs;
#define PH_BEGIN() KArgs ap_ = (KArgs)__builtin_amdgcn_kernarg_segment_ptr(); asm volatile("" : "+s"(ap_)); const __attribute__((address_space(4))) Args& a = *ap_; \
  int wv_ = wave_u; asm volatile("" : "+s"(wv_)); unsigned z_ = 0u; asm volatile("" : "+v"(z_)); int tid512 = wv_ * 64 + (int)__builtin_amdgcn_mbcnt_hi(~0u, __builtin_amdgcn_mbcnt_lo(~0u, z_)); asm volatile("" : "+v"(tid512)); \
  const int half = tid512 >> 8, tid = tid512 & 255, wave = tid512 >> 6, lane = tid512 & 63; (void)half; (void)tid; (void)wave; (void)lane; \
  size_t zo_ = 0; asm volatile("" : "+s"(zo_)); unsigned char* ws = as_global(a.ws) + zo_; float* x = as_global(a.x) + zo_; \
  char* sm = lds + 1024 + half * 36864; (void)sm; float* rstd = (float*)(ws + OFF_CTL + CTL_RSTD); (void)rstd;

__device__ __forceinline__ void prep_attn_weights(const __attribute__((address_space(4))) Args& a, unsigned char* ws, int l, int half, int tid, char* sm) {
  const float* g_attn = AIN(1) + l * 1024; const float* w_in = AIN(2) + (size_t)l * 1024 * NIN;
  { TrDesc d{w_in, nullptr, g_attn, (bf16_t*)(ws + OFF_WATT + WA_IN), NIN, 1024, NZP, 1}; VB_LOOP2(1664, b_transpose2(d, 0, 0, vb, tid, sm)); }
  { TrDesc d{AIN(4) + (size_t)l * 256 * 768, nullptr, AIN(3) + l * 256, (bf16_t*)(ws + OFF_WATT + WA_UQ), 768, 256, 768, 2}; VB_LOOP2(48, b_transpose2(d, 0, 0, vb, tid, sm)); }
  { TrDesc d{AIN(6) + (size_t)l * 128 * 1024, nullptr, AIN(5) + l * 128, (bf16_t*)(ws + OFF_WATT + WA_UKV), 1024, 128, 1024, 0, 256}; VB_LOOP2(32, b_transpose2(d, 0, 0, vb, tid, sm)); }
  { TrDesc d{AIN(8) + (size_t)l * 512 * 1024, nullptr, nullptr, (bf16_t*)(ws + OFF_WATT + WA_P), 1024, 512, 1024, 0}; VB_LOOP2(128, b_transpose2(d, 0, 0, vb, tid, sm)); }
  { TrDesc d{AIN(9) + (size_t)l * 512 * 1024, nullptr, nullptr, (bf16_t*)(ws + OFF_WATT + WA_P) + (size_t)1024 * 512, 1024, 512, 1024, 0}; VB_LOOP2(128, b_transpose2(d, 0, 0, vb, tid, sm)); }
  { TrDesc d{AIN(10) + (size_t)l * 512 * 1024, nullptr, nullptr, (bf16_t*)(ws + OFF_WATT + WA_P) + (size_t)2 * 1024 * 512, 1024, 512, 1024, 0}; VB_LOOP2(128, b_transpose2(d, 0, 0, vb, tid, sm)); }
  { TrDesc d{AIN(11) + (size_t)l * 1024 * 1024, nullptr, nullptr, (bf16_t*)(ws + OFF_WATT + WA_O), 1024, 1024, 1024, 0}; VB_LOOP2(256, b_transpose2(d, 0, 0, vb, tid, sm)); }
}

#define GRID_BAR() do { PH_BEGIN(); XcdBarrier bar_; bar_.bar = (unsigned*)(ws + OFF_CTL + CTL_BAR); bar_.x = xb_xcc_id(); bar_.st = (volatile LAS unsigned*)lds; xcd_barrier(bar_, tid512); } while (0)
template <int l>
__device__ __forceinline__ void layer_phases(const int wave_u, char* lds) {
#define PH_P1() { PH_BEGIN(); __syncthreads(); \
      { pg8::PlainOrder S{(const char*)(ws + OFF_XB), (const char*)(ws + OFF_WATT + WA_IN), 1024, 1024, T / 256, NZP / 256, (int)gridDim.x, (int)blockIdx.x, 16}; pg8::EpiIn E{ws}; \
        pg8::gemm_phase<pg8::EpiIn, pg8::PlainOrder, true, false, 1024, 1024, 1024>(tid512, (PG8_LAS unsigned char*)lds + GEMM_LDS_OFF, S, E); } }
    PH_P1();
#if RP_P1 > 1
    PH_P1();
#endif
#if RP_BAR > 1
    GRID_BAR(); GRID_BAR(); GRID_BAR(); GRID_BAR(); GRID_BAR(); GRID_BAR(); GRID_BAR(); GRID_BAR(); GRID_BAR(); GRID_BAR();
#endif
    GRID_BAR();
#define PH_UP() { PH_BEGIN(); __syncthreads(); pg8::UpOrder S{ws, (int)gridDim.x, (int)blockIdx.x}; pg8::EpiUpBoth E{ws}; \
      pg8::gemm_phase<pg8::EpiUpBoth, pg8::UpOrder, true, false, 384, 256, 256>(tid512, (PG8_LAS unsigned char*)lds + GEMM_LDS_OFF, S, E); }
    PH_UP();
#if RP_UP > 1
    PH_UP();
#endif
#define PH_IDX() { PH_BEGIN(); __syncthreads(); const int w = blockIdx.x, bb = w >> 5, i = w & 31;        \
      idx::indexer_unit(ws, tid512, lds + GEMM_LDS_OFF, bb, i, 0); idx::indexer_unit(ws, tid512, lds + GEMM_LDS_OFF, bb, 31 - i, 1); }
    PH_IDX();
#if RP_IDX > 1
    PH_IDX();
#endif
    GRID_BAR();
#define PH_ATT(dry) \
    { PH_BEGIN(); const int w = blockIdx.x, bb = w >> 5, i = w & 31; att::attn_unit<0>(ws, nullptr, tid512, lds + GEMM_LDS_OFF, bb, 0, i, dry); } \
    { PH_BEGIN(); const int w = blockIdx.x, bb = w >> 5, i = w & 31; att::attn_unit<1>(ws, nullptr, tid512, lds + GEMM_LDS_OFF, bb, i & 3, 7 - (i >> 2), dry); } \
    { PH_BEGIN(); const float* relb_ = AIN(7) + l * 4 * 257; const int w = blockIdx.x, bb = w >> 5, i = w & 31; att::attn_unit<2>(ws, relb_, tid512, lds + GEMM_LDS_OFF, bb, i & 3, i >> 2, dry); }
#if RP_ATT > 1
    PH_ATT(true);
#endif
    PH_ATT(false);
    GRID_BAR();
    { PH_BEGIN(); if (blockIdx.x == 0 && tid512 < 128) ((unsigned*)(ws + OFF_CTL + CTL_CNT))[tid512] = 0u; }
#define PH_P4()     { PH_BEGIN(); __syncthreads(); \
      pg8::ProjOrder S{ws, (int)gridDim.x, (int)blockIdx.x}; pg8::EpiProj E{ws}; \
      pg8::gemm_phase<pg8::EpiProj, pg8::ProjOrder, false, false, 512, 512, 512>(tid512, (PG8_LAS unsigned char*)lds + GEMM_LDS_OFF, S, E); }
    PH_P4();
#if RP_P4 > 1
    PH_P4();
#endif
    GRID_BAR();
    { PH_BEGIN(); __syncthreads();
      pg8::PlainOrder S{(const char*)(ws + OFF_MIX), (const char*)(ws + OFF_WATT + WA_O), 1024, 1024, T / 256, 4, (int)gridDim.x, (int)blockIdx.x, 16}; pg8::EpiOut E{x, (bf16_t*)(ws + OFF_XB)};
      pg8::gemm_phase<pg8::EpiOut, pg8::PlainOrder, false, false, 1024, 1024, 1024>(tid512, (PG8_LAS unsigned char*)lds + GEMM_LDS_OFF, S, E); }
    GRID_BAR();
#define PH_RT(DRY)     { PH_BEGIN(); const float* g_ = AIN(12) + l * 1024; const float* wg_ = AIN(13) + (size_t)l * 1024 * 4; const float* bg_ = AIN(14) + l * 4; const float* wr_ = AIN(15) + (size_t)l * 1024 * 32; const float* br_ = AIN(16) + l * 32; \
      __syncthreads(); float* wt_ = (float*)(lds + GEMM_LDS_OFF); router_stage(g_, wg_, wr_, wt_, tid512); __syncthreads(); \
      for (int t0 = blockIdx.x * 64; t0 < T; t0 += gridDim.x * 64) \
        router_mfma((const float*)x, wt_, lds + GEMM_LDS_OFF + ROUTER_LDS, bg_, br_, (int*)(ws + OFF_CTL + CTL_TOKE), (float*)(ws + OFF_CTL + CTL_TOKW), rstd, (unsigned*)(ws + OFF_CTL + CTL_CNT), (int*)(ws + OFF_LIST), t0 + (wave & 3) * 16, wave, lane, DRY); \
      __syncthreads(); }
#if RP_RT > 1
    PH_RT(true);
#endif
    PH_RT(false);
#if RP_PREP > 1
    { PH_BEGIN();
      { TrDesc d{AIN(17) + (size_t)l * 32 * 1024 * 256, AIN(18) + (size_t)l * 32 * 1024 * 256, AIN(12) + l * 1024, (bf16_t*)(ws + OFF_WGU), 256, 1024, 512, 3};
        VB_LOOP2(128 * 32, b_transpose2(d, (size_t)1024 * 256, (size_t)512 * 1024, vb, tid, sm)); }
      { TrDesc d{AIN(19) + (size_t)l * 32 * 256 * 1024, nullptr, nullptr, (bf16_t*)(ws + OFF_WD), 1024, 256, 1024, 0};
        VB_LOOP2(64 * 32, b_transpose2(d, (size_t)256 * 1024, (size_t)1024 * 256, vb, tid, sm)); } }
#endif
    { PH_BEGIN();
      { TrDesc d{AIN(17) + (size_t)l * 32 * 1024 * 256, AIN(18) + (size_t)l * 32 * 1024 * 256, AIN(12) + l * 1024, (bf16_t*)(ws + OFF_WGU), 256, 1024, 512, 3};
        VB_LOOP2(128 * 32, b_transpose2(d, (size_t)1024 * 256, (size_t)512 * 1024, vb, tid, sm)); }
      { TrDesc d{AIN(19) + (size_t)l * 32 * 256 * 1024, nullptr, nullptr, (bf16_t*)(ws + OFF_WD), 1024, 256, 1024, 0};
        VB_LOOP2(64 * 32, b_transpose2(d, (size_t)256 * 1024, (size_t)1024 * 256, vb, tid, sm)); } }
    GRID_BAR();
#define MOE_TAB ((PG8_LAS unsigned*)((PG8_LAS unsigned char*)lds + XLDS_OFF))
#define PH_MOE_A() { PH_BEGIN(); __syncthreads(); pg8::moe_build_map((unsigned*)(ws + OFF_CTL + CTL_CNT), MOE_TAB, tid512); \
      pg8::MoeOrder<2, false> S{ws, (int)gridDim.x, (int)blockIdx.x, MOE_TAB, 0, 256}; pg8::EpiGU E{ws}; \
      pg8::gemm_phase<pg8::EpiGU, pg8::MoeOrder<2, false>, true, true, 1024, 1024, 1024>(tid512, (PG8_LAS unsigned char*)lds + GEMM_LDS_OFF, S, E, (PG8_LAS unsigned char*)lds + XLDS_OFF + 1024); }
#define PH_MOE_B() \
    { PH_BEGIN(); __syncthreads(); pg8::moe_build_map((unsigned*)(ws + OFF_CTL + CTL_CNT), MOE_TAB, tid512); \
      pg8::MoeOrder<2, false> S{ws, (int)gridDim.x, (int)blockIdx.x, MOE_TAB, 256, 1 << 30}; pg8::EpiGU E{ws}; \
      pg8::gemm_phase<pg8::EpiGU, pg8::MoeOrder<2, false>, true, true, 1024, 1024, 1024>(tid512, (PG8_LAS unsigned char*)lds + GEMM_LDS_OFF, S, E, (PG8_LAS unsigned char*)lds + XLDS_OFF + 1024); \
      const int nt_ = __builtin_amdgcn_readfirstlane((int)MOE_TAB[255]); const int L_ = 256 + (int)blockIdx.x;       \
      asm volatile("s_waitcnt vmcnt(0)" ::: "memory"); __syncthreads(); \
      if (L_ < 2 * nt_ && tid512 == 0) { __builtin_amdgcn_fence(__ATOMIC_RELEASE, "agent"); asm volatile("s_waitcnt vmcnt(0)" ::: "memory"); \
        __hip_atomic_fetch_add((unsigned*)(ws + OFF_CTL + CTL_CNT) + 64 + (L_ / 2 - 128), 1u, __ATOMIC_RELAXED, __HIP_MEMORY_SCOPE_AGENT); } } \
    { PH_BEGIN(); __syncthreads(); const int nt_ = __builtin_amdgcn_readfirstlane((int)MOE_TAB[255]); const int nx_ = 2 * nt_ > 256 ? 2 * nt_ - 256 : 0; \
      pg8::MoeOrder<4, true> S{ws, (int)gridDim.x - nx_, (int)blockIdx.x - nx_, MOE_TAB, 0, 512}; pg8::EpiDown E{ws}; \
      pg8::gemm_phase<pg8::EpiDown, pg8::MoeOrder<4, true>, true, false, 256, 256, 256>(tid512, (PG8_LAS unsigned char*)lds + GEMM_LDS_OFF, S, E); } \
    { PH_BEGIN(); __syncthreads(); const int nt_ = __builtin_amdgcn_readfirstlane((int)MOE_TAB[255]); const int L_ = 512 + (int)blockIdx.x; \
      if (L_ < 4 * nt_) { if (tid512 == 0) { unsigned* fl_ = (unsigned*)(ws + OFF_CTL + CTL_CNT) + 64 + (L_ / 4 - 128); unsigned sp_ = 0; \
          while (__hip_atomic_load(fl_, __ATOMIC_RELAXED, __HIP_MEMORY_SCOPE_AGENT) < 2u && ++sp_ < (1u << 22)) __builtin_amdgcn_s_sleep(1); \
          __builtin_amdgcn_fence(__ATOMIC_ACQUIRE, "agent"); asm volatile("s_waitcnt vmcnt(0)" ::: "memory"); } } \
      __syncthreads(); \
      pg8::MoeOrder<4, true> S{ws, (int)gridDim.x, (int)blockIdx.x, MOE_TAB, 512, 1 << 30}; pg8::EpiDown E{ws}; \
      pg8::gemm_phase<pg8::EpiDown, pg8::MoeOrder<4, true>, true, false, 256, 256, 256>(tid512, (PG8_LAS unsigned char*)lds + GEMM_LDS_OFF, S, E); }
#if RP_MOE > 1
    PH_MOE_A(); GRID_BAR();
#endif
    PH_MOE_A();
    GRID_BAR();
    PH_MOE_B();
    GRID_BAR();
    if (l == 0) { { PH_BEGIN(); ROW_LOOP(T, b_finalize<false>(x, ws, nullptr, row, lane)); } { PH_BEGIN(); prep_attn_weights(a, ws, 1, half, tid, sm); } if (RP_PREP > 1) { PH_BEGIN(); prep_attn_weights(a, ws, 1, half, tid, sm); } GRID_BAR(); }
    else { PH_BEGIN(); const float* gf_ = AIN(20); ROW_LOOP(T, b_finalize<true>(x, ws, gf_, row, lane)); }
}

__global__ void __launch_bounds__(NTHR, 2) mk_fwd(Args a_in) {
  extern __shared__ __attribute__((aligned(16))) char lds[];
  const int wave_u = __builtin_amdgcn_readfirstlane((int)threadIdx.x >> 6);
  { PH_BEGIN();
    if (tid512 == 0) { ((volatile LAS unsigned*)lds)[0] = 0u; ((volatile LAS unsigned*)lds)[1] = 0u; ((volatile LAS unsigned*)lds)[2] = 0u; ((volatile LAS unsigned*)lds)[3] = 0u; }
    __syncthreads();
    (void)xcd_barrier_post((unsigned*)(ws + OFF_CTL + CTL_BAR), (volatile LAS unsigned*)lds, tid512); }
  { PH_BEGIN(); ELEM_LOOP(2048 * 56, b_rope_tables((float*)(ws + OFF_CTL + CTL_ROPE), idx)); }
  { PH_BEGIN(); const float* xin = AIN(0); ROW_LOOP(T, b_x_init(xin, x, (bf16_t*)(ws + OFF_XB), rstd, row, lane)); }
  { PH_BEGIN(); prep_attn_weights(a, ws, 0, half, tid, sm); }
  if (RP_PREP > 1) { PH_BEGIN(); prep_attn_weights(a, ws, 0, half, tid, sm); }
  GRID_BAR();
  layer_phases<0>(wave_u, lds);
  layer_phases<1>(wave_u, lds);
}

extern "C" void kernel_launch(void* const* d_in, const int* in_sizes, int n_in, void* d_out, int out_size, void* d_ws, size_t ws_size, hipStream_t stream) {
  if (ws_size < WS_END) { fprintf(stderr, "kernel_launch: workspace too small: %zu < %zu\n", ws_size, WS_END); return; }
  static int grid = 0;
  if (!grid) {
    int dev = 0, cus = 0, per_cu = 0;
    hipGetDevice(&dev);
    hipDeviceGetAttribute(&cus, hipDeviceAttributeMultiprocessorCount, dev);
    hipFuncSetAttribute((const void*)mk_fwd, hipFuncAttributeMaxDynamicSharedMemorySize, LDS_BYTES);
    hipOccupancyMaxActiveBlocksPerMultiprocessor(&per_cu, (const void*)mk_fwd, NTHR, LDS_BYTES);
    if (per_cu < 1) { fprintf(stderr, "kernel_launch: occupancy query says %d blocks per CU\n", per_cu); return; }
    if (cus < 256) { fprintf(stderr, "kernel_launch: this kernel is laid out for 256 workgroups, one per CU; the device reports %d CUs\n", cus); return; }
    grid = 256;
  }
  Args a{};
  for (int i = 0; i < 21; ++i) a.in[i] = (const float*)d_in[i];
  a.x = (float*)d_out; a.ws = (unsigned char*)d_ws;
  hipMemsetAsync((unsigned char*)d_ws + OFF_CTL + CTL_BAR, 0, XCD_BAR_WORDS * sizeof(unsigned), stream);
  hipLaunchKernelGGL(mk_fwd, dim3(grid), dim3(NTHR), LDS_BYTES, stream, a);
}
```

```cpp
#include <hip/hip_runtime.h>
#include <hip/hip_bf16.h>
#include <cstdint>
#include <cstdio>

typedef unsigned short bf16_t;
typedef unsigned long long u64;

constexpr int T = 16384, DM = 1024, SEQ = 2048, NB = 8;
constexpr int NIN = 6408, NZ = 6400, NZP = 6656;
constexpr float EPS = 1e-6f;

constexpr size_t MiB = (size_t)1 << 20;
constexpr size_t OFF_CTL = 0;
constexpr size_t OFF_WATT = 4 * MiB;
constexpr size_t OFF_XB = 23 * MiB;
constexpr size_t OFF_AQ = 55 * MiB;
constexpr size_t OFF_CQ = 71 * MiB;
constexpr size_t OFF_QB = 87 * MiB;
constexpr size_t OFF_ZA = 111 * MiB;
constexpr size_t OFF_AK = OFF_ZA;
constexpr size_t OFF_AV = OFF_AK + 4 * MiB;
constexpr size_t OFF_AIQ = OFF_AV + 4 * MiB;
constexpr size_t OFF_AIK = OFF_AIQ + 16 * MiB;
constexpr size_t OFF_BKR = OFF_AIK + 2 * MiB;
constexpr size_t OFF_BCKV = OFF_BKR + 2 * MiB;
constexpr size_t OFF_BCQ = OFF_BCKV + 4 * MiB;
constexpr size_t OFF_BC = OFF_BCKV;
constexpr size_t OFF_CK = OFF_BCQ + 8 * MiB;
constexpr size_t OFF_CV = OFF_CK + 16 * MiB;
constexpr size_t OFF_KVB = 183 * MiB;
constexpr size_t OFF_MASK = 215 * MiB;
constexpr size_t OFF_G = 219 * MiB;
constexpr size_t OFF_AIWB = 315 * MiB;
constexpr size_t WS_END = 323 * MiB;
constexpr size_t OFF_MIX = OFF_KVB;
constexpr size_t OFF_WMOE = OFF_ZA;
constexpr size_t OFF_WGU = OFF_WMOE;
constexpr size_t OFF_WD = OFF_WMOE + 32 * MiB;
constexpr size_t OFF_Y = OFF_G;
constexpr size_t OFF_LIST = OFF_MASK;
constexpr size_t OFF_H = OFF_AQ;
constexpr size_t CTL_BAR = 0;
constexpr size_t CTL_CNT = 16 * 1024;
constexpr size_t CTL_ROPE = 64 * 1024;
constexpr size_t CTL_RSTD = 1 * MiB;
constexpr size_t CTL_RSTDQ = CTL_RSTD + 64 * 1024;
constexpr size_t CTL_RSTDKV = CTL_RSTDQ + 64 * 1024;
constexpr size_t CTL_AIW = CTL_RSTDKV + 64 * 1024;
constexpr size_t CTL_SSQ = 2 * MiB;
constexpr size_t CTL_SSQQ = CTL_SSQ;
constexpr size_t CTL_SSQKV = CTL_SSQ + 512 * 1024;
constexpr size_t CTL_TOKE = 3 * MiB;
constexpr size_t CTL_TOKW = CTL_TOKE + 128 * 1024;
constexpr size_t CTL_WIW = 3 * MiB + 512 * 1024;
constexpr size_t WA_IN = 0;
constexpr size_t WA_UQ = 13 * MiB;
constexpr size_t WA_UKV = WA_UQ + 512 * 1024;
constexpr size_t WA_P = 14 * MiB;
constexpr size_t WA_O = 17 * MiB;
constexpr int RT_COSA = 0, RT_SINA = 2048 * 16, RT_COSI = 2048 * 32, RT_SINI = 2048 * 40, RT_COSB = 2048 * 48, RT_SINB = 2048 * 80;

template <class Tp> __device__ __forceinline__ Tp* as_global(Tp* p) { return (Tp*)(__attribute__((address_space(1))) Tp*)p; }
__device__ __forceinline__ float bf2f(bf16_t v) { return __uint_as_float(((unsigned)v) << 16); }
__device__ __forceinline__ bf16_t f2bf(float f) { unsigned u = __float_as_uint(f); return (bf16_t)((u + 0x7fffu + ((u >> 16) & 1u)) >> 16); }
__device__ __forceinline__ float shx(float v, int m, int lane) { return __int_as_float(__builtin_amdgcn_ds_bpermute((lane ^ m) << 2, __float_as_int(v))); }
__device__ __forceinline__ float wave_sum(float v, int lane) {
  v += shx(v, 32, lane); v += shx(v, 16, lane); v += shx(v, 8, lane); v += shx(v, 4, lane); v += shx(v, 2, lane); v += shx(v, 1, lane); return v;
}
__host__ __device__ __forceinline__ int zmap(int c) {
  if (c < 1344) return c;
  if (c < 1408) { int n = c - 1344, g = n >> 5, r = n & 31; return 1736 + (r < 16 ? 16 * g + r : 32 + 16 * g + (r - 16)); }
  if (c < 1536) return 1608 + (c - 1408);
  if (c < 1792) return 1352 + (c - 1536);
  return c + 8;
}
__host__ __device__ __forceinline__ int uqmap(int c) {
  if (c < 512) { int h = c >> 7, d = c & 127; return h * 192 + d; }
  int n = c - 512, h = n >> 6, m = n & 63, g = m >> 5, r = m & 31;
  return h * 192 + 128 + (r < 16 ? 16 * g + r : 32 + 16 * g + (r - 16));
}
__host__ __device__ __forceinline__ int gumap(int n, int& isup) { int pn = n >> 8, j = n & 255; isup = j >= 128; return 128 * pn + (j & 127); }

struct TrDesc { const float* src; const float* src2; const float* scale; bf16_t* dst; int ld; int K; int N; int kind; int dp = 0; };
struct TrRegs { float4 v[4]; float sc[4]; };
__device__ __forceinline__ void tt_load(const TrDesc& d, int tn, int tk, int tid, TrRegs& R) {
  const int n0 = tn * 64, k0 = tk * 64;
  const int n4 = (tid & 15) * 4, kq = tid >> 4;
  const int n = n0 + n4;
  const float* s = d.src; int col; float cs = 1.f;
  if (d.kind == 0) col = n; else if (d.kind == 1) { if (n >= NZ) { col = n < NZ + 8 ? 1344 + (n - NZ) : 0; cs = n < NZ + 8 ? 0.35355339059327373f * 0.125f : 0.f; } else col = zmap(n); } else if (d.kind == 2) col = uqmap(n);
  else { int isup; col = gumap(n, isup); if (isup) s = d.src2; }
  const bool vec = ((((size_t)d.ld * 4) & 15) == 0) && ((col & 3) == 0);
#pragma unroll
  for (int i = 0; i < 4; ++i) { const int kk = kq + 16 * i; const float* p = s + (size_t)(k0 + kk) * d.ld + col;
    if (vec) R.v[i] = *(const float4*)p; else { R.v[i].x = p[0]; R.v[i].y = p[1]; R.v[i].z = p[2]; R.v[i].w = p[3]; }
    R.sc[i] = (d.scale ? d.scale[k0 + kk] : 1.f) * cs; }
}
__device__ __forceinline__ void tt_lds(const TrRegs& R, float (*tile)[65], int tid) {
  const int n4 = (tid & 15) * 4, kq = tid >> 4;
#pragma unroll
  for (int i = 0; i < 4; ++i) { const int kk = kq + 16 * i; const float sc = R.sc[i];
    tile[kk][n4] = R.v[i].x * sc; tile[kk][n4 + 1] = R.v[i].y * sc; tile[kk][n4 + 2] = R.v[i].z * sc; tile[kk][n4 + 3] = R.v[i].w * sc; }
}
__device__ __forceinline__ void tt_store(const TrDesc& d, int tn, int tk, float (*tile)[65], int tid) {
  const int n0 = tn * 64, k0 = tk * 64;
  const int dp = d.dp ? d.dp : d.K;
#pragma unroll
  for (int i = 0; i < 2; ++i) { const int e = tid + 256 * i, nn = e >> 3, k8 = (e & 7) * 8;
    uint4 w;
    w.x = (unsigned)f2bf(tile[k8 + 0][nn]) | ((unsigned)f2bf(tile[k8 + 1][nn]) << 16); w.y = (unsigned)f2bf(tile[k8 + 2][nn]) | ((unsigned)f2bf(tile[k8 + 3][nn]) << 16);
    w.z = (unsigned)f2bf(tile[k8 + 4][nn]) | ((unsigned)f2bf(tile[k8 + 5][nn]) << 16); w.w = (unsigned)f2bf(tile[k8 + 6][nn]) | ((unsigned)f2bf(tile[k8 + 7][nn]) << 16);
    *(uint4*)(d.dst + (size_t)(n0 + nn) * dp + k0 + k8) = w; }
}
__device__ __forceinline__ void b_transpose2(TrDesc d, size_t src_stride, size_t dst_stride, int vb, int tid, char* sm) {
  float (*tileA)[65] = (float (*)[65])sm; float (*tileB)[65] = (float (*)[65])(sm + 64 * 65 * 4);
  const int ntk = d.K / 64, per = (d.N / 64) * ntk;
  TrDesc da = d, db = d;
  { const int e = vb / per; da.src += (size_t)e * src_stride; if (da.src2) da.src2 += (size_t)e * src_stride; da.dst += (size_t)e * dst_stride; }
  { const int e = (vb + 1) / per; db.src += (size_t)e * src_stride; if (db.src2) db.src2 += (size_t)e * src_stride; db.dst += (size_t)e * dst_stride; }
  const int ta = vb % per, tb = (vb + 1) % per;
  TrRegs ra, rb; tt_load(da, ta / ntk, ta % ntk, tid, ra); tt_load(db, tb / ntk, tb % ntk, tid, rb);
  tt_lds(ra, tileA, tid); tt_lds(rb, tileB, tid);
  __syncthreads();
  tt_store(da, ta / ntk, ta % ntk, tileA, tid); tt_store(db, tb / ntk, tb % ntk, tileB, tid);
  __syncthreads();
}
__device__ __forceinline__ void b_rope_tables(float* rt, int i) {
  int pos = i / 56, j = i % 56; int rot, idx, oc, os;
  if (j < 16) { rot = 32; idx = j; oc = RT_COSA + pos * 16 + idx; os = RT_SINA + pos * 16 + idx; }
  else if (j < 24) { rot = 16; idx = j - 16; oc = RT_COSI + pos * 8 + idx; os = RT_SINI + pos * 8 + idx; }
  else { rot = 64; idx = j - 24; oc = RT_COSB + pos * 32 + idx; os = RT_SINB + pos * 32 + idx; }
  float inv = (float)pow(500000.0, -(double)(2 * idx) / (double)rot);
  float ang = (float)pos * inv;
  rt[oc] = (float)cos((double)ang); rt[os] = (float)sin((double)ang);
}
__device__ __forceinline__ void b_x_init(const float* xin, float* x, bf16_t* xb, float* rstd, int row, int lane) {
  const float4* s = (const float4*)(xin + (size_t)row * DM); float4* d = (float4*)(x + (size_t)row * DM);
  float ss = 0.f;
#pragma unroll
  for (int i = 0; i < 4; ++i) { float4 v = s[lane + 64 * i]; d[lane + 64 * i] = v; ss += v.x * v.x + v.y * v.y + v.z * v.z + v.w * v.w;
    bf16_t* o = xb + (size_t)row * DM + (lane + 64 * i) * 4; o[0] = f2bf(v.x); o[1] = f2bf(v.y); o[2] = f2bf(v.z); o[3] = f2bf(v.w); }
  ss = wave_sum(ss, lane);
  if (lane == 0) rstd[row] = rsqrtf(ss * (1.f / DM) + EPS);
}

constexpr int RT_P = 1028;
constexpr int ROUTER_LDS = 36 * RT_P * 4;
__device__ __forceinline__ void router_stage(const float* g, const float* wg, const float* wr, float* wt, int tid) {
  for (int i = tid; i < 1024 * 32; i += 512) { const int k = i >> 5, j = i & 31; wt[(4 + j) * RT_P + k] = g[k] * wr[i]; }
  for (int i = tid; i < 1024 * 4; i += 512) { const int k = i >> 2, j = i & 3; wt[j * RT_P + k] = g[k] * wg[i]; }
}
__device__ __forceinline__ void router_select(const float (&acc)[36], const float rs, const float* bg, const float* br, int t, int* toke, float* tokw, float* rstd_out, unsigned* cnt, int* list, bool dry) {
  float lg[4]; float mx = -INFINITY;
#pragma unroll
  for (int j = 0; j < 4; ++j) { lg[j] = acc[j] * rs + bg[j]; mx = fmaxf(mx, lg[j]); }
  float sm = 0.f, best = -1.f; int gs = 0;
#pragma unroll
  for (int j = 0; j < 4; ++j) { const float p = __expf(lg[j] - mx); sm += p; if (p > best) { best = p; gs = j; } }
  const float pg = best / sm;
  const float m0 = gs == 0 ? 1.f : 0.f, m1 = gs == 1 ? 1.f : 0.f, m2 = gs == 2 ? 1.f : 0.f, m3 = gs == 3 ? 1.f : 0.f;
  float e[8]; float emx = -INFINITY;
#pragma unroll
  for (int j = 0; j < 8; ++j) { e[j] = ((acc[4 + j] * m0 + acc[12 + j] * m1) + (acc[20 + j] * m2 + acc[28 + j] * m3)) * rs + br[gs * 8 + j]; emx = fmaxf(emx, e[j]); }
  float es = 0.f, b0 = -1.f, b1 = -1.f; int i0 = 0, i1 = 0;
#pragma unroll
  for (int j = 0; j < 8; ++j) { const float p = __expf(e[j] - emx); es += p;
    if (p > b0) { b1 = b0; i1 = i0; b0 = p; i0 = j; } else if (p > b1) { b1 = p; i1 = j; } }
  const float p0 = b0 / es, p1 = b1 / es, ps = p0 + p1;
  const int e0 = gs * 8 + i0, e1 = gs * 8 + i1;
  if (dry) { asm volatile("" :: "v"(p0 + ps), "v"(e0 + e1)); return; }
  rstd_out[t] = rs;
  toke[t * 2] = e0; toke[t * 2 + 1] = e1; tokw[t * 2] = pg * p0 / ps; tokw[t * 2 + 1] = pg * p1 / ps;
  const unsigned s0 = atomicAdd(cnt + e0, 1u), s1 = atomicAdd(cnt + e1, 1u);
  list[(size_t)e0 * T + s0] = t * 2; list[(size_t)e1 * T + s1] = t * 2 + 1;
}
__device__ __forceinline__ void router_mfma(const float* x, const float* wt, char* scr  , const float* bg, const float* br, int* toke, float* tokw, float* rstd_out,
                                            unsigned* cnt, int* list, const int t0  , const int wave, const int lane, const bool dry) {
  typedef float f4 __attribute__((ext_vector_type(4)));
  const int i = lane & 15, g = lane >> 4, wp = wave & 3, kh = wave >> 2;
  const float* xr = x + (size_t)(t0 + i) * DM + kh * 512 + 4 * g;
  const float* w0 = wt + (size_t)i * RT_P + kh * 512 + 4 * g; const float* w1 = w0 + 16 * RT_P; const float* w2 = wt + (size_t)(32 + (i < 4 ? i : 3)) * RT_P + kh * 512 + 4 * g;
  f4 c0 = {0.f, 0.f, 0.f, 0.f}, c1 = c0, c2 = c0; float ssl = 0.f;
#pragma unroll 4
  for (int s = 0; s < 32; ++s) {
    const f4 xa = *(const f4*)(xr + 16 * s), b0 = *(const f4*)(w0 + 16 * s), b1 = *(const f4*)(w1 + 16 * s), b2 = *(const f4*)(w2 + 16 * s);
    ssl += (xa[0] * xa[0] + xa[1] * xa[1]) + (xa[2] * xa[2] + xa[3] * xa[3]);
#pragma unroll
    for (int e = 0; e < 4; ++e) { c0 = __builtin_amdgcn_mfma_f32_16x16x4f32(xa[e], b0[e], c0, 0, 0, 0); c1 = __builtin_amdgcn_mfma_f32_16x16x4f32(xa[e], b1[e], c1, 0, 0, 0); c2 = __builtin_amdgcn_mfma_f32_16x16x4f32(xa[e], b2[e], c2, 0, 0, 0); }
  }
  float* part = (float*)scr + (size_t)(wp * 64 + lane) * 12; float* pss = (float*)(scr + 4 * 3072) + wp * 64 + lane;
  if (kh == 1) { *(f4*)part = c0; *(f4*)(part + 4) = c1; *(f4*)(part + 8) = c2; *pss = ssl; }
  __syncthreads();
  if (kh == 0) {
    c0 += *(const f4*)part; c1 += *(const f4*)(part + 4); c2 += *(const f4*)(part + 8); ssl += *pss;
    asm volatile("s_waitcnt lgkmcnt(0)" ::: "memory");
    ssl += shx(ssl, 16, lane); ssl += shx(ssl, 32, lane);
    float* lg = (float*)(scr + wp * 3072);
#pragma unroll
    for (int r = 0; r < 4; ++r) { lg[(4 * g + r) * 48 + i] = c0[r]; lg[(4 * g + r) * 48 + 16 + i] = c1[r]; lg[(4 * g + r) * 48 + 32 + i] = c2[r]; }
    asm volatile("s_waitcnt lgkmcnt(0)" ::: "memory");
    if (lane < 16) { float acc[36];
#pragma unroll
      for (int j = 0; j < 36; ++j) acc[j] = lg[lane * 48 + j];
      router_select(acc, rsqrtf(ssl * (1.f / DM) + EPS), bg, br, t0 + lane, toke, tokw, rstd_out, cnt, list, dry); }
  }
  __syncthreads();
}
template <bool LAST>
__device__ __forceinline__ void b_finalize(float* x, unsigned char* ws, const float* gf, int row, int lane) {
  float4* xr = (float4*)(x + (size_t)row * DM);
  const bf16_t* y0 = (const bf16_t*)(ws + OFF_Y) + (size_t)row * 2048; const bf16_t* y1 = y0 + 1024;
  float4 v[4]; float ss = 0.f;
#pragma unroll
  for (int i = 0; i < 4; ++i) { const int c4 = lane + 64 * i; float4 a = xr[c4];
    uint2 p0 = *(const uint2*)(y0 + c4 * 4), p1 = *(const uint2*)(y1 + c4 * 4);
    a.x += __uint_as_float(p0.x << 16) + __uint_as_float(p1.x << 16); a.y += __uint_as_float(p0.x & 0xffff0000u) + __uint_as_float(p1.x & 0xffff0000u);
    a.z += __uint_as_float(p0.y << 16) + __uint_as_float(p1.y << 16); a.w += __uint_as_float(p0.y & 0xffff0000u) + __uint_as_float(p1.y & 0xffff0000u);
    v[i] = a; ss += a.x * a.x + a.y * a.y + a.z * a.z + a.w * a.w; }
  ss = wave_sum(ss, lane);
  const float rs = rsqrtf(ss * (1.f / DM) + EPS);
#pragma unroll
  for (int i = 0; i < 4; ++i) { const int c4 = lane + 64 * i; float4 a = v[i];
    if (LAST) { float4 g = ((const float4*)gf)[c4]; a.x *= rs * g.x; a.y *= rs * g.y; a.z *= rs * g.z; a.w *= rs * g.w; xr[c4] = a; }
    else { xr[c4] = a; bf16_t* o = (bf16_t*)(ws + OFF_XB) + (size_t)row * DM + c4 * 4; o[0] = f2bf(a.x); o[1] = f2bf(a.y); o[2] = f2bf(a.z); o[3] = f2bf(a.w); } }
  if (!LAST && lane == 0) ((float*)(ws + OFF_CTL + CTL_RSTD))[row] = rs;
}


namespace pg8 {
#define PG8_LAS __attribute__((address_space(3)))
typedef short bf16x8 __attribute__((ext_vector_type(8)));
typedef float f32x4 __attribute__((ext_vector_type(4)));
typedef unsigned u32x4 __attribute__((ext_vector_type(4)));
constexpr int BM = 256, BK = 64, HALF = 128, HTB = HALF * BK * 2, STAGE_BYTES = 8 * HTB, NXCD = 8, WGM = 8;
__host__ __device__ __forceinline__ int lds_byte(int r, int c) { const int st = (r >> 4) * 2 + (c >> 5), rr = r & 15, cc = c & 31, ob = rr * 64 + cc * 2; return st * 1024 + (ob ^ (((ob >> 9) & 1) << 5)); }
__host__ __device__ __forceinline__ void stage_rc(int b, int& R, int& C) { const int st = b / 1024, sb = b % 1024, swz = sb ^ (((sb >> 9) & 1) << 5); R = (st >> 1) * 16 + swz / 64; C = (st & 1) * 32 + (swz % 64) / 2; }
__host__ __device__ __forceinline__ int perm32(int rho) { const int n = rho >> 4, i = rho & 15; return 8 * (i >> 2) + 4 * n + (i & 3); }
__device__ __forceinline__ unsigned cvt_pk_bf16(float lo, float hi) { unsigned r; asm volatile("v_cvt_pk_bf16_f32 %0, %1, %2" : "=v"(r) : "v"(lo), "v"(hi)); return r; }

struct Unit { int pm, pn; const char* A; const char* B; const int* rows; int aux; int nt; };

__device__ __forceinline__ bool static_tile(int i, int G, int c, int nM, int nN, int& pm, int& pn) {
  const int nwg = nM * nN; const long L = (long)i * G + c; if (L >= nwg) return false;
  int wgid = (int)L; { const int q = nwg / NXCD, r = nwg % NXCD, xcd = wgid % NXCD, off = wgid / NXCD; wgid = (xcd < r ? xcd * (q + 1) : r * (q + 1) + (xcd - r) * q) + off; }
  const int nig = WGM * nN, gid = wgid / nig, fm = gid * WGM, gsz = (nM - fm) < WGM ? (nM - fm) : WGM;
  pm = fm + ((wgid % nig) % gsz); pn = (wgid % nig) / gsz; return true;
}
struct PlainOrder {
  const char* A; const char* Bt; int lda, ldb, nM, nN, G, c, nt;
  __device__ __forceinline__ bool next(int i, Unit& u) const {
    if (!static_tile(i, G, c, nM, nN, u.pm, u.pn)) return false;
    u.A = A + (size_t)u.pm * BM * lda * 2; u.B = Bt + (size_t)u.pn * BM * ldb * 2; u.rows = nullptr; u.aux = 0; u.nt = nt; return true; }
};

__host__ __device__ constexpr int in_tile(int v) {
  constexpr int tab[28] = {13, 15, 17, 21,  14, 16, 18, 22,  2, 5, 19, 23,  6, 10, 20, 24,  7, 11, 0, 3,  8, 12, 1, 4,  9, 25, 0, 0};
  return tab[v]; }
struct InOrder {
  const char* A; const char* Bt; int G, c;
  __device__ __forceinline__ bool next(int i, Unit& u) const {
    int pv; if (!static_tile(i, G, c, T / BM, NZP / BM, u.pm, pv)) return false;
    unsigned long long w0 = 0, w1 = 0, w2 = 0;
#pragma unroll
    for (int k = 0; k < 12; ++k) { w0 |= (unsigned long long)in_tile(k) << (5 * k); w1 |= (unsigned long long)in_tile(12 + k) << (5 * k); if (k < 2) w2 |= (unsigned long long)in_tile(24 + k) << (5 * k); }
    const unsigned long long w = pv < 12 ? w0 : pv < 24 ? w1 : w2; const int sh = 5 * (pv < 12 ? pv : pv < 24 ? pv - 12 : pv - 24);
    u.pn = (int)((w >> sh) & 31ull);
    u.A = A + (size_t)u.pm * BM * 1024 * 2; u.B = Bt + (size_t)u.pn * BM * 1024 * 2; u.rows = nullptr; u.aux = 0; u.nt = 16; return true; }
};

template <class Epi> __device__ __forceinline__ auto epi_keep(const Epi&, const Unit& u) -> decltype(Epi::keep(u)) { return Epi::keep(u); }
template <class Epi, class... X> __device__ __forceinline__ bool epi_keep(const Epi&, const Unit&, X...) { return false; }
template <class Epi, class Sched, bool ALIGN_EPI, bool GATHER, int lda, int ldb, int K>
__device__ __forceinline__ void gemm_phase(const int tid, PG8_LAS unsigned char* lds, const Sched& S, const Epi& E, PG8_LAS unsigned char* xlds = nullptr) {
    const int wid = __builtin_amdgcn_readfirstlane(tid >> 6), lane = tid & 63, wr = wid >> 2, wc = wid & 3, fr = lane & 15, fq = lane >> 4;
    unsigned voffA[2][2], voffB[2];
#pragma unroll
    for (int i = 0; i < 2; ++i) { int R, C; stage_rc(tid * 16 + i * 8192, R, C); const int Rb = (R & ~31) + perm32(R & 31);
        voffB[i] = (unsigned)(Rb * ldb + C) * 2u;
#pragma unroll
        for (int h = 0; h < 2; ++h) { voffA[h][i] = (unsigned)((R + (GATHER ? h * HALF : 0)) * lda + C) * 2u; } }
    const size_t hstepA = GATHER ? (size_t)0 : (size_t)HALF * lda * 2;
    const size_t kstep = (size_t)(BK * 2);
    const size_t hstepB = (size_t)HALF * ldb * 2;
    const unsigned ldsw = (unsigned)wid * 1024u;
    const int aoff = lds_byte(wr * 64 + fr, fq * 8), boff = lds_byte(wc * 32 + fr, fq * 8);
#define PG8_SA(b, h) (((b) * 2 + (h)) * HTB)
#define PG8_SB(b, h) ((4 + (b) * 2 + (h)) * HTB)
#define PG8_STAGE(bufoff, gbase, voff) do { _Pragma("unroll") for (int _i = 0; _i < 2; ++_i) \
        __builtin_amdgcn_global_load_lds((const unsigned*)((const char*)(gbase) + (voff)[_i]), (PG8_LAS unsigned*)(lds + (bufoff) + ldsw + _i * 8192), 16, 0, 0); } while (0)
#define PG8_LDA(dst, b, h) do { _Pragma("unroll") for (int m = 0; m < 4; ++m) _Pragma("unroll") for (int k = 0; k < 2; ++k) dst[m][k] = *(const PG8_LAS bf16x8*)(lds + PG8_SA(b, h) + aoff + m * 2048 + k * 1024); } while (0)
#define PG8_LDB(dst, b, h) do { _Pragma("unroll") for (int n = 0; n < 2; ++n) _Pragma("unroll") for (int k = 0; k < 2; ++k) dst[n][k] = *(const PG8_LAS bf16x8*)(lds + PG8_SB(b, h) + boff + n * 2048 + k * 1024); } while (0)
#define PG8_MMA(ai, bj, At, Bt) do { __builtin_amdgcn_s_setprio(1); _Pragma("unroll") for (int m = 0; m < 4; ++m) _Pragma("unroll") for (int n = 0; n < 2; ++n) _Pragma("unroll") for (int k = 0; k < 2; ++k) \
        acc[ai][bj][m][n] = __builtin_amdgcn_mfma_f32_16x16x32_bf16(Bt[n][k], At[m][k], acc[ai][bj][m][n], 0, 0, 0); __builtin_amdgcn_s_setprio(0); } while (0)
#define PG8_WAIT_V(n) asm volatile("s_waitcnt vmcnt(" #n ")" ::: "memory")
#define PG8_WAIT_L(n) asm volatile("s_waitcnt lgkmcnt(" #n ")" ::: "memory")
#define PG8_BAR __builtin_amdgcn_s_barrier()
#define PG8_SCHED __builtin_amdgcn_sched_barrier(0)
#define PG8_GATHER_OFFS(dst, u) do { if (GATHER) { _Pragma("unroll") for (int _i = 0; _i < 2; ++_i) { int _R, _C; stage_rc(tid * 16 + _i * 8192, _R, _C); \
        _Pragma("unroll") for (int _h = 0; _h < 2; ++_h) { const int _r = _h * HALF + _R; const int _e = _r < (u).aux ? ((u).rows[_r] >> 1) : 0; dst[_h][_i] = (unsigned)(_e * lda + _C) * 2u; } } } } while (0)
    Unit cur, nxt; int ui = 0;
    if (!S.next(0, cur)) return;
    PG8_GATHER_OFFS(voffA, cur);
    f32x4 acc[2][2][4][2];
#pragma unroll
    for (int a = 0; a < 2; ++a)
#pragma unroll
        for (int b = 0; b < 2; ++b)
#pragma unroll
            for (int m = 0; m < 4; ++m)
#pragma unroll
                for (int n = 0; n < 2; ++n) acc[a][b][m][n] = (f32x4){0.f, 0.f, 0.f, 0.f};
    bf16x8 At[4][2], B0[2][2], B1[2][2];
    const char* cA = cur.A; const char* cB = cur.B;
    PG8_STAGE(PG8_SB(0, 0), cB, voffB); PG8_STAGE(PG8_SB(0, 1), cB + hstepB, voffB); PG8_STAGE(PG8_SA(0, 0), cA, voffA[0]); PG8_STAGE(PG8_SA(0, 1), cA + hstepA, voffA[1]);
    if (wr == 1) PG8_BAR;
    PG8_WAIT_V(2); PG8_BAR;
    PG8_STAGE(PG8_SB(1, 0), cB + kstep, voffB); PG8_STAGE(PG8_SA(1, 0), cA + kstep, voffA[0]); PG8_STAGE(PG8_SB(1, 1), cB + hstepB + kstep, voffB);
    PG8_WAIT_V(6); PG8_BAR;
    for (;;) {
        const bool has_next = S.next(ui + 1, nxt);
        const char* nA = has_next ? nxt.A : cA; const char* nB = has_next ? nxt.B : cB;

        const int nt = cur.nt;
#pragma unroll 1
        for (int t = 0; t < nt; t += 2) {
            const bool last = (t == nt - 2);
            const char* a1 = cA + (size_t)(t + 1) * kstep;
            const char* a2 = last ? nA : cA + (size_t)(t + 2) * kstep; const char* b2 = last ? nB : cB + (size_t)(t + 2) * kstep;
            const char* a3 = a2 + kstep; const char* b3 = b2 + kstep;

            PG8_LDB(B0, 0, 0); PG8_LDB(B1, 0, 1); PG8_SCHED; PG8_LDA(At, 0, 0); PG8_STAGE(PG8_SA(1, 1), a1 + hstepA, voffA[1]);
            if (GATHER && last && has_next) PG8_GATHER_OFFS(voffA, nxt);
            PG8_WAIT_V(8); PG8_WAIT_L(0); PG8_BAR; PG8_MMA(0, 0, At, B0); PG8_MMA(0, 1, At, B1); PG8_BAR; PG8_SCHED;
            PG8_LDA(At, 0, 1); PG8_STAGE(PG8_SB(0, 0), b2, voffB); PG8_STAGE(PG8_SB(0, 1), b2 + hstepB, voffB); PG8_STAGE(PG8_SA(0, 0), a2, voffA[0]);
            PG8_WAIT_V(8); PG8_WAIT_L(0); PG8_BAR; PG8_MMA(1, 0, At, B0); PG8_MMA(1, 1, At, B1); PG8_BAR; PG8_SCHED;
            PG8_LDB(B0, 1, 0); PG8_LDB(B1, 1, 1); PG8_SCHED; PG8_LDA(At, 1, 0); PG8_STAGE(PG8_SA(0, 1), a2 + hstepA, voffA[1]);
            PG8_WAIT_V(8); PG8_WAIT_L(0); PG8_BAR; PG8_MMA(0, 0, At, B0); PG8_MMA(0, 1, At, B1); PG8_BAR; PG8_SCHED;
            PG8_LDA(At, 1, 1); PG8_STAGE(PG8_SB(1, 0), b3, voffB); PG8_STAGE(PG8_SB(1, 1), b3 + hstepB, voffB); PG8_STAGE(PG8_SA(1, 0), a3, voffA[0]);
            PG8_WAIT_V(8); PG8_WAIT_L(0); PG8_BAR; PG8_MMA(1, 0, At, B0); PG8_MMA(1, 1, At, B1); PG8_BAR; PG8_SCHED;
        }
        if constexpr (ALIGN_EPI) { if (wr == 0) PG8_BAR; }
        { int fr_e = fr, fq_e = fq; asm volatile("" : "+v"(fr_e), "+v"(fq_e)); E(acc, cur, wr, wc, fr_e, fq_e); }
        if (!has_next) break;
        if (!epi_keep<Epi>(E, cur)) {
#pragma unroll
        for (int a = 0; a < 2; ++a)
#pragma unroll
            for (int b = 0; b < 2; ++b)
#pragma unroll
                for (int m = 0; m < 4; ++m)
#pragma unroll
                    for (int n = 0; n < 2; ++n) acc[a][b][m][n] = (f32x4){0.f, 0.f, 0.f, 0.f};
        }
        cur = nxt; cA = nA; cB = nB; ++ui;

        if constexpr (ALIGN_EPI) { if (wr == 1) PG8_BAR; }
    }
    PG8_WAIT_V(0);
    if constexpr (!ALIGN_EPI) { if (wr == 0) PG8_BAR; }
    PG8_BAR;
#undef PG8_SA
#undef PG8_SB
#undef PG8_STAGE
#undef PG8_LDA
#undef PG8_LDB
#undef PG8_MMA
#undef PG8_WAIT_V
#undef PG8_WAIT_L
#undef PG8_BAR
#undef PG8_SCHED
#undef PG8_GATHER_OFFS
}

__device__ __forceinline__ u32x4 pack8(const f32x4 v0, const f32x4 v1) { u32x4 w; w.x = cvt_pk_bf16(v0[0], v0[1]); w.y = cvt_pk_bf16(v0[2], v0[3]); w.z = cvt_pk_bf16(v1[0], v1[1]); w.w = cvt_pk_bf16(v1[2], v1[3]); return w; }
__device__ __forceinline__ void unpack8v(const u32x4 w, f32x4& v0, f32x4& v1) {
  v0[0] = __uint_as_float(w.x << 16); v0[1] = __uint_as_float(w.x & 0xffff0000u); v0[2] = __uint_as_float(w.y << 16); v0[3] = __uint_as_float(w.y & 0xffff0000u);
  v1[0] = __uint_as_float(w.z << 16); v1[1] = __uint_as_float(w.z & 0xffff0000u); v1[2] = __uint_as_float(w.w << 16); v1[3] = __uint_as_float(w.w & 0xffff0000u); }

__device__ __forceinline__ void rope8(f32x4& v0, f32x4& v1, const float* ct, const float* st, int xorm, bool first, bool active, int lane) {
  f32x4 p0, p1;
#pragma unroll
  for (int j = 0; j < 4; ++j) { p0[j] = __int_as_float(__builtin_amdgcn_ds_bpermute((lane ^ xorm) << 2, __float_as_int(v0[j]))); p1[j] = __int_as_float(__builtin_amdgcn_ds_bpermute((lane ^ xorm) << 2, __float_as_int(v1[j]))); }
  const f32x4 c0 = *(const f32x4*)ct, c1 = *(const f32x4*)(ct + 4), s0 = *(const f32x4*)st, s1 = *(const f32x4*)(st + 4);
  const float sg = first ? -1.f : 1.f;
  const f32x4 n0 = v0 * c0 + (p0 * s0) * sg, n1 = v1 * c1 + (p1 * s1) * sg;
  if (active) { v0 = n0; v1 = n1; }
}
enum { K_PLAIN = 0, K_SIG, K_ROPE_A, K_ROPE_I, K_ROPE_B, K_SSQ };
struct EpiIn {
  unsigned char* ws;
  __device__ __forceinline__ void operator()(const f32x4 (&acc)[2][2][4][2], const Unit& u, int wr, int wc, int fr, int fq) const {
    const float* rstd = (const float*)(ws + OFF_CTL + CTL_RSTD); const float* rt = (const float*)(ws + OFF_CTL + CTL_ROPE);
    const int pn = u.pn, lane = fr + 16 * fq;
    float rsv[8];
#pragma unroll
    for (int k = 0; k < 8; ++k) rsv[k] = rstd[u.pm * BM + (k >> 2) * HALF + wr * 64 + (k & 3) * 16 + fr];
#pragma unroll
    for (int bj = 0; bj < 2; ++bj) {
      bf16_t* base; int pitch, lc, kind = K_PLAIN, rg = 0; float* ssq = nullptr;
      const int gc = bj * 128 + wc * 32;
      if (pn < 2) { base = (bf16_t*)(ws + OFF_AQ); pitch = 512; lc = pn * 256 + gc; if (wc == 0) kind = K_ROPE_A; }
      else if (pn == 2) { base = (bf16_t*)(ws + (bj == 0 ? OFF_AK : OFF_AV)); pitch = 128; lc = wc * 32; if (bj == 0 && wc == 0) kind = K_ROPE_A; }
      else if (pn < 5) { base = (bf16_t*)(ws + OFF_AIQ); pitch = 512; lc = (pn - 3) * 256 + gc; if ((wc & 1) == 0) kind = K_ROPE_I; }
      else if (pn == 5) { if (bj == 0) { if (wc < 2) { base = (bf16_t*)(ws + OFF_AIK); pitch = 64; lc = wc * 32; if (wc == 0) kind = K_ROPE_I; }
                                         else { base = (bf16_t*)(ws + OFF_BKR); pitch = 64; lc = (wc - 2) * 32; kind = K_ROPE_B; rg = wc - 2; } }
                          else { base = (bf16_t*)(ws + OFF_BC); pitch = 384; lc = 256 + wc * 32; kind = K_SSQ; ssq = (float*)(ws + OFF_CTL + CTL_SSQKV); } }
      else if (pn == 6) { base = (bf16_t*)(ws + OFF_BC); pitch = 384; lc = gc; kind = K_SSQ; ssq = (float*)(ws + OFF_CTL + CTL_SSQQ) + bj * 4 * T; }
      else if (pn < 9) { base = (bf16_t*)(ws + OFF_CQ); pitch = 512; lc = (pn - 7) * 256 + gc; }
      else if (pn < 11) { base = (bf16_t*)(ws + OFF_CK); pitch = 512; lc = (pn - 9) * 256 + gc; }
      else if (pn < 13) { base = (bf16_t*)(ws + OFF_CV); pitch = 512; lc = (pn - 11) * 256 + gc; }
      else if (pn < 25) { base = (bf16_t*)(ws + OFF_G); pitch = 3072; lc = (pn - 13) * 256 + gc; kind = K_SIG; }
      else { base = (bf16_t*)(ws + OFF_AIWB); pitch = 256; lc = gc; }
#pragma unroll
      for (int ai = 0; ai < 2; ++ai)
#pragma unroll
        for (int m = 0; m < 4; ++m) {
          const int row = u.pm * BM + ai * HALF + wr * 64 + m * 16 + fr; const float rs = rsv[ai * 4 + m]; const int pos = row & (SEQ - 1);
          f32x4 v0 = acc[ai][bj][m][0] * rs, v1 = acc[ai][bj][m][1] * rs;
          if (kind == K_SIG) {
#pragma unroll
            for (int j = 0; j < 4; ++j) { v0[j] = __builtin_amdgcn_rcpf(1.f + __expf(-v0[j])); v1[j] = __builtin_amdgcn_rcpf(1.f + __expf(-v1[j])); } }
          else if (kind == K_ROPE_A) rope8(v0, v1, rt + RT_COSA + pos * 16 + 8 * (fq & 1), rt + RT_SINA + pos * 16 + 8 * (fq & 1), 32, fq < 2, true, lane);
          else if (kind == K_ROPE_I) rope8(v0, v1, rt + RT_COSI + pos * 8, rt + RT_SINI + pos * 8, 16, fq == 0, fq < 2, lane);
          else if (kind == K_ROPE_B) rope8(v0, v1, rt + RT_COSB + pos * 32 + 16 * rg + 8 * (fq & 1), rt + RT_SINB + pos * 32 + 16 * rg + 8 * (fq & 1), 32, fq < 2, true, lane);
          else if (kind == K_SSQ) { float q = 0.f;
#pragma unroll
            for (int j = 0; j < 4; ++j) q += v0[j] * v0[j] + v1[j] * v1[j];
            q += __int_as_float(__builtin_amdgcn_ds_bpermute((lane ^ 16) << 2, __float_as_int(q))); q += __int_as_float(__builtin_amdgcn_ds_bpermute((lane ^ 32) << 2, __float_as_int(q)));
            if (fq == 0) ssq[(size_t)row * 4 + wc] = q; }
          *(u32x4*)(base + (size_t)row * pitch + lc + 8 * fq) = pack8(v0, v1);
        }
    }
  }
};
template <int NP, int W, bool ROPE>
struct EpiUp {
  unsigned char* ws; bf16_t* O; int pitch; const float* ssq;
  __device__ __forceinline__ void operator()(const f32x4 (&acc)[2][2][4][2], const Unit& u, int wr, int wc, int fr, int fq) const {
    const float* rt = (const float*)(ws + OFF_CTL + CTL_ROPE); const int lane = fr + 16 * fq;
#pragma unroll
    for (int ai = 0; ai < 2; ++ai) {
      float rsv[4];
#pragma unroll
      for (int k = 0; k < 4; ++k) { const int row = u.pm * BM + ai * HALF + wr * 64 + k * 16 + fr; float q = 0.f;
#pragma unroll
        for (int p = 0; p < NP; ++p) { const f32x4 s4 = *(const f32x4*)(ssq + (size_t)p * 4 * T + (size_t)row * 4); q += (s4[0] + s4[1]) + (s4[2] + s4[3]); }
        rsv[k] = rsqrtf(q * (1.f / W) + EPS); }
#pragma unroll
      for (int m = 0; m < 4; ++m) { const int row = u.pm * BM + ai * HALF + wr * 64 + m * 16 + fr; const int pos = row & (SEQ - 1);
        const float rs = rsv[m];
#pragma unroll
        for (int bj = 0; bj < 2; ++bj) { f32x4 v0 = acc[ai][bj][m][0] * rs, v1 = acc[ai][bj][m][1] * rs;
          if (ROPE && u.pn == 2) { const int rg = wc & 1; rope8(v0, v1, rt + RT_COSB + pos * 32 + 16 * rg + 8 * (fq & 1), rt + RT_SINB + pos * 32 + 16 * rg + 8 * (fq & 1), 32, fq < 2, true, lane); }
          *(u32x4*)(O + (size_t)row * pitch + u.pn * BM + bj * HALF + wc * 32 + 8 * fq) = pack8(v0, v1); } } }
  }
};
struct EpiProj {
  unsigned char* ws;
  static __device__ __forceinline__ bool keep(const Unit& u) { return u.aux < 2; }
  __device__ __forceinline__ void operator()(f32x4 (&acc)[2][2][4][2], const Unit& u, int wr, int wc, int fr, int fq) const {
    const int b = u.aux;
#pragma unroll
    for (int ai = 0; ai < 2; ++ai) {
      u32x4 gn[4][2], gd[4][2];
#pragma unroll
      for (int m = 0; m < 4; ++m) { const int row = u.pm * BM + ai * HALF + wr * 64 + m * 16 + fr;
#pragma unroll
        for (int bj = 0; bj < 2; ++bj) { const int col = u.pn * BM + bj * HALF + wc * 32 + 8 * fq;
          gn[m][bj] = *(const u32x4*)((const bf16_t*)(ws + OFF_G) + (size_t)row * 3072 + b * 1024 + col);
          if (b < 2) gd[m][bj] = *(const u32x4*)((const bf16_t*)(ws + OFF_G) + (size_t)row * 3072 + (b + 1) * 1024 + col); } }
#pragma unroll
      for (int m = 0; m < 4; ++m) { const int row = u.pm * BM + ai * HALF + wr * 64 + m * 16 + fr;
#pragma unroll
        for (int bj = 0; bj < 2; ++bj) { const int col = u.pn * BM + bj * HALF + wc * 32 + 8 * fq;
          f32x4 g0, g1; unpack8v(gn[m][bj], g0, g1);
          if (b < 2) { f32x4 d0, d1; unpack8v(gd[m][bj], d0, d1);
#pragma unroll
            for (int j = 0; j < 4; ++j) { g0[j] *= __builtin_amdgcn_rcpf(fmaxf(d0[j], 1e-30f)); g1[j] *= __builtin_amdgcn_rcpf(fmaxf(d1[j], 1e-30f)); } }
          acc[ai][bj][m][0] *= g0; acc[ai][bj][m][1] *= g1;
          if (b == 2) *(u32x4*)((bf16_t*)(ws + OFF_MIX) + (size_t)row * 1024 + col) = pack8(acc[ai][bj][m][0], acc[ai][bj][m][1]); } }
    }
  }
};
struct EpiOut {
  float* x; bf16_t* xb;
  __device__ __forceinline__ void operator()(const f32x4 (&acc)[2][2][4][2], const Unit& u, int wr, int wc, int fr, int fq) const {
#pragma unroll
    for (int ai = 0; ai < 2; ++ai)
#pragma unroll
    for (int mh = 0; mh < 2; ++mh) {
      f32x4 xv[2][2][2];
#pragma unroll
      for (int m2 = 0; m2 < 2; ++m2) { const int m = mh * 2 + m2, row = u.pm * BM + ai * HALF + wr * 64 + m * 16 + fr;
#pragma unroll
        for (int bj = 0; bj < 2; ++bj) { const size_t off = (size_t)row * DM + u.pn * BM + bj * HALF + wc * 32 + 8 * fq; xv[m2][bj][0] = *(const f32x4*)(x + off); xv[m2][bj][1] = *(const f32x4*)(x + off + 4); } }
#pragma unroll
      for (int m2 = 0; m2 < 2; ++m2) { const int m = mh * 2 + m2, row = u.pm * BM + ai * HALF + wr * 64 + m * 16 + fr;
#pragma unroll
        for (int bj = 0; bj < 2; ++bj) { const size_t off = (size_t)row * DM + u.pn * BM + bj * HALF + wc * 32 + 8 * fq;
          const f32x4 a0 = xv[m2][bj][0] + acc[ai][bj][m][0], a1 = xv[m2][bj][1] + acc[ai][bj][m][1];
          *(f32x4*)(x + off) = a0; *(f32x4*)(x + off + 4) = a1; *(u32x4*)(xb + off) = pack8(a0, a1); } }
    }
  }
};
struct EpiUpBoth {
  unsigned char* ws;
  __device__ __forceinline__ void operator()(const f32x4 (&acc)[2][2][4][2], const Unit& u, int wr, int wc, int fr, int fq) const {
    if (u.aux == 0) { EpiUp<2, 256, true> e{ws, (bf16_t*)(ws + OFF_QB), 768, (const float*)(ws + OFF_CTL + CTL_SSQQ)}; e(acc, u, wr, wc, fr, fq); }
    else { EpiUp<1, 128, false> e{ws, (bf16_t*)(ws + OFF_KVB), 1024, (const float*)(ws + OFF_CTL + CTL_SSQKV)}; e(acc, u, wr, wc, fr, fq); }
  }
};
struct UpOrder {
  unsigned char* ws; int G, c;
  __device__ __forceinline__ bool next(int i, Unit& u) const {
    const int L = i * G + c; if (L >= 448) return false;
    u.rows = nullptr;
    if (L < 192) { u.pm = L / 3; u.pn = L % 3; u.aux = 0; u.nt = 4; u.A = (const char*)(ws + OFF_BC) + (size_t)u.pm * BM * 384 * 2; u.B = (const char*)(ws + OFF_WATT + WA_UQ) + (size_t)u.pn * BM * 256 * 2; }
    else { const int k = L - 192; u.pm = k >> 2; u.pn = k & 3; u.aux = 1; u.nt = 2; u.A = (const char*)(ws + OFF_BC) + (size_t)u.pm * BM * 384 * 2 + 512; u.B = (const char*)(ws + OFF_WATT + WA_UKV) + (size_t)u.pn * BM * 256 * 2; }
    return true; }
};
struct ProjOrder {
  unsigned char* ws; int G, c;
  __device__ __forceinline__ bool next(int i, Unit& u) const {
    const int b = i % 3; if (!static_tile(i / 3, G, c, T / BM, 4, u.pm, u.pn)) return false;
    const size_t oa = b == 0 ? OFF_AQ : b == 1 ? OFF_AIQ : OFF_CQ;
    u.A = (const char*)(ws + oa) + (size_t)u.pm * BM * 512 * 2; u.B = (const char*)(ws + OFF_WATT + WA_P) + ((size_t)b * 1024 + (size_t)u.pn * BM) * 512 * 2; u.rows = nullptr; u.aux = b; u.nt = 8; return true; }
};

__device__ __forceinline__ void moe_build_map(unsigned* cntp, PG8_LAS unsigned* tab, int tid) {
  if (tid < 64) { const int lane = tid;
    const unsigned c = lane < 32 ? __hip_atomic_load(cntp + lane, __ATOMIC_RELAXED, __HIP_MEMORY_SCOPE_AGENT) : 0u;
    const unsigned nt = (c + 255u) >> 8; unsigned incl = nt;
#pragma unroll
    for (int o = 1; o < 32; o <<= 1) { const unsigned v = (unsigned)__builtin_amdgcn_ds_bpermute(((lane - o) & 63) << 2, (int)incl); if ((lane & 31) >= o) incl += v; }
    const unsigned start = incl - nt;
    if (lane < 32) for (unsigned j = 0; j < nt; ++j) { unsigned valid = c - j * 256u; valid = valid > 256u ? 256u : valid; tab[start + j] = (unsigned)lane | (j << 8) | (valid << 16); }
    if (lane == 31) tab[255] = incl; }
  __syncthreads();
}
template <int NPN, bool DOWN>
struct MoeOrder {
  unsigned char* ws; int G, c; const PG8_LAS unsigned* tab; int lo, hi;
  __device__ __forceinline__ bool next(int i, Unit& u) const {
    const int L = lo + i * G + c, tile = L / NPN, pn = L % NPN; const int total = __builtin_amdgcn_readfirstlane((int)tab[255]); if (c < 0 || L >= hi || tile >= total) return false;
    const unsigned rec = (unsigned)__builtin_amdgcn_readfirstlane((int)tab[tile]);
    const int e = rec & 255u, j = (rec >> 8) & 255u, valid = rec >> 16;
    u.pm = tile; u.pn = pn; u.aux = valid; u.nt = DOWN ? 4 : 16; u.rows = (const int*)(ws + OFF_LIST) + (size_t)e * T + j * 256;
    if (!DOWN) { u.A = (const char*)(ws + OFF_XB); u.B = (const char*)(ws + OFF_WGU) + ((size_t)e * 512 + (size_t)pn * 256) * 1024 * 2; }
    else { u.A = (const char*)(ws + OFF_H) + (size_t)tile * 256 * 256 * 2; u.B = (const char*)(ws + OFF_WD) + ((size_t)e * 1024 + (size_t)pn * 256) * 256 * 2; }
    return true; }
};
struct EpiGU {
  unsigned char* ws;
  __device__ __forceinline__ void operator()(const f32x4 (&acc)[2][2][4][2], const Unit& u, int wr, int wc, int fr, int fq) const {
    const float* rstd = (const float*)(ws + OFF_CTL + CTL_RSTD); const float* tokw = (const float*)(ws + OFF_CTL + CTL_TOKW);
    int ent[8]; float rs[8], wv[8];
#pragma unroll
    for (int k = 0; k < 8; ++k) { const int r = (k >> 2) * HALF + wr * 64 + (k & 3) * 16 + fr; ent[k] = u.rows[r < u.aux ? r : u.aux - 1]; }
#pragma unroll
    for (int k = 0; k < 8; ++k) { rs[k] = rstd[ent[k] >> 1]; wv[k] = tokw[ent[k]]; }
#pragma unroll
    for (int ai = 0; ai < 2; ++ai)
#pragma unroll
      for (int m = 0; m < 4; ++m) { const int r = ai * HALF + wr * 64 + m * 16 + fr; const int k = ai * 4 + m;
        { const float rsk = rs[k], w = wv[k];
          f32x4 h0, h1;
#pragma unroll
          for (int j = 0; j < 4; ++j) { const float a0 = acc[ai][0][m][0][j] * rsk, a1 = acc[ai][0][m][1][j] * rsk;
            h0[j] = a0 * __builtin_amdgcn_rcpf(1.f + __expf(-a0)) * (acc[ai][1][m][0][j] * rsk) * w; h1[j] = a1 * __builtin_amdgcn_rcpf(1.f + __expf(-a1)) * (acc[ai][1][m][1][j] * rsk) * w; }
          *(u32x4*)((bf16_t*)(ws + OFF_H) + ((size_t)u.pm * 256 + r) * 256 + u.pn * 128 + wc * 32 + 8 * fq) = pack8(h0, h1); } }
  }
};
struct EpiDown {
  unsigned char* ws;
  __device__ __forceinline__ void operator()(const f32x4 (&acc)[2][2][4][2], const Unit& u, int wr, int wc, int fr, int fq) const {
    int ent[8];
#pragma unroll
    for (int k = 0; k < 8; ++k) { const int r = (k >> 2) * HALF + wr * 64 + (k & 3) * 16 + fr; ent[k] = u.rows[r < u.aux ? r : u.aux - 1]; }
#pragma unroll
    for (int ai = 0; ai < 2; ++ai)
#pragma unroll
      for (int m = 0; m < 4; ++m) { const int r = ai * HALF + wr * 64 + m * 16 + fr;
        { const int entry = r < u.aux ? ent[ai * 4 + m] : 2 * T;
#pragma unroll
          for (int bj = 0; bj < 2; ++bj) *(u32x4*)((bf16_t*)(ws + OFF_Y) + (size_t)entry * 1024 + u.pn * BM + bj * HALF + wc * 32 + 8 * fq) = pack8(acc[ai][bj][m][0], acc[ai][bj][m][1]); } }
  }
};
}

namespace att {
using bf16x8 = __attribute__((ext_vector_type(8))) short;
using s16x4  = __attribute__((ext_vector_type(4))) short;
using f32x16 = __attribute__((ext_vector_type(16))) float;
using u32x4  = __attribute__((ext_vector_type(4))) unsigned;
constexpr int KVBLK = 64;
constexpr float THR = 8.f, NEG = -1e30f, M_INIT = -1e6f;
#define ASBAR() __builtin_amdgcn_sched_barrier(0)
__device__ __forceinline__ constexpr int crow_c(int r) { return (r & 3) + 8 * (r >> 2); }
__device__ __forceinline__ unsigned cvtpk(float lo, float hi) { unsigned r; asm volatile("v_cvt_pk_bf16_f32 %0, %1, %2" : "=v"(r) : "v"(lo), "v"(hi)); return r; }
template <int MODE> struct Cfg {
  static constexpr int DQK = MODE == 1 ? 192 : 128, ND0 = DQK / 16, KP = DQK * 2, SHM_K = 64 * KP;
  static constexpr float SCALE = MODE == 1 ? 0.07216878364870322f : 0.088388347648318440f;
};
template <int MODE>
__device__ __forceinline__ void partialSM(f32x16& p0, f32x16& p1, float& m_reg, float& mn, float& alpha) {
  constexpr float SC = Cfg<MODE>::SCALE, C = SC * 1.4426950408889634f;
#pragma unroll
  for (int r = 0; r < 16; ++r) { p0[r] *= C; p1[r] *= C; }
  float pmax = p0[0];
#pragma unroll
  for (int r = 1; r < 16; ++r) pmax = fmaxf(pmax, p0[r]);
#pragma unroll
  for (int r = 0; r < 16; ++r) pmax = fmaxf(pmax, p1[r]);
  { auto rr = __builtin_amdgcn_permlane32_swap(__float_as_uint(pmax), __float_as_uint(pmax), false, false);
    pmax = fmaxf(__uint_as_float(rr[0]), __uint_as_float(rr[1])); }
  if (__builtin_expect(__all(pmax - m_reg <= THR * 1.4426950408889634f), 1)) { mn = m_reg; alpha = 1.f; }
  else { mn = fmaxf(m_reg, pmax); alpha = __builtin_amdgcn_exp2f(m_reg - mn); m_reg = mn; }
#pragma unroll
  for (int r = 0; r < 16; ++r) { p0[r] -= mn; p1[r] -= mn; }
#pragma unroll
  for (int r = 0; r < 16; ++r) p0[r] = __builtin_amdgcn_exp2f(p0[r]);
}
__device__ __forceinline__ void finishSM(f32x16& p0, f32x16& p1, float alpha, float& l_reg, bf16x8& pa0, bf16x8& pa1, bf16x8& pa2, bf16x8& pa3) {
#pragma unroll
  for (int r = 0; r < 16; ++r) p1[r] = __builtin_amdgcn_exp2f(p1[r]);
  float ps = 0;
#pragma unroll
  for (int r = 0; r < 16; ++r) ps += p0[r];
#pragma unroll
  for (int r = 0; r < 16; ++r) ps += p1[r];
  { auto rr = __builtin_amdgcn_permlane32_swap(__float_as_uint(ps), __float_as_uint(ps), false, false);
    ps = __uint_as_float(rr[0]) + __uint_as_float(rr[1]); }
  l_reg = l_reg * alpha + ps;
#define PK4(P, BASE, OUT) do { unsigned a0 = cvtpk(P[BASE + 0], P[BASE + 1]), a1 = cvtpk(P[BASE + 2], P[BASE + 3]);   \
    unsigned b0 = cvtpk(P[BASE + 4], P[BASE + 5]), b1 = cvtpk(P[BASE + 6], P[BASE + 7]);                              \
    auto r0 = __builtin_amdgcn_permlane32_swap(a0, b0, false, false); auto r1 = __builtin_amdgcn_permlane32_swap(a1, b1, false, false); \
    u32x4 w = {r0[0], r1[0], r0[1], r1[1]}; OUT = *reinterpret_cast<bf16x8*>(&w); } while (0)
  PK4(p0, 0, pa0); PK4(p0, 8, pa1); PK4(p1, 0, pa2); PK4(p1, 8, pa3);
#undef PK4
}
#define KSWZ(row, colB, KP) ((row) * (KP) + ((colB) ^ (((row) & 7) << 4)))
template <int MODE>
__device__ __forceinline__ void qkt(f32x16& p0, f32x16& p1, const char* Ks, const bf16x8* qr, const char* qx  , int r32, int hi) {
  constexpr int KP = Cfg<MODE>::KP;
  p0 = f32x16{}; p1 = f32x16{};
#pragma unroll
  for (int d0 = 0; d0 < Cfg<MODE>::ND0; ++d0) { const int cb = (d0 * 16 + hi * 8) * 2;
    bf16x8 b0 = *reinterpret_cast<const bf16x8*>(Ks + KSWZ(r32, cb, KP));
    bf16x8 b1 = *reinterpret_cast<const bf16x8*>(Ks + KSWZ(32 + r32, cb, KP));
    const bf16x8 q = d0 < 8 ? qr[d0 < 8 ? d0 : 0] : *reinterpret_cast<const bf16x8*>(qx + (d0 - 8) * 32);
    p0 = __builtin_amdgcn_mfma_f32_32x32x16_bf16(b0, q, p0, 0, 0, 0);
    p1 = __builtin_amdgcn_mfma_f32_32x32x16_bf16(b1, q, p1, 0, 0, 0); }
}
__device__ __forceinline__ int v_st(int k, int c) { const int kk = (k & ~0xC) | ((k & 4) << 1) | ((k & 8) >> 1); return ((kk >> 3) * 4 + (c >> 5)) * 512 + ((kk & 7) * 32 + (c & 31)) * 2; }
__device__ __forceinline__ int v_rd_base(int lane) { return ((lane & 3) << 3) | (((lane >> 2) & 3) << 6) | (((lane >> 4) & 1) << 5) | (((lane >> 5) & 1) << 8); }
constexpr int v_rd_off(int d0, int ks, int half) { return d0 * 512 + ks * 4096 + half * 2048; }
template <int OFF> __device__ __forceinline__ s16x4 tr_read(int vb) {
  s16x4 r; asm volatile("ds_read_b64_tr_b16 %0, %1 offset:%2" : "=&v"(r) : "v"(vb), "i"(OFF) : "memory"); return r;
}
template <int D0> __device__ __forceinline__ void pv_one(f32x16& od, int vb, bf16x8 pa0, bf16x8 pa1, bf16x8 pa2, bf16x8 pa3) {
  const s16x4 l0 = tr_read<v_rd_off(D0, 0, 0)>(vb), h0 = tr_read<v_rd_off(D0, 0, 1)>(vb), l1 = tr_read<v_rd_off(D0, 1, 0)>(vb), h1 = tr_read<v_rd_off(D0, 1, 1)>(vb);
  const s16x4 l2 = tr_read<v_rd_off(D0, 2, 0)>(vb), h2 = tr_read<v_rd_off(D0, 2, 1)>(vb), l3 = tr_read<v_rd_off(D0, 3, 0)>(vb), h3 = tr_read<v_rd_off(D0, 3, 1)>(vb);
  asm volatile("s_waitcnt lgkmcnt(0)" ::: "memory"); ASBAR();
#define PK(L, H) (bf16x8){L[0], L[1], L[2], L[3], H[0], H[1], H[2], H[3]}
  od = __builtin_amdgcn_mfma_f32_32x32x16_bf16(pa0, PK(l0, h0), od, 0, 0, 0);
  od = __builtin_amdgcn_mfma_f32_32x32x16_bf16(pa1, PK(l1, h1), od, 0, 0, 0);
  od = __builtin_amdgcn_mfma_f32_32x32x16_bf16(pa2, PK(l2, h2), od, 0, 0, 0);
  od = __builtin_amdgcn_mfma_f32_32x32x16_bf16(pa3, PK(l3, h3), od, 0, 0, 0);
#undef PK
}
__device__ __forceinline__ void pv_d0(f32x16* o, int vb, bf16x8 pa0, bf16x8 pa1, bf16x8 pa2, bf16x8 pa3) {
  pv_one<0>(o[0], vb, pa0, pa1, pa2, pa3); pv_one<1>(o[1], vb, pa0, pa1, pa2, pa3); pv_one<2>(o[2], vb, pa0, pa1, pa2, pa3); pv_one<3>(o[3], vb, pa0, pa1, pa2, pa3);
}
template <int MODE>
__device__ __forceinline__ void post_scores(f32x16& p0, f32x16& p1, int jt, int jlo_w, int jhi_w, int cw, const char* xl, int qloc, int hi) {
  if (MODE == 0) {
    const uint2 w = *reinterpret_cast<const uint2*>(xl + qloc * 264 + jt * 8);
    const unsigned wl = w.x >> (4 * hi), wh = w.y >> (4 * hi);
#pragma unroll
    for (int r = 0; r < 16; ++r) { const unsigned m0 = (unsigned)__builtin_amdgcn_sbfe((int)wl, crow_c(r), 1), m1 = (unsigned)__builtin_amdgcn_sbfe((int)wh, crow_c(r), 1);
      p0[r] = __uint_as_float((__float_as_uint(p0[r]) & m0) | (__float_as_uint(NEG) & ~m0)); p1[r] = __uint_as_float((__float_as_uint(p1[r]) & m1) | (__float_as_uint(NEG) & ~m1)); }
  } else {
    if (jt > jhi_w || jt < jlo_w) {
#pragma unroll
      for (int r = 0; r < 16; ++r) { p0[r] = NEG; p1[r] = NEG; }
    } else if (MODE == 2) {
      const float* tab = reinterpret_cast<const float*>(xl);
      const int dj = cw - jt;
      if (dj >= 3) { const float bf = tab[256];
#pragma unroll
        for (int r = 0; r < 16; ++r) { p0[r] += bf; p1[r] += bf; } }
      else { const int dbase = dj * 64 + qloc - 4 * hi;
#pragma unroll
        for (int r = 0; r < 16; ++r) { int d0 = dbase - crow_c(r), d1 = d0 - 32; d0 = d0 > 128 ? 128 : d0; d1 = d1 > 128 ? 128 : d1; p0[r] += tab[d0 + 128]; p1[r] += tab[d1 + 128]; } }
    }
  }
}
template <int MODE>
__device__ __forceinline__ void attn_unit(unsigned char* ws, const float* relb, const int tid, char* lds, const int b, const int hx, const int cg, const bool dry = false) {
  using C = Cfg<MODE>;
  constexpr int KP = C::KP, SHM_K = C::SHM_K, SHM_V = 16384, ND0 = C::ND0;
  const int wid = __builtin_amdgcn_readfirstlane(tid >> 6), lane = tid & 63, r32 = lane & 31, hi = lane >> 5;
  char* V_lds = lds; char* K_lds = lds + 2 * SHM_V;
  float* wsc = reinterpret_cast<float*>(lds + 2 * SHM_V + 2 * SHM_K) + wid * 64; float* li_l = wsc; float* al_l = wsc + 32;
  char* xl = lds + 2 * SHM_V + 2 * SHM_K + 2048;
  const size_t tb = (size_t)b * SEQ;
  const int cw = MODE == 0 ? cg : 4 * cg + (wid >> 1);
  const int qloc = (wid & 1) * 32 + r32;
  const size_t tok = tb + (size_t)cw * 64 + qloc;
  const int j0 = MODE == 2 ? (4 * cg - 8 > 0 ? 4 * cg - 8 : 0) : 0;
  const int NT = MODE == 0 ? ((cg + 2) & ~1) : (4 * cg + 4 - j0);
  const int jlo_w = MODE == 2 ? (cw - 8 > 0 ? cw - 8 : 0) : 0, jhi_w = cw;
  const bf16_t* Kh; const bf16_t* Vh; const bf16_t* Kr = nullptr; int LDK;
  if (MODE == 0) { Kh = (const bf16_t*)(ws + OFF_AK) + tb * 128; Vh = (const bf16_t*)(ws + OFF_AV) + tb * 128; LDK = 128; }
  else if (MODE == 1) { Kh = (const bf16_t*)(ws + OFF_KVB) + tb * 1024 + hx * 256; Vh = Kh + 128; Kr = (const bf16_t*)(ws + OFF_BKR) + tb * 64; LDK = 1024; }
  else { Kh = (const bf16_t*)(ws + OFF_CK) + tb * 512 + hx * 128; Vh = (const bf16_t*)(ws + OFF_CV) + tb * 512 + hx * 128; LDK = 512; }
  __syncthreads();
  if (MODE == 0) { const uint2* mb = (const uint2*)(ws + OFF_MASK) + (tb + (size_t)cg * 64) * 32;
    for (int i = tid; i < 64 * 32; i += 512) { const int q = i >> 5, j = i & 31; *reinterpret_cast<uint2*>(xl + q * 264 + j * 8) = mb[i]; } }
  if (MODE == 2) { for (int i = tid; i < 257; i += 512) reinterpret_cast<float*>(xl)[i] = relb[hx * 257 + i] * (1.f / C::SCALE); }
  float m_reg = M_INIT, l_reg = 0; f32x16 o[4] = {}; bf16x8 qr[8];
  const char* qx = xl + wid * 4608 + r32 * 144 + hi * 16;
  { const bf16_t* Qw;
    if (MODE == 0) Qw = (const bf16_t*)(ws + OFF_AQ) + tok * 512 + (wid >> 1) * 128 + hi * 8;
    else if (MODE == 1) Qw = (const bf16_t*)(ws + OFF_QB) + tok * 768 + hx * 128 + hi * 8;
    else Qw = (const bf16_t*)(ws + OFF_CQ) + tok * 512 + hx * 128 + hi * 8;
#pragma unroll
    for (int d0 = 0; d0 < 8; ++d0) qr[d0] = *reinterpret_cast<const bf16x8*>(Qw + d0 * 16);
    if (MODE == 1) { const bf16_t* Qr = (const bf16_t*)(ws + OFF_QB) + tok * 768 + 512 + hx * 64 + hi * 8;
#pragma unroll
      for (int d0 = 8; d0 < ND0; ++d0) *reinterpret_cast<bf16x8*>(const_cast<char*>(qx) + (d0 - 8) * 32) = *reinterpret_cast<const bf16x8*>(Qr + (d0 - 8) * 16); } }
  const int sr = tid >> 4, sc = (tid & 15) * 8, vst0 = v_st(sr, sc), vst1 = v_st(32 + sr, sc);
  const int vb0 = (int)(uintptr_t)V_lds + v_rd_base(lane);
  constexpr int NPI = SHM_K / 8192;
  unsigned koff[NPI], kstr[NPI];
#pragma unroll
  for (int i = 0; i < NPI; ++i) { const int L = (i * 8 + wid) * 1024 + lane * 16, row = L / KP, cs = L % KP, colB = cs ^ ((row & 7) << 4);
    if (MODE == 1 && colB >= 256) { koff[i] = (unsigned)(OFF_BKR + (tb + (size_t)j0 * 64 + row) * 128 + (colB - 256)); kstr[i] = 64 * 128; }
    else { koff[i] = (unsigned)((MODE == 0 ? OFF_AK : MODE == 1 ? OFF_KVB : OFF_CK) + (tb + (size_t)j0 * 64 + row) * (size_t)LDK * 2 + (MODE == 0 ? 0 : MODE == 1 ? hx * 512 : hx * 256) + colB); kstr[i] = 64 * LDK * 2; } }
  bf16x8 vs0, vs1;
#define SLOAD(jrel, bf) do { const int k0_ = kbase + (jrel) * KVBLK; \
    vs0 = *reinterpret_cast<const bf16x8*>(&Vh[(size_t)(k0_ + sr) * LDK + sc]); vs1 = *reinterpret_cast<const bf16x8*>(&Vh[(size_t)(k0_ + 32 + sr) * LDK + sc]); \
    _Pragma("unroll") for (int i_ = 0; i_ < NPI; ++i_) { __builtin_amdgcn_global_load_lds((const unsigned*)(ws + koff[i_]), \
        (__attribute__((address_space(3))) unsigned*)(K_lds + (bf) * SHM_K + (i_ * 8 + wid) * 1024), 16, 0, 0); koff[i_] += (MODE == 1 ? kstr[i_] : (unsigned)(64 * LDK * 2)); } } while (0)
#define SWRITE(bf) do { *reinterpret_cast<bf16x8*>(V_lds + (bf) * SHM_V + vst0) = vs0; *reinterpret_cast<bf16x8*>(V_lds + (bf) * SHM_V + vst1) = vs1; } while (0)
#define RESC(a) do { if (__any((a) < 1.f)) { if (hi == 0) al_l[r32] = (a); asm volatile("s_waitcnt lgkmcnt(0)" ::: "memory"); \
    _Pragma("unroll") for (int d = 0; d < 4; ++d) _Pragma("unroll") for (int r = 0; r < 16; ++r) o[d][r] *= al_l[crow_c(r) + 4 * hi]; } } while (0)
#define POST(P0, P1, jrel) post_scores<MODE>(P0, P1, j0 + (jrel), jlo_w, jhi_w, cw, xl, qloc, hi)
  const int kbase = j0 * KVBLK; (void)kbase;
  bf16x8 pa0, pa1, pa2, pa3;
  if (MODE != 2) {
    f32x16 p0, p1; float mn, al;
    SLOAD(0, 0); asm volatile("s_waitcnt vmcnt(0)" ::: "memory"); SWRITE(0); __syncthreads();
    for (int j = 0; j < NT; j += 2) {
      SLOAD(j + 1, 1); ASBAR();
      qkt<MODE>(p0, p1, K_lds, qr, qx, r32, hi); POST(p0, p1, j); partialSM<MODE>(p0, p1, m_reg, mn, al); RESC(al);
      finishSM(p0, p1, al, l_reg, pa0, pa1, pa2, pa3); ASBAR();
      pv_d0(o, vb0, pa0, pa1, pa2, pa3);
      asm volatile("s_waitcnt vmcnt(0)" ::: "memory"); SWRITE(1); __syncthreads();
      const bool more = j + 2 < NT;
      if (more) SLOAD(j + 2, 0);
      ASBAR();
      qkt<MODE>(p0, p1, K_lds + SHM_K, qr, qx, r32, hi); POST(p0, p1, j + 1); partialSM<MODE>(p0, p1, m_reg, mn, al); RESC(al);
      finishSM(p0, p1, al, l_reg, pa0, pa1, pa2, pa3); ASBAR();
      pv_d0(o, vb0 + SHM_V, pa0, pa1, pa2, pa3);
      asm volatile("s_waitcnt vmcnt(0)" ::: "memory"); if (more) SWRITE(0); __syncthreads();
    }
  } else {
    f32x16 pA0, pA1, pB0, pB1; float mnA, mnB, alA, alB;
    SLOAD(0, 0); asm volatile("s_waitcnt vmcnt(0)" ::: "memory"); SWRITE(0); __syncthreads();
    qkt<MODE>(pA0, pA1, K_lds, qr, qx, r32, hi); POST(pA0, pA1, 0); partialSM<MODE>(pA0, pA1, m_reg, mnA, alA);
    SLOAD(1, 1);
    asm volatile("s_waitcnt vmcnt(0)" ::: "memory"); SWRITE(1); __syncthreads();
    for (int j = 1; j + 1 < NT; j += 2) {
      ASBAR(); qkt<MODE>(pB0, pB1, K_lds + SHM_K, qr, qx, r32, hi); POST(pB0, pB1, j);
      finishSM(pA0, pA1, alA, l_reg, pa0, pa1, pa2, pa3); ASBAR();
      SLOAD(j + 1, 0); ASBAR();
      pv_d0(o, vb0, pa0, pa1, pa2, pa3); partialSM<MODE>(pB0, pB1, m_reg, mnB, alB);
      __syncthreads(); asm volatile("s_waitcnt vmcnt(0)" ::: "memory"); SWRITE(0);
      RESC(alB); __syncthreads();
      ASBAR(); qkt<MODE>(pA0, pA1, K_lds, qr, qx, r32, hi); POST(pA0, pA1, j + 1);
      finishSM(pB0, pB1, alB, l_reg, pa0, pa1, pa2, pa3); ASBAR();
      SLOAD(j + 2, 1); ASBAR();
      pv_d0(o, vb0 + SHM_V, pa0, pa1, pa2, pa3); partialSM<MODE>(pA0, pA1, m_reg, mnA, alA);
      __syncthreads(); asm volatile("s_waitcnt vmcnt(0)" ::: "memory"); SWRITE(1);
      RESC(alA); __syncthreads();
    }
    ASBAR(); qkt<MODE>(pB0, pB1, K_lds + SHM_K, qr, qx, r32, hi); POST(pB0, pB1, NT - 1);
    finishSM(pA0, pA1, alA, l_reg, pa0, pa1, pa2, pa3); ASBAR();
    pv_d0(o, vb0, pa0, pa1, pa2, pa3); partialSM<MODE>(pB0, pB1, m_reg, mnB, alB);
    __syncthreads(); RESC(alB);
    finishSM(pB0, pB1, alB, l_reg, pa0, pa1, pa2, pa3); ASBAR();
    pv_d0(o, vb0 + SHM_V, pa0, pa1, pa2, pa3);
  }
  int lane_e = lane; asm volatile("" : "+v"(lane_e));
  const int r32e = lane_e & 31, hie = lane_e >> 5;
  if (hi == 0) li_l[r32] = l_reg; asm volatile("s_waitcnt lgkmcnt(0)" ::: "memory");
  float rli[16];
#pragma unroll
  for (int r = 0; r < 16; ++r) rli[r] = __builtin_amdgcn_rcpf(li_l[crow_c(r) + 4 * hi]);
  __syncthreads();
  char* Ost = lds + wid * 8192;
#pragma unroll
  for (int r = 0; r < 16; ++r) { const int orow = crow_c(r) + 4 * hie;
#pragma unroll
    for (int d0 = 0; d0 < 4; ++d0) *reinterpret_cast<bf16_t*>(Ost + orow * 256 + (d0 * 32 + r32e) * 2) = f2bf(o[d0][r] * rli[r]); }
  asm volatile("s_waitcnt lgkmcnt(0)" ::: "memory");
  { bf16_t* Ob; int ldo;
    const size_t tok0 = tb + (size_t)cw * 64 + (wid & 1) * 32;
    if (MODE == 0) { Ob = (bf16_t*)(ws + OFF_AQ) + tok0 * 512 + (wid >> 1) * 128; ldo = 512; }
    else if (MODE == 1) { Ob = (bf16_t*)(ws + OFF_AIQ) + tok0 * 512 + hx * 128; ldo = 512; }
    else { Ob = (bf16_t*)(ws + OFF_CQ) + tok0 * 512 + hx * 128; ldo = 512; }
#pragma unroll
    for (int i = 0; i < 8; ++i) { const int ch = i * 64 + lane_e, row = ch >> 4, c16 = ch & 15;
      const u32x4 ov = *reinterpret_cast<const u32x4*>(Ost + row * 256 + c16 * 16); if (!dry) *reinterpret_cast<u32x4*>(Ob + (size_t)row * ldo + c16 * 8) = ov; } }
#undef SLOAD
#undef SWRITE
#undef RESC
#undef POST
}
}

namespace idx {
using bf16x8 = __attribute__((ext_vector_type(8))) short;
using f32x4 = __attribute__((ext_vector_type(4))) float;
__device__ __forceinline__ unsigned ordkey(float f) { const unsigned u = __float_as_uint(f); return (u & 0x80000000u) ? ~u : (u | 0x80000000u); }
__device__ __forceinline__ void select2(const unsigned (&key)[2][32], const int nw, unsigned* h0p, unsigned* h1p, const int lane_in, unsigned (&thr)[2], bool (&allsel)[2]) {
  unsigned prefix[2] = {0u, 0u}; int rneed[2] = {256, 256}; bool done[2] = {false, false};
  thr[0] = thr[1] = 0u; allsel[0] = allsel[1] = false;
#pragma unroll
  for (int pass = 0; pass < 3; ++pass) {
    if (!(done[0] && done[1])) {
      int lane = lane_in; asm volatile("" : "+v"(lane));
      const int sh = pass == 0 ? 21 : pass == 1 ? 10 : 0, bits = pass == 2 ? 10 : 11; const unsigned nbm = (1u << bits) - 1u;
#pragma unroll
      for (int i = 0; i < 8; ++i) { *reinterpret_cast<uint4*>(reinterpret_cast<char*>(h0p) + (i * 64 + lane) * 16) = make_uint4(0u, 0u, 0u, 0u); *reinterpret_cast<uint4*>(reinterpret_cast<char*>(h1p) + (i * 64 + lane) * 16) = make_uint4(0u, 0u, 0u, 0u); }
#pragma unroll
      for (int i = 0; i < 32; ++i) if (i < nw) {
#pragma unroll
        for (int q = 0; q < 2; ++q) { const bool match = pass == 0 ? true : (key[q][i] >> (sh + bits)) == prefix[q];
          if (match) { const unsigned d = (key[q][i] >> sh) & nbm; atomicAdd(&(q ? h1p : h0p)[(d & ~31u) | ((d & 31u) ^ ((d >> 5) & 31u))], 1u); } } }
      unsigned tl[2] = {0u, 0u};
#pragma unroll
      for (int i = 0; i < 32; ++i) { tl[0] += h0p[32 * lane + (i ^ (lane & 31))]; tl[1] += h1p[32 * lane + (i ^ (lane & 31))]; }
      unsigned S[2] = {tl[0], tl[1]};
#pragma unroll
      for (int o = 1; o < 64; o <<= 1) {
        const unsigned v0 = (unsigned)__builtin_amdgcn_ds_bpermute(((lane + o) & 63) << 2, (int)S[0]), v1 = (unsigned)__builtin_amdgcn_ds_bpermute(((lane + o) & 63) << 2, (int)S[1]);
        if (lane + o < 64) { S[0] += v0; S[1] += v1; } }
      int Ls[2], rls[2];
#pragma unroll
      for (int q = 0; q < 2; ++q) { const u64 mk = __ballot((int)S[q] >= rneed[q]); Ls[q] = __builtin_amdgcn_readfirstlane(63 - __clzll(mk));
        rls[q] = __builtin_amdgcn_readlane(rneed[q] - (int)(S[q] - tl[q]), Ls[q]); }
      const int li = lane & 31;
      unsigned hbv[2] = {h0p[32 * Ls[0] + (li ^ (Ls[0] & 31))], h1p[32 * Ls[1] + (li ^ (Ls[1] & 31))]};
      unsigned P[2] = {hbv[0], hbv[1]};
#pragma unroll
      for (int o = 1; o < 32; o <<= 1) {
        const unsigned v0 = (unsigned)__builtin_amdgcn_ds_bpermute(((lane + o) & 63) << 2, (int)P[0]), v1 = (unsigned)__builtin_amdgcn_ds_bpermute(((lane + o) & 63) << 2, (int)P[1]);
        if (li + o < 32) { P[0] += v0; P[1] += v1; } }
#pragma unroll
      for (int q = 0; q < 2; ++q) {
        const unsigned mk2 = (unsigned)__ballot((int)P[q] >= rls[q]);
        const int bi = __builtin_amdgcn_readfirstlane(31 - __clz(mk2));
        const int hbs = __builtin_amdgcn_readlane((int)hbv[q], bi), Pbi = __builtin_amdgcn_readlane((int)P[q], bi);
        const int rn = rls[q] - (Pbi - hbs);
        if (!done[q]) { rneed[q] = rn; prefix[q] = (prefix[q] << bits) | (unsigned)(32 * Ls[q] + bi); thr[q] = prefix[q] << sh;
          if (hbs == rn) { done[q] = true; allsel[q] = true; } }
      }
    }
  }
}
__device__ __forceinline__ u64 mask_words(const unsigned (&key)[32], const unsigned thr, const bool allsel, const int lane) {
  u64 myword = 0ull;
  if (allsel) {
#pragma unroll
    for (int i = 0; i < 32; ++i) { const u64 word = __ballot(key[i] >= thr); if (lane == i) myword = word; }
  } else {
    int cgt = 0;
#pragma unroll
    for (int i = 0; i < 32; ++i) cgt += __popcll(__ballot(key[i] > thr));
    const int need = 256 - cgt; int taken = 0;
#pragma unroll
    for (int i = 0; i < 32; ++i) {
      const bool gt = key[i] > thr, eq = key[i] == thr; const u64 em = __ballot(eq);
      const int before = taken + (int)__builtin_amdgcn_mbcnt_hi((unsigned)(em >> 32), __builtin_amdgcn_mbcnt_lo((unsigned)em, 0u));
      const u64 word = __ballot(gt || (eq && before < need)); taken += __popcll(em);
      if (lane == i) myword = word;
    }
  }
  return myword;
}
__device__ __forceinline__ void indexer_unit(unsigned char* ws, const int tid, char* lds, const int b, const int c, const int half) {
  const int wid = __builtin_amdgcn_readfirstlane(tid >> 6), lane = tid & 63, l15 = lane & 15, G = lane >> 4;
  const size_t tb = (size_t)b * SEQ;
  const int nk = (c + 1) * 64, nw = c + 1, nt16 = nk / 16;
  u64* mrow = (u64*)(ws + OFF_MASK) + (tb + (size_t)c * 64 + half * 32) * 32;
  if (c < 4) {
    for (int i = tid; i < 32 * 32; i += 512) mrow[i] = (i & 31) <= c ? ~0ull : 0ull;
    return;
  }
  float* sc = reinterpret_cast<float*>(lds);
  const bf16_t* aiq = (const bf16_t*)(ws + OFF_AIQ); const bf16_t* aik = (const bf16_t*)(ws + OFF_AIK) + tb * 64; const bf16_t* aiwb = (const bf16_t*)(ws + OFF_AIWB);
  for (int r = 0; r < 2; ++r) {
    for (int hh = 0; hh < 2; ++hh) {
      const int qbase = c * 64 + half * 32 + r * 16 + hh * 8;
      bf16x8 a[2][2][2]; f32x4 w[2][2];
#pragma unroll
      for (int p = 0; p < 2; ++p) { const size_t tq = tb + qbase + 4 * p + (l15 >> 2); const int h = l15 & 3;
#pragma unroll
        for (int hg = 0; hg < 2; ++hg)
#pragma unroll
          for (int ks = 0; ks < 2; ++ks) a[p][hg][ks] = *reinterpret_cast<const bf16x8*>(aiq + tq * 512 + (h + 4 * hg) * 64 + 8 * G + 32 * ks);
        { const uint4 wq = *reinterpret_cast<const uint4*>(aiwb + (tb + qbase + 4 * p + G) * 256);
          w[p][0] = (f32x4){__uint_as_float(wq.x << 16), __uint_as_float(wq.x & 0xffff0000u), __uint_as_float(wq.y << 16), __uint_as_float(wq.y & 0xffff0000u)};
          w[p][1] = (f32x4){__uint_as_float(wq.z << 16), __uint_as_float(wq.z & 0xffff0000u), __uint_as_float(wq.w << 16), __uint_as_float(wq.w & 0xffff0000u)}; } }
      bf16x8 cb[4][2], nb[4][2];
#define IDX_LOADB(dst, t0) do { _Pragma("unroll") for (int k_ = 0; k_ < 4; ++k_) { int tk_ = (t0) + 8 * k_; tk_ = tk_ < nt16 ? tk_ : nt16 - 1; \
        const bf16_t* kp_ = aik + (size_t)(tk_ * 16 + l15) * 64 + 8 * G; dst[k_][0] = *reinterpret_cast<const bf16x8*>(kp_); dst[k_][1] = *reinterpret_cast<const bf16x8*>(kp_ + 32); } } while (0)
      IDX_LOADB(cb, wid);
      for (int t0 = wid; t0 < nt16; t0 += 32) {
        IDX_LOADB(nb, t0 + 32);
#pragma unroll
        for (int k = 0; k < 4; ++k) { const int tk = t0 + 8 * k;
          if (tk < nt16) {
#pragma unroll
            for (int p = 0; p < 2; ++p) {
              f32x4 c0 = {0.f, 0.f, 0.f, 0.f}, c1 = {0.f, 0.f, 0.f, 0.f};
              c0 = __builtin_amdgcn_mfma_f32_16x16x32_bf16(a[p][0][0], cb[k][0], c0, 0, 0, 0); c0 = __builtin_amdgcn_mfma_f32_16x16x32_bf16(a[p][0][1], cb[k][1], c0, 0, 0, 0);
              c1 = __builtin_amdgcn_mfma_f32_16x16x32_bf16(a[p][1][0], cb[k][0], c1, 0, 0, 0); c1 = __builtin_amdgcn_mfma_f32_16x16x32_bf16(a[p][1][1], cb[k][1], c1, 0, 0, 0);
              float sv = 0.f;
#pragma unroll
              for (int j = 0; j < 4; ++j) { const float r0 = __builtin_amdgcn_fmed3f(c0[j], 0.f, __builtin_inff()), r1 = __builtin_amdgcn_fmed3f(c1[j], 0.f, __builtin_inff());
                sv = __builtin_fmaf(r0, w[p][0][j], sv); sv = __builtin_fmaf(r1, w[p][1][j], sv); }
              sc[(8 * hh + 4 * p + G) * 2048 + tk * 16 + l15] = sv; } } }
#pragma unroll
        for (int k = 0; k < 4; ++k) { cb[k][0] = nb[k][0]; cb[k][1] = nb[k][1]; }
      }
#undef IDX_LOADB
    }
    __syncthreads();
    unsigned key[2][32];
#pragma unroll
    for (int i = 0; i < 32; ++i) { const unsigned k0 = ordkey(sc[wid * 2048 + i * 64 + lane]), k1 = ordkey(sc[(wid + 8) * 2048 + i * 64 + lane]);
      key[0][i] = i < nw ? k0 : 0u; key[1][i] = i < nw ? k1 : 0u; }
    asm volatile("s_waitcnt lgkmcnt(0)" ::: "memory");
    unsigned thr[2]; bool allsel[2];
    select2(key, nw, reinterpret_cast<unsigned*>(sc + wid * 2048), reinterpret_cast<unsigned*>(sc + (wid + 8) * 2048), lane, thr, allsel);
    const u64 w0 = mask_words(key[0], thr[0], allsel[0], lane), w1 = mask_words(key[1], thr[1], allsel[1], lane);
    if (lane < 32) { mrow[(size_t)(r * 16 + wid) * 32 + lane] = w0; mrow[(size_t)(r * 16 + wid + 8) * 32 + lane] = w1; }
    __syncthreads();
  }
}
}

#define XB_TMO      128
#define XB_XCNT(j)  (256  + 64 * (j))
#define XB_XSUB(j)  (1280 + 64 * (j))
#define XB_XGEN(j)  (2304 + 64 * (j))
#define XB_TOP      3328
#define XB_TOPGEN   3392
#define XCD_BAR_WORDS 3456
#define XB_SPIN_CAP (1u << 18)
#define LAS __attribute__((address_space(3)))

__device__ __forceinline__ unsigned xb_ld(unsigned* p)              { return __hip_atomic_load(p, __ATOMIC_RELAXED, __HIP_MEMORY_SCOPE_AGENT); }
__device__ __forceinline__ unsigned xb_add(unsigned* p, unsigned v) { return __hip_atomic_fetch_add(p, v, __ATOMIC_RELAXED, __HIP_MEMORY_SCOPE_AGENT); }
__device__ __forceinline__ unsigned xb_xcc_id() { return (unsigned)__builtin_amdgcn_s_getreg((3 << 11) | 20) & 0xFu; }
#define XB_SPIN(cond, bar) do { unsigned _sp = 0; while (cond) { __builtin_amdgcn_s_sleep(1); \
    if ((++_sp & 255u) == 0u) { if (xb_ld(&(bar)[XB_TMO])) break; if (_sp > XB_SPIN_CAP) { atomicAdd(&(bar)[XB_TMO], 1u); break; } } } } while (0)

struct XcdBarrier { unsigned* bar; unsigned x; volatile LAS unsigned* st; };

__device__ __forceinline__ XcdBarrier xcd_barrier_post(unsigned* bar, volatile LAS unsigned* st, int tid) {
    XcdBarrier b; b.bar = bar; b.x = xb_xcc_id(); b.st = st;
    if (tid == 0) (void)xb_add(&bar[XB_XCNT(b.x)], 1u);
    return b;
}
__device__ __forceinline__ void xcd_barrier_complete(unsigned* bar, unsigned x, unsigned& nloc, unsigned& nx) {
    const unsigned G = gridDim.x * gridDim.y * gridDim.z;
    unsigned sum, cnt, mine, sp = 0u;
    for (;;) {
        sum = 0u; cnt = 0u; mine = 0u;
#pragma unroll
        for (unsigned j = 0; j < 16; ++j) { const unsigned c = xb_ld(&bar[XB_XCNT(j)]); sum += c; cnt += (c > 0u) ? 1u : 0u; mine = (j == x) ? c : mine; }
        if (sum == G) break;
        __builtin_amdgcn_s_sleep(1);
        if ((++sp & 255u) == 0u) { if (xb_ld(&bar[XB_TMO])) break; if (sp > XB_SPIN_CAP) { atomicAdd(&bar[XB_TMO], 1u); break; } }
    }
    nloc = mine > 0u ? mine : 1u; nx = cnt > 0u ? cnt : 1u;
}
__device__ __forceinline__ void xcd_barrier(const XcdBarrier& b, int tid) {
    asm volatile("s_waitcnt vmcnt(0)" ::: "memory");
    __syncthreads();
    if (tid == 0) {
        unsigned* bar = b.bar;
        __builtin_amdgcn_s_waitcnt(0);
        unsigned nloc = b.st[0], nx = b.st[1];
        if (nloc == 0u) { xcd_barrier_complete(bar, b.x, nloc, nx); b.st[0] = nloc; b.st[1] = nx; }
        const unsigned old = xb_add(&bar[XB_XSUB(b.x)], 1u);
        const unsigned gen = old / nloc;
        if (old + 1u == (gen + 1u) * nloc) {
            __builtin_amdgcn_fence(__ATOMIC_RELEASE, "agent");
            asm volatile("s_waitcnt vmcnt(0)" ::: "memory");
            const unsigned og = xb_add(&bar[XB_TOP], 1u);
            const unsigned tg = og / nx;
            if (og + 1u == (tg + 1u) * nx) xb_add(&bar[XB_TOPGEN], 1u);
            else XB_SPIN(xb_ld(&bar[XB_TOPGEN]) == tg, bar);
            __builtin_amdgcn_fence(__ATOMIC_ACQUIRE, "agent");
            xb_add(&bar[XB_XGEN(b.x)], 1u);
            asm volatile("s_waitcnt vmcnt(0)" ::: "memory");
        } else {
            XB_SPIN(xb_ld(&bar[XB_XGEN(b.x)]) == gen, bar);
            __builtin_amdgcn_fence(__ATOMIC_ACQUIRE, "agent");
            asm volatile("s_waitcnt vmcnt(0)" ::: "memory");
        }
    }
    __syncthreads();
}

#ifndef RP_PREP
#define RP_PREP 1
#endif
#ifndef RP_P1
#define RP_P1 1
#endif
#ifndef RP_ATT
#define RP_ATT 1
#endif
#ifndef RP_MOE
#define RP_MOE 1
#endif
#ifndef RP_IDX
#define RP_IDX 1
#endif
#ifndef RP_RT
#define RP_RT 1
#endif
#ifndef RP_P4
#define RP_P4 1
#endif
#ifndef RP_UP
#define RP_UP 1
#endif
#ifndef RP_AIW
#define RP_AIW 1
#endif
#ifndef RP_BAR
#define RP_BAR 1
#endif
constexpr int NTHR = 512;
constexpr int LDS_BYTES = 163840;
constexpr int GEMM_LDS_OFF = 1024;
constexpr int XLDS_OFF = 1024 + 131072;
struct Args { const float* in[21]; float* x; unsigned char* ws; };

#define VB_LOOP2(NVB, BODY) do { for (int _i = blockIdx.x; _i < (NVB) / 4; _i += gridDim.x) { const int vb = 4 * _i + 2 * half; BODY; } } while (0)
#define VB_LOOP(NVB, BODY) do { for (int _i = blockIdx.x; _i < (NVB) / 2; _i += gridDim.x) { const int vb = 2 * _i + half; BODY; } } while (0)
#define ROW_LOOP(NROW, BODY) do { for (int row = blockIdx.x * 8 + wave; row < (NROW); row += gridDim.x * 8) { BODY; } } while (0)
#define ELEM_LOOP(N, BODY) do { for (int idx = blockIdx.x * NTHR + tid512; idx < (N); idx += gridDim.x * NTHR) { BODY; } } while (0)

#define AIN(k) as_global(a.in[k])
typedef const __attribute__((address_space(4))) Args* KArgs;
#define PH_BEGIN() KArgs ap_ = (KArgs)__builtin_amdgcn_kernarg_segment_ptr(); asm volatile("" : "+s"(ap_)); const __attribute__((address_space(4))) Args& a = *ap_; \
  int wv_ = wave_u; asm volatile("" : "+s"(wv_)); unsigned z_ = 0u; asm volatile("" : "+v"(z_)); int tid512 = wv_ * 64 + (int)__builtin_amdgcn_mbcnt_hi(~0u, __builtin_amdgcn_mbcnt_lo(~0u, z_)); asm volatile("" : "+v"(tid512)); \
  const int half = tid512 >> 8, tid = tid512 & 255, wave = tid512 >> 6, lane = tid512 & 63; (void)half; (void)tid; (void)wave; (void)lane; \
  size_t zo_ = 0; asm volatile("" : "+s"(zo_)); unsigned char* ws = as_global(a.ws) + zo_; float* x = as_global(a.x) + zo_; \
  char* sm = lds + 1024 + half * 36864; (void)sm; float* rstd = (float*)(ws + OFF_CTL + CTL_RSTD); (void)rstd;

__device__ __forceinline__ void prep_attn_weights(const __attribute__((address_space(4))) Args& a, unsigned char* ws, int l, int half, int tid, char* sm) {
  const float* g_attn = AIN(1) + l * 1024; const float* w_in = AIN(2) + (size_t)l * 1024 * NIN;
  { TrDesc d{w_in, nullptr, g_attn, (bf16_t*)(ws + OFF_WATT + WA_IN), NIN, 1024, NZP, 1}; VB_LOOP2(1664, b_transpose2(d, 0, 0, vb, tid, sm)); }
  { TrDesc d{AIN(4) + (size_t)l * 256 * 768, nullptr, AIN(3) + l * 256, (bf16_t*)(ws + OFF_WATT + WA_UQ), 768, 256, 768, 2}; VB_LOOP2(48, b_transpose2(d, 0, 0, vb, tid, sm)); }
  { TrDesc d{AIN(6) + (size_t)l * 128 * 1024, nullptr, AIN(5) + l * 128, (bf16_t*)(ws + OFF_WATT + WA_UKV), 1024, 128, 1024, 0, 256}; VB_LOOP2(32, b_transpose2(d, 0, 0, vb, tid, sm)); }
  { TrDesc d{AIN(8) + (size_t)l * 512 * 1024, nullptr, nullptr, (bf16_t*)(ws + OFF_WATT + WA_P), 1024, 512, 1024, 0}; VB_LOOP2(128, b_transpose2(d, 0, 0, vb, tid, sm)); }
  { TrDesc d{AIN(9) + (size_t)l * 512 * 1024, nullptr, nullptr, (bf16_t*)(ws + OFF_WATT + WA_P) + (size_t)1024 * 512, 1024, 512, 1024, 0}; VB_LOOP2(128, b_transpose2(d, 0, 0, vb, tid, sm)); }
  { TrDesc d{AIN(10) + (size_t)l * 512 * 1024, nullptr, nullptr, (bf16_t*)(ws + OFF_WATT + WA_P) + (size_t)2 * 1024 * 512, 1024, 512, 1024, 0}; VB_LOOP2(128, b_transpose2(d, 0, 0, vb, tid, sm)); }
  { TrDesc d{AIN(11) + (size_t)l * 1024 * 1024, nullptr, nullptr, (bf16_t*)(ws + OFF_WATT + WA_O), 1024, 1024, 1024, 0}; VB_LOOP2(256, b_transpose2(d, 0, 0, vb, tid, sm)); }
}

#define GRID_BAR() do { PH_BEGIN(); XcdBarrier bar_; bar_.bar = (unsigned*)(ws + OFF_CTL + CTL_BAR); bar_.x = xb_xcc_id(); bar_.st = (volatile LAS unsigned*)lds; xcd_barrier(bar_, tid512); } while (0)
template <int l>
__device__ __forceinline__ void layer_phases(const int wave_u, char* lds) {
#define PH_P1() { PH_BEGIN(); __syncthreads(); \
      { pg8::InOrder S{(const char*)(ws + OFF_XB), (const char*)(ws + OFF_WATT + WA_IN), (int)gridDim.x, (int)blockIdx.x}; pg8::EpiIn E{ws}; \
        pg8::gemm_phase<pg8::EpiIn, pg8::InOrder, true, false, 1024, 1024, 1024>(tid512, (PG8_LAS unsigned char*)lds + GEMM_LDS_OFF, S, E); } }
    PH_P1();
#if RP_P1 > 1
    PH_P1();
#endif
#if RP_BAR > 1
    GRID_BAR(); GRID_BAR(); GRID_BAR(); GRID_BAR(); GRID_BAR(); GRID_BAR(); GRID_BAR(); GRID_BAR(); GRID_BAR(); GRID_BAR();
#endif
    GRID_BAR();
#define PH_UP() { PH_BEGIN(); __syncthreads(); pg8::UpOrder S{ws, (int)gridDim.x, (int)blockIdx.x}; pg8::EpiUpBoth E{ws}; \
      pg8::gemm_phase<pg8::EpiUpBoth, pg8::UpOrder, true, false, 384, 256, 256>(tid512, (PG8_LAS unsigned char*)lds + GEMM_LDS_OFF, S, E); }
    PH_UP();
#if RP_UP > 1
    PH_UP();
#endif
#define PH_IDX() { PH_BEGIN(); __syncthreads(); const int w = blockIdx.x, bb = w >> 5, i = w & 31;        \
      idx::indexer_unit(ws, tid512, lds + GEMM_LDS_OFF, bb, i, 0); idx::indexer_unit(ws, tid512, lds + GEMM_LDS_OFF, bb, 31 - i, 1); }
    PH_IDX();
#if RP_IDX > 1
    PH_IDX();
#endif
    GRID_BAR();
#define PH_ATT(dry) \
    { PH_BEGIN(); const int w = blockIdx.x, bb = w >> 5, i = w & 31; att::attn_unit<0>(ws, nullptr, tid512, lds + GEMM_LDS_OFF, bb, 0, i, dry); } \
    { PH_BEGIN(); const int w = blockIdx.x, bb = w >> 5, i = w & 31; att::attn_unit<1>(ws, nullptr, tid512, lds + GEMM_LDS_OFF, bb, i & 3, 7 - (i >> 2), dry); } \
    { PH_BEGIN(); const float* relb_ = AIN(7) + l * 4 * 257; const int w = blockIdx.x, bb = w >> 5, i = w & 31; att::attn_unit<2>(ws, relb_, tid512, lds + GEMM_LDS_OFF, bb, i & 3, i >> 2, dry); }
#if RP_ATT > 1
    PH_ATT(true);
#endif
    PH_ATT(false);
    GRID_BAR();
    { PH_BEGIN(); if (blockIdx.x == 0 && tid512 < 128) ((unsigned*)(ws + OFF_CTL + CTL_CNT))[tid512] = 0u; }
#define PH_P4()     { PH_BEGIN(); __syncthreads(); \
      pg8::ProjOrder S{ws, (int)gridDim.x, (int)blockIdx.x}; pg8::EpiProj E{ws}; \
      pg8::gemm_phase<pg8::EpiProj, pg8::ProjOrder, false, false, 512, 512, 512>(tid512, (PG8_LAS unsigned char*)lds + GEMM_LDS_OFF, S, E); }
    PH_P4();
#if RP_P4 > 1
    PH_P4();
#endif
    GRID_BAR();
    { PH_BEGIN(); __syncthreads();
      pg8::PlainOrder S{(const char*)(ws + OFF_MIX), (const char*)(ws + OFF_WATT + WA_O), 1024, 1024, T / 256, 4, (int)gridDim.x, (int)blockIdx.x, 16}; pg8::EpiOut E{x, (bf16_t*)(ws + OFF_XB)};
      pg8::gemm_phase<pg8::EpiOut, pg8::PlainOrder, false, false, 1024, 1024, 1024>(tid512, (PG8_LAS unsigned char*)lds + GEMM_LDS_OFF, S, E); }
    GRID_BAR();
#define PH_RT(DRY)     { PH_BEGIN(); const float* g_ = AIN(12) + l * 1024; const float* wg_ = AIN(13) + (size_t)l * 1024 * 4; const float* bg_ = AIN(14) + l * 4; const float* wr_ = AIN(15) + (size_t)l * 1024 * 32; const float* br_ = AIN(16) + l * 32; \
      __syncthreads(); float* wt_ = (float*)(lds + GEMM_LDS_OFF); router_stage(g_, wg_, wr_, wt_, tid512); __syncthreads(); \
      for (int t0 = blockIdx.x * 64; t0 < T; t0 += gridDim.x * 64) \
        router_mfma((const float*)x, wt_, lds + GEMM_LDS_OFF + ROUTER_LDS, bg_, br_, (int*)(ws + OFF_CTL + CTL_TOKE), (float*)(ws + OFF_CTL + CTL_TOKW), rstd, (unsigned*)(ws + OFF_CTL + CTL_CNT), (int*)(ws + OFF_LIST), t0 + (wave & 3) * 16, wave, lane, DRY); \
      __syncthreads(); }
#if RP_RT > 1
    PH_RT(true);
#endif
    PH_RT(false);
#if RP_PREP > 1
    { PH_BEGIN();
      { TrDesc d{AIN(17) + (size_t)l * 32 * 1024 * 256, AIN(18) + (size_t)l * 32 * 1024 * 256, AIN(12) + l * 1024, (bf16_t*)(ws + OFF_WGU), 256, 1024, 512, 3};
        VB_LOOP2(128 * 32, b_transpose2(d, (size_t)1024 * 256, (size_t)512 * 1024, vb, tid, sm)); }
      { TrDesc d{AIN(19) + (size_t)l * 32 * 256 * 1024, nullptr, nullptr, (bf16_t*)(ws + OFF_WD), 1024, 256, 1024, 0};
        VB_LOOP2(64 * 32, b_transpose2(d, (size_t)256 * 1024, (size_t)1024 * 256, vb, tid, sm)); } }
#endif
    { PH_BEGIN();
      { TrDesc d{AIN(17) + (size_t)l * 32 * 1024 * 256, AIN(18) + (size_t)l * 32 * 1024 * 256, AIN(12) + l * 1024, (bf16_t*)(ws + OFF_WGU), 256, 1024, 512, 3};
        VB_LOOP2(128 * 32, b_transpose2(d, (size_t)1024 * 256, (size_t)512 * 1024, vb, tid, sm)); }
      { TrDesc d{AIN(19) + (size_t)l * 32 * 256 * 1024, nullptr, nullptr, (bf16_t*)(ws + OFF_WD), 1024, 256, 1024, 0};
        VB_LOOP2(64 * 32, b_transpose2(d, (size_t)256 * 1024, (size_t)1024 * 256, vb, tid, sm)); } }
    GRID_BAR();
#define MOE_TAB ((PG8_LAS unsigned*)((PG8_LAS unsigned char*)lds + XLDS_OFF))
#define PH_MOE_A() { PH_BEGIN(); __syncthreads(); pg8::moe_build_map((unsigned*)(ws + OFF_CTL + CTL_CNT), MOE_TAB, tid512); \
      pg8::MoeOrder<2, false> S{ws, (int)gridDim.x, (int)blockIdx.x, MOE_TAB, 0, 256}; pg8::EpiGU E{ws}; \
      pg8::gemm_phase<pg8::EpiGU, pg8::MoeOrder<2, false>, true, true, 1024, 1024, 1024>(tid512, (PG8_LAS unsigned char*)lds + GEMM_LDS_OFF, S, E, (PG8_LAS unsigned char*)lds + XLDS_OFF + 1024); }
#define PH_MOE_B() \
    { PH_BEGIN(); __syncthreads(); pg8::moe_build_map((unsigned*)(ws + OFF_CTL + CTL_CNT), MOE_TAB, tid512); \
      pg8::MoeOrder<2, false> S{ws, (int)gridDim.x, (int)blockIdx.x, MOE_TAB, 256, 1 << 30}; pg8::EpiGU E{ws}; \
      pg8::gemm_phase<pg8::EpiGU, pg8::MoeOrder<2, false>, true, true, 1024, 1024, 1024>(tid512, (PG8_LAS unsigned char*)lds + GEMM_LDS_OFF, S, E, (PG8_LAS unsigned char*)lds + XLDS_OFF + 1024); \
      const int nt_ = __builtin_amdgcn_readfirstlane((int)MOE_TAB[255]); const int L_ = 256 + (int)blockIdx.x;       \
      asm volatile("s_waitcnt vmcnt(0)" ::: "memory"); __syncthreads(); \
      if (L_ < 2 * nt_ && tid512 == 0) { __builtin_amdgcn_fence(__ATOMIC_RELEASE, "agent"); asm volatile("s_waitcnt vmcnt(0)" ::: "memory"); \
        __hip_atomic_fetch_add((unsigned*)(ws + OFF_CTL + CTL_CNT) + 64 + (L_ / 2 - 128), 1u, __ATOMIC_RELAXED, __HIP_MEMORY_SCOPE_AGENT); } } \
    { PH_BEGIN(); __syncthreads(); const int nt_ = __builtin_amdgcn_readfirstlane((int)MOE_TAB[255]); const int nx_ = 2 * nt_ > 256 ? 2 * nt_ - 256 : 0; \
      pg8::MoeOrder<4, true> S{ws, (int)gridDim.x - nx_, (int)blockIdx.x - nx_, MOE_TAB, 0, 512}; pg8::EpiDown E{ws}; \
      pg8::gemm_phase<pg8::EpiDown, pg8::MoeOrder<4, true>, true, false, 256, 256, 256>(tid512, (PG8_LAS unsigned char*)lds + GEMM_LDS_OFF, S, E); } \
    { PH_BEGIN(); __syncthreads(); const int nt_ = __builtin_amdgcn_readfirstlane((int)MOE_TAB[255]); const int L_ = 512 + (int)blockIdx.x; \
      if (L_ < 4 * nt_) { if (tid512 == 0) { unsigned* fl_ = (unsigned*)(ws + OFF_CTL + CTL_CNT) + 64 + (L_ / 4 - 128); unsigned sp_ = 0; \
          while (__hip_atomic_load(fl_, __ATOMIC_RELAXED, __HIP_MEMORY_SCOPE_AGENT) < 2u && ++sp_ < (1u << 22)) __builtin_amdgcn_s_sleep(1); \
          __builtin_amdgcn_fence(__ATOMIC_ACQUIRE, "agent"); asm volatile("s_waitcnt vmcnt(0)" ::: "memory"); } } \
      __syncthreads(); \
      pg8::MoeOrder<4, true> S{ws, (int)gridDim.x, (int)blockIdx.x, MOE_TAB, 512, 1 << 30}; pg8::EpiDown E{ws}; \
      pg8::gemm_phase<pg8::EpiDown, pg8::MoeOrder<4, true>, true, false, 256, 256, 256>(tid512, (PG8_LAS unsigned char*)lds + GEMM_LDS_OFF, S, E); }
#if RP_MOE > 1
    PH_MOE_A(); GRID_BAR();
#endif
    PH_MOE_A();
    GRID_BAR();
    PH_MOE_B();
    GRID_BAR();
    if (l == 0) { { PH_BEGIN(); ROW_LOOP(T, b_finalize<false>(x, ws, nullptr, row, lane)); } { PH_BEGIN(); prep_attn_weights(a, ws, 1, half, tid, sm); } if (RP_PREP > 1) { PH_BEGIN(); prep_attn_weights(a, ws, 1, half, tid, sm); } GRID_BAR(); }
    else { PH_BEGIN(); const float* gf_ = AIN(20); ROW_LOOP(T, b_finalize<true>(x, ws, gf_, row, lane)); }
}

__global__ void __launch_bounds__(NTHR, 2) mk_fwd(Args a_in) {
  extern __shared__ __attribute__((aligned(16))) char lds[];
  const int wave_u = __builtin_amdgcn_readfirstlane((int)threadIdx.x >> 6);
  { PH_BEGIN();
    if (tid512 == 0) { ((volatile LAS unsigned*)lds)[0] = 0u; ((volatile LAS unsigned*)lds)[1] = 0u; ((volatile LAS unsigned*)lds)[2] = 0u; ((volatile LAS unsigned*)lds)[3] = 0u; }
    __syncthreads();
    (void)xcd_barrier_post((unsigned*)(ws + OFF_CTL + CTL_BAR), (volatile LAS unsigned*)lds, tid512); }
  { PH_BEGIN(); ELEM_LOOP(2048 * 56, b_rope_tables((float*)(ws + OFF_CTL + CTL_ROPE), idx)); }
  { PH_BEGIN(); const float* xin = AIN(0); ROW_LOOP(T, b_x_init(xin, x, (bf16_t*)(ws + OFF_XB), rstd, row, lane)); }
  { PH_BEGIN(); prep_attn_weights(a, ws, 0, half, tid, sm); }
  if (RP_PREP > 1) { PH_BEGIN(); prep_attn_weights(a, ws, 0, half, tid, sm); }
  GRID_BAR();
  layer_phases<0>(wave_u, lds);
  layer_phases<1>(wave_u, lds);
}

extern "C" void kernel_launch(void* const* d_in, const int* in_sizes, int n_in, void* d_out, int out_size, void* d_ws, size_t ws_size, hipStream_t stream) {
  if (ws_size < WS_END) { fprintf(stderr, "kernel_launch: workspace too small: %zu < %zu\n", ws_size, WS_END); return; }
  static int grid = 0;
  if (!grid) {
    int dev = 0, cus = 0, per_cu = 0;
    hipGetDevice(&dev);
    hipDeviceGetAttribute(&cus, hipDeviceAttributeMultiprocessorCount, dev);
    hipFuncSetAttribute((const void*)mk_fwd, hipFuncAttributeMaxDynamicSharedMemorySize, LDS_BYTES);
    hipOccupancyMaxActiveBlocksPerMultiprocessor(&per_cu, (const void*)mk_fwd, NTHR, LDS_BYTES);
    if (per_cu < 1) { fprintf(stderr, "kernel_launch: occupancy query says %d blocks per CU\n", per_cu); return; }
    if (cus < 256) { fprintf(stderr, "kernel_launch: this kernel is laid out for 256 workgroups, one per CU; the device reports %d CUs\n", cus); return; }
    grid = 256;
  }
  Args a{};
  for (int i = 0; i < 21; ++i) a.in[i] = (const float*)d_in[i];
  a.x = (float*)d_out; a.ws = (unsigned char*)d_ws;
  hipMemsetAsync((unsigned char*)d_ws + OFF_CTL + CTL_BAR, 0, XCD_BAR_WORDS * sizeof(unsigned), stream);
  hipLaunchKernelGGL(mk_fwd, dim3(grid), dim3(NTHR), LDS_BYTES, stream, a);
}
```

```cpp
#include <hip/hip_runtime.h>
#include <hip/hip_bf16.h>
#include <cstdint>
#include <cstdio>

typedef unsigned short bf16_t;
typedef unsigned long long u64;

constexpr int T = 16384, DM = 1024, SEQ = 2048, NB = 8;
constexpr int NIN = 6408, NZ = 6400, NZP = 6656;
constexpr float EPS = 1e-6f;

constexpr size_t MiB = (size_t)1 << 20;
constexpr size_t OFF_CTL = 0;
constexpr size_t OFF_WATT = 4 * MiB;
constexpr size_t OFF_XB = 23 * MiB;
constexpr size_t OFF_AQ = 55 * MiB;
constexpr size_t OFF_CQ = 71 * MiB;
constexpr size_t OFF_QB = 87 * MiB;
constexpr size_t OFF_ZA = 111 * MiB;
constexpr size_t OFF_AK = OFF_ZA;
constexpr size_t OFF_AV = OFF_AK + 4 * MiB;
constexpr size_t OFF_AIQ = OFF_AV + 4 * MiB;
constexpr size_t OFF_AIK = OFF_AIQ + 16 * MiB;
constexpr size_t OFF_BKR = OFF_AIK + 2 * MiB;
constexpr size_t OFF_BCKV = OFF_BKR + 2 * MiB;
constexpr size_t OFF_BCQ = OFF_BCKV + 4 * MiB;
constexpr size_t OFF_BC = OFF_BCKV;
constexpr size_t OFF_CK = OFF_BCQ + 8 * MiB;
constexpr size_t OFF_CV = OFF_CK + 16 * MiB;
constexpr size_t OFF_KVB = 183 * MiB;
constexpr size_t OFF_MASK = 215 * MiB;
constexpr size_t OFF_G = 219 * MiB;
constexpr size_t OFF_AIWB = 315 * MiB;
constexpr size_t WS_END = 323 * MiB;
constexpr size_t OFF_MIX = OFF_KVB;
constexpr size_t OFF_WMOE = OFF_ZA;
constexpr size_t OFF_WGU = OFF_WMOE;
constexpr size_t OFF_WD = OFF_WMOE + 32 * MiB;
constexpr size_t OFF_Y = OFF_G;
constexpr size_t OFF_LIST = OFF_MASK;
constexpr size_t OFF_H = OFF_AQ;
constexpr size_t CTL_BAR = 0;
constexpr size_t CTL_CNT = 16 * 1024;
constexpr size_t CTL_ROPE = 64 * 1024;
constexpr size_t CTL_RSTD = 1 * MiB;
constexpr size_t CTL_RSTDQ = CTL_RSTD + 64 * 1024;
constexpr size_t CTL_RSTDKV = CTL_RSTDQ + 64 * 1024;
constexpr size_t CTL_AIW = CTL_RSTDKV + 64 * 1024;
constexpr size_t CTL_SSQ = 2 * MiB;
constexpr size_t CTL_SSQQ = CTL_SSQ;
constexpr size_t CTL_SSQKV = CTL_SSQ + 512 * 1024;
constexpr size_t CTL_TOKE = 3 * MiB;
constexpr size_t CTL_TOKW = CTL_TOKE + 128 * 1024;
constexpr size_t CTL_WIW = 3 * MiB + 512 * 1024;
constexpr size_t WA_IN = 0;
constexpr size_t WA_UQ = 13 * MiB;
constexpr size_t WA_UKV = WA_UQ + 512 * 1024;
constexpr size_t WA_P = 14 * MiB;
constexpr size_t WA_O = 17 * MiB;
constexpr int RT_COSA = 0, RT_SINA = 2048 * 16, RT_COSI = 2048 * 32, RT_SINI = 2048 * 40, RT_COSB = 2048 * 48, RT_SINB = 2048 * 80;

template <class Tp> __device__ __forceinline__ Tp* as_global(Tp* p) { return (Tp*)(__attribute__((address_space(1))) Tp*)p; }
__device__ __forceinline__ float bf2f(bf16_t v) { return __uint_as_float(((unsigned)v) << 16); }
__device__ __forceinline__ bf16_t f2bf(float f) { unsigned u = __float_as_uint(f); return (bf16_t)((u + 0x7fffu + ((u >> 16) & 1u)) >> 16); }
__device__ __forceinline__ float shx(float v, int m, int lane) { return __int_as_float(__builtin_amdgcn_ds_bpermute((lane ^ m) << 2, __float_as_int(v))); }
__device__ __forceinline__ float wave_sum(float v, int lane) {
  v += shx(v, 32, lane); v += shx(v, 16, lane); v += shx(v, 8, lane); v += shx(v, 4, lane); v += shx(v, 2, lane); v += shx(v, 1, lane); return v;
}
__host__ __device__ __forceinline__ int zmap(int c) {
  if (c < 1344) return c;
  if (c < 1408) { int n = c - 1344, g = n >> 5, r = n & 31; return 1736 + (r < 16 ? 16 * g + r : 32 + 16 * g + (r - 16)); }
  if (c < 1536) return 1608 + (c - 1408);
  if (c < 1792) return 1352 + (c - 1536);
  return c + 8;
}
__host__ __device__ __forceinline__ int uqmap(int c) {
  if (c < 512) { int h = c >> 7, d = c & 127; return h * 192 + d; }
  int n = c - 512, h = n >> 6, m = n & 63, g = m >> 5, r = m & 31;
  return h * 192 + 128 + (r < 16 ? 16 * g + r : 32 + 16 * g + (r - 16));
}
__host__ __device__ __forceinline__ int gumap(int n, int& isup) { int pn = n >> 8, j = n & 255; isup = j >= 128; return 128 * pn + (j & 127); }

struct TrDesc { const float* src; const float* src2; const float* scale; bf16_t* dst; int ld; int K; int N; int kind; int dp = 0; };
struct TrRegs { float4 v[4]; float sc[4]; };
__device__ __forceinline__ void tt_load(const TrDesc& d, int tn, int tk, int tid, TrRegs& R) {
  const int n0 = tn * 64, k0 = tk * 64;
  const int n4 = (tid & 15) * 4, kq = tid >> 4;
  const int n = n0 + n4;
  const float* s = d.src; int col; float cs = 1.f;
  if (d.kind == 0) col = n; else if (d.kind == 1) { if (n >= NZ) { col = n < NZ + 8 ? 1344 + (n - NZ) : 0; cs = n < NZ + 8 ? 0.35355339059327373f * 0.125f : 0.f; } else col = zmap(n); } else if (d.kind == 2) col = uqmap(n);
  else { int isup; col = gumap(n, isup); if (isup) s = d.src2; }
  const bool vec = ((((size_t)d.ld * 4) & 15) == 0) && ((col & 3) == 0);
#pragma unroll
  for (int i = 0; i < 4; ++i) { const int kk = kq + 16 * i; const float* p = s + (size_t)(k0 + kk) * d.ld + col;
    if (vec) R.v[i] = *(const float4*)p; else { R.v[i].x = p[0]; R.v[i].y = p[1]; R.v[i].z = p[2]; R.v[i].w = p[3]; }
    R.sc[i] = (d.scale ? d.scale[k0 + kk] : 1.f) * cs; }
}
__device__ __forceinline__ void tt_lds(const TrRegs& R, float (*tile)[65], int tid) {
  const int n4 = (tid & 15) * 4, kq = tid >> 4;
#pragma unroll
  for (int i = 0; i < 4; ++i) { const int kk = kq + 16 * i; const float sc = R.sc[i];
    tile[kk][n4] = R.v[i].x * sc; tile[kk][n4 + 1] = R.v[i].y * sc; tile[kk][n4 + 2] = R.v[i].z * sc; tile[kk][n4 + 3] = R.v[i].w * sc; }
}
__device__ __forceinline__ void tt_store(const TrDesc& d, int tn, int tk, float (*tile)[65], int tid) {
  const int n0 = tn * 64, k0 = tk * 64;
  const int dp = d.dp ? d.dp : d.K;
#pragma unroll
  for (int i = 0; i < 2; ++i) { const int e = tid + 256 * i, nn = e >> 3, k8 = (e & 7) * 8;
    uint4 w;
    w.x = (unsigned)f2bf(tile[k8 + 0][nn]) | ((unsigned)f2bf(tile[k8 + 1][nn]) << 16); w.y = (unsigned)f2bf(tile[k8 + 2][nn]) | ((unsigned)f2bf(tile[k8 + 3][nn]) << 16);
    w.z = (unsigned)f2bf(tile[k8 + 4][nn]) | ((unsigned)f2bf(tile[k8 + 5][nn]) << 16); w.w = (unsigned)f2bf(tile[k8 + 6][nn]) | ((unsigned)f2bf(tile[k8 + 7][nn]) << 16);
    *(uint4*)(d.dst + (size_t)(n0 + nn) * dp + k0 + k8) = w; }
}
__device__ __forceinline__ void b_transpose2(TrDesc d, size_t src_stride, size_t dst_stride, int vb, int tid, char* sm) {
  float (*tileA)[65] = (float (*)[65])sm; float (*tileB)[65] = (float (*)[65])(sm + 64 * 65 * 4);
  const int ntk = d.K / 64, per = (d.N / 64) * ntk;
  TrDesc da = d, db = d;
  { const int e = vb / per; da.src += (size_t)e * src_stride; if (da.src2) da.src2 += (size_t)e * src_stride; da.dst += (size_t)e * dst_stride; }
  { const int e = (vb + 1) / per; db.src += (size_t)e * src_stride; if (db.src2) db.src2 += (size_t)e * src_stride; db.dst += (size_t)e * dst_stride; }
  const int ta = vb % per, tb = (vb + 1) % per;
  TrRegs ra, rb; tt_load(da, ta / ntk, ta % ntk, tid, ra); tt_load(db, tb / ntk, tb % ntk, tid, rb);
  tt_lds(ra, tileA, tid); tt_lds(rb, tileB, tid);
  __syncthreads();
  tt_store(da, ta / ntk, ta % ntk, tileA, tid); tt_store(db, tb / ntk, tb % ntk, tileB, tid);
  __syncthreads();
}
__device__ __forceinline__ void b_rope_tables(float* rt, int i) {
  int pos = i / 56, j = i % 56; int rot, idx, oc, os;
  if (j < 16) { rot = 32; idx = j; oc = RT_COSA + pos * 16 + idx; os = RT_SINA + pos * 16 + idx; }
  else if (j < 24) { rot = 16; idx = j - 16; oc = RT_COSI + pos * 8 + idx; os = RT_SINI + pos * 8 + idx; }
  else { rot = 64; idx = j - 24; oc = RT_COSB + pos * 32 + idx; os = RT_SINB + pos * 32 + idx; }
  float inv = (float)pow(500000.0, -(double)(2 * idx) / (double)rot);
  float ang = (float)pos * inv;
  rt[oc] = (float)cos((double)ang); rt[os] = (float)sin((double)ang);
}
__device__ __forceinline__ void b_x_init(const float* xin, float* x, bf16_t* xb, float* rstd, int row, int lane) {
  const float4* s = (const float4*)(xin + (size_t)row * DM); float4* d = (float4*)(x + (size_t)row * DM);
  float ss = 0.f;
#pragma unroll
  for (int i = 0; i < 4; ++i) { float4 v = s[lane + 64 * i]; d[lane + 64 * i] = v; ss += v.x * v.x + v.y * v.y + v.z * v.z + v.w * v.w;
    bf16_t* o = xb + (size_t)row * DM + (lane + 64 * i) * 4; o[0] = f2bf(v.x); o[1] = f2bf(v.y); o[2] = f2bf(v.z); o[3] = f2bf(v.w); }
  ss = wave_sum(ss, lane);
  if (lane == 0) rstd[row] = rsqrtf(ss * (1.f / DM) + EPS);
}

constexpr int RT_P = 1028;
constexpr int ROUTER_LDS = 36 * RT_P * 4;
__device__ __forceinline__ void router_stage(const float* g, const float* wg, const float* wr, float* wt, int tid) {
  for (int i = tid; i < 1024 * 32; i += 512) { const int k = i >> 5, j = i & 31; wt[(4 + j) * RT_P + k] = g[k] * wr[i]; }
  for (int i = tid; i < 1024 * 4; i += 512) { const int k = i >> 2, j = i & 3; wt[j * RT_P + k] = g[k] * wg[i]; }
}
__device__ __forceinline__ void router_select(const float (&acc)[36], const float rs, const float* bg, const float* br, int t, int* toke, float* tokw, float* rstd_out, unsigned* cnt, int* list, bool dry) {
  float lg[4]; float mx = -INFINITY;
#pragma unroll
  for (int j = 0; j < 4; ++j) { lg[j] = acc[j] * rs + bg[j]; mx = fmaxf(mx, lg[j]); }
  float sm = 0.f, best = -1.f; int gs = 0;
#pragma unroll
  for (int j = 0; j < 4; ++j) { const float p = __expf(lg[j] - mx); sm += p; if (p > best) { best = p; gs = j; } }
  const float pg = best / sm;
  const float m0 = gs == 0 ? 1.f : 0.f, m1 = gs == 1 ? 1.f : 0.f, m2 = gs == 2 ? 1.f : 0.f, m3 = gs == 3 ? 1.f : 0.f;
  float e[8]; float emx = -INFINITY;
#pragma unroll
  for (int j = 0; j < 8; ++j) { e[j] = ((acc[4 + j] * m0 + acc[12 + j] * m1) + (acc[20 + j] * m2 + acc[28 + j] * m3)) * rs + br[gs * 8 + j]; emx = fmaxf(emx, e[j]); }
  float es = 0.f, b0 = -1.f, b1 = -1.f; int i0 = 0, i1 = 0;
#pragma unroll
  for (int j = 0; j < 8; ++j) { const float p = __expf(e[j] - emx); es += p;
    if (p > b0) { b1 = b0; i1 = i0; b0 = p; i0 = j; } else if (p > b1) { b1 = p; i1 = j; } }
  const float p0 = b0 / es, p1 = b1 / es, ps = p0 + p1;
  const int e0 = gs * 8 + i0, e1 = gs * 8 + i1;
  if (dry) { asm volatile("" :: "v"(p0 + ps), "v"(e0 + e1)); return; }
  rstd_out[t] = rs;
  toke[t * 2] = e0; toke[t * 2 + 1] = e1; tokw[t * 2] = pg * p0 / ps; tokw[t * 2 + 1] = pg * p1 / ps;
  const unsigned s0 = atomicAdd(cnt + e0, 1u), s1 = atomicAdd(cnt + e1, 1u);
  list[(size_t)e0 * T + s0] = t * 2; list[(size_t)e1 * T + s1] = t * 2 + 1;
}
__device__ __forceinline__ void router_mfma(const float* x, const float* wt, char* scr  , const float* bg, const float* br, int* toke, float* tokw, float* rstd_out,
                                            unsigned* cnt, int* list, const int t0  , const int wave, const int lane, const bool dry) {
  typedef float f4 __attribute__((ext_vector_type(4)));
  const int i = lane & 15, g = lane >> 4, wp = wave & 3, kh = wave >> 2;
  const float* xr = x + (size_t)(t0 + i) * DM + kh * 512 + 4 * g;
  const float* w0 = wt + (size_t)i * RT_P + kh * 512 + 4 * g; const float* w1 = w0 + 16 * RT_P; const float* w2 = wt + (size_t)(32 + (i < 4 ? i : 3)) * RT_P + kh * 512 + 4 * g;
  f4 c0 = {0.f, 0.f, 0.f, 0.f}, c1 = c0, c2 = c0; float ssl = 0.f;
#pragma unroll 4
  for (int s = 0; s < 32; ++s) {
    const f4 xa = *(const f4*)(xr + 16 * s), b0 = *(const f4*)(w0 + 16 * s), b1 = *(const f4*)(w1 + 16 * s), b2 = *(const f4*)(w2 + 16 * s);
    ssl += (xa[0] * xa[0] + xa[1] * xa[1]) + (xa[2] * xa[2] + xa[3] * xa[3]);
#pragma unroll
    for (int e = 0; e < 4; ++e) { c0 = __builtin_amdgcn_mfma_f32_16x16x4f32(xa[e], b0[e], c0, 0, 0, 0); c1 = __builtin_amdgcn_mfma_f32_16x16x4f32(xa[e], b1[e], c1, 0, 0, 0); c2 = __builtin_amdgcn_mfma_f32_16x16x4f32(xa[e], b2[e], c2, 0, 0, 0); }
  }
  float* part = (float*)scr + (size_t)(wp * 64 + lane) * 12; float* pss = (float*)(scr + 4 * 3072) + wp * 64 + lane;
  if (kh == 1) { *(f4*)part = c0; *(f4*)(part + 4) = c1; *(f4*)(part + 8) = c2; *pss = ssl; }
  __syncthreads();
  if (kh == 0) {
    c0 += *(const f4*)part; c1 += *(const f4*)(part + 4); c2 += *(const f4*)(part + 8); ssl += *pss;
    asm volatile("s_waitcnt lgkmcnt(0)" ::: "memory");
    ssl += shx(ssl, 16, lane); ssl += shx(ssl, 32, lane);
    float* lg = (float*)(scr + wp * 3072);
#pragma unroll
    for (int r = 0; r < 4; ++r) { lg[(4 * g + r) * 48 + i] = c0[r]; lg[(4 * g + r) * 48 + 16 + i] = c1[r]; lg[(4 * g + r) * 48 + 32 + i] = c2[r]; }
    asm volatile("s_waitcnt lgkmcnt(0)" ::: "memory");
    if (lane < 16) { float acc[36];
#pragma unroll
      for (int j = 0; j < 36; ++j) acc[j] = lg[lane * 48 + j];
      router_select(acc, rsqrtf(ssl * (1.f / DM) + EPS), bg, br, t0 + lane, toke, tokw, rstd_out, cnt, list, dry); }
  }
  __syncthreads();
}
template <bool LAST>
__device__ __forceinline__ void b_finalize(float* x, unsigned char* ws, const float* gf, int row, int lane) {
  float4* xr = (float4*)(x + (size_t)row * DM);
  const bf16_t* y0 = (const bf16_t*)(ws + OFF_Y) + (size_t)row * 2048; const bf16_t* y1 = y0 + 1024;
  float4 v[4]; float ss = 0.f;
#pragma unroll
  for (int i = 0; i < 4; ++i) { const int c4 = lane + 64 * i; float4 a = xr[c4];
    uint2 p0 = *(const uint2*)(y0 + c4 * 4), p1 = *(const uint2*)(y1 + c4 * 4);
    a.x += __uint_as_float(p0.x << 16) + __uint_as_float(p1.x << 16); a.y += __uint_as_float(p0.x & 0xffff0000u) + __uint_as_float(p1.x & 0xffff0000u);
    a.z += __uint_as_float(p0.y << 16) + __uint_as_float(p1.y << 16); a.w += __uint_as_float(p0.y & 0xffff0000u) + __uint_as_float(p1.y & 0xffff0000u);
    v[i] = a; ss += a.x * a.x + a.y * a.y + a.z * a.z + a.w * a.w; }
  ss = wave_sum(ss, lane);
  const float rs = rsqrtf(ss * (1.f / DM) + EPS);
#pragma unroll
  for (int i = 0; i < 4; ++i) { const int c4 = lane + 64 * i; float4 a = v[i];
    if (LAST) { float4 g = ((const float4*)gf)[c4]; a.x *= rs * g.x; a.y *= rs * g.y; a.z *= rs * g.z; a.w *= rs * g.w; xr[c4] = a; }
    else { xr[c4] = a; bf16_t* o = (bf16_t*)(ws + OFF_XB) + (size_t)row * DM + c4 * 4; o[0] = f2bf(a.x); o[1] = f2bf(a.y); o[2] = f2bf(a.z); o[3] = f2bf(a.w); } }
  if (!LAST && lane == 0) ((float*)(ws + OFF_CTL + CTL_RSTD))[row] = rs;
}


namespace pg8 {
#define PG8_LAS __attribute__((address_space(3)))
typedef short bf16x8 __attribute__((ext_vector_type(8)));
typedef float f32x4 __attribute__((ext_vector_type(4)));
typedef unsigned u32x4 __attribute__((ext_vector_type(4)));
constexpr int BM = 256, BK = 64, HALF = 128, HTB = HALF * BK * 2, STAGE_BYTES = 8 * HTB, NXCD = 8, WGM = 8;
__host__ __device__ __forceinline__ int lds_byte(int r, int c) { const int st = (r >> 4) * 2 + (c >> 5), rr = r & 15, cc = c & 31, ob = rr * 64 + cc * 2; return st * 1024 + (ob ^ (((ob >> 9) & 1) << 5)); }
__host__ __device__ __forceinline__ void stage_rc(int b, int& R, int& C) { const int st = b / 1024, sb = b % 1024, swz = sb ^ (((sb >> 9) & 1) << 5); R = (st >> 1) * 16 + swz / 64; C = (st & 1) * 32 + (swz % 64) / 2; }
__host__ __device__ __forceinline__ int perm32(int rho) { const int n = rho >> 4, i = rho & 15; return 8 * (i >> 2) + 4 * n + (i & 3); }
__device__ __forceinline__ unsigned cvt_pk_bf16(float lo, float hi) { unsigned r; asm volatile("v_cvt_pk_bf16_f32 %0, %1, %2" : "=v"(r) : "v"(lo), "v"(hi)); return r; }

struct Unit { int pm, pn; const char* A; const char* B; const int* rows; int aux; int nt; };

__device__ __forceinline__ bool static_tile(int i, int G, int c, int nM, int nN, int& pm, int& pn) {
  const int nwg = nM * nN; const long L = (long)i * G + c; if (L >= nwg) return false;
  int wgid = (int)L; { const int q = nwg / NXCD, r = nwg % NXCD, xcd = wgid % NXCD, off = wgid / NXCD; wgid = (xcd < r ? xcd * (q + 1) : r * (q + 1) + (xcd - r) * q) + off; }
  const int nig = WGM * nN, gid = wgid / nig, fm = gid * WGM, gsz = (nM - fm) < WGM ? (nM - fm) : WGM;
  pm = fm + ((wgid % nig) % gsz); pn = (wgid % nig) / gsz; return true;
}
struct PlainOrder {
  const char* A; const char* Bt; int lda, ldb, nM, nN, G, c, nt;
  __device__ __forceinline__ bool next(int i, Unit& u) const {
    if (!static_tile(i, G, c, nM, nN, u.pm, u.pn)) return false;
    u.A = A + (size_t)u.pm * BM * lda * 2; u.B = Bt + (size_t)u.pn * BM * ldb * 2; u.rows = nullptr; u.aux = 0; u.nt = nt; return true; }
};

__host__ __device__ constexpr int in_tile(int v) {
  constexpr int tab[28] = {13, 15, 17, 21,  14, 16, 18, 22,  2, 5, 19, 23,  6, 10, 20, 24,  7, 11, 0, 3,  8, 12, 1, 4,  9, 25, 0, 0};
  return tab[v]; }
struct InOrder {
  const char* A; const char* Bt; int G, c;
  __device__ __forceinline__ bool next(int i, Unit& u) const {
    int pv; if (!static_tile(i, G, c, T / BM, NZP / BM, u.pm, pv)) return false;
    unsigned long long w0 = 0, w1 = 0, w2 = 0;
#pragma unroll
    for (int k = 0; k < 12; ++k) { w0 |= (unsigned long long)in_tile(k) << (5 * k); w1 |= (unsigned long long)in_tile(12 + k) << (5 * k); if (k < 2) w2 |= (unsigned long long)in_tile(24 + k) << (5 * k); }
    const unsigned long long w = pv < 12 ? w0 : pv < 24 ? w1 : w2; const int sh = 5 * (pv < 12 ? pv : pv < 24 ? pv - 12 : pv - 24);
    u.pn = (int)((w >> sh) & 31ull);
    u.A = A + (size_t)u.pm * BM * 1024 * 2; u.B = Bt + (size_t)u.pn * BM * 1024 * 2; u.rows = nullptr; u.aux = 0; u.nt = 16; return true; }
};

template <class Epi> __device__ __forceinline__ auto epi_keep(const Epi&, const Unit& u) -> decltype(Epi::keep(u)) { return Epi::keep(u); }
template <class Epi, class... X> __device__ __forceinline__ bool epi_keep(const Epi&, const Unit&, X...) { return false; }
template <class Epi, class Sched, bool ALIGN_EPI, bool GATHER, int lda, int ldb, int K>
__device__ __forceinline__ void gemm_phase(const int tid, PG8_LAS unsigned char* lds, const Sched& S, const Epi& E, PG8_LAS unsigned char* xlds = nullptr) {
    const int wid = __builtin_amdgcn_readfirstlane(tid >> 6), lane = tid & 63, wr = wid >> 2, wc = wid & 3, fr = lane & 15, fq = lane >> 4;
    unsigned voffA[2][2], voffB[2];
#pragma unroll
    for (int i = 0; i < 2; ++i) { int R, C; stage_rc(tid * 16 + i * 8192, R, C); const int Rb = (R & ~31) + perm32(R & 31);
        voffB[i] = (unsigned)(Rb * ldb + C) * 2u;
#pragma unroll
        for (int h = 0; h < 2; ++h) { voffA[h][i] = (unsigned)((R + (GATHER ? h * HALF : 0)) * lda + C) * 2u; } }
    const size_t hstepA = GATHER ? (size_t)0 : (size_t)HALF * lda * 2;
    const size_t kstep = (size_t)(BK * 2);
    const size_t hstepB = (size_t)HALF * ldb * 2;
    const unsigned ldsw = (unsigned)wid * 1024u;
    const int aoff = lds_byte(wr * 64 + fr, fq * 8), boff = lds_byte(wc * 32 + fr, fq * 8);
#define PG8_SA(b, h) (((b) * 2 + (h)) * HTB)
#define PG8_SB(b, h) ((4 + (b) * 2 + (h)) * HTB)
#define PG8_STAGE(bufoff, gbase, voff) do { _Pragma("unroll") for (int _i = 0; _i < 2; ++_i) \
        __builtin_amdgcn_global_load_lds((const unsigned*)((const char*)(gbase) + (voff)[_i]), (PG8_LAS unsigned*)(lds + (bufoff) + ldsw + _i * 8192), 16, 0, 0); } while (0)
#define PG8_LDA(dst, b, h) do { _Pragma("unroll") for (int m = 0; m < 4; ++m) _Pragma("unroll") for (int k = 0; k < 2; ++k) dst[m][k] = *(const PG8_LAS bf16x8*)(lds + PG8_SA(b, h) + aoff + m * 2048 + k * 1024); } while (0)
#define PG8_LDB(dst, b, h) do { _Pragma("unroll") for (int n = 0; n < 2; ++n) _Pragma("unroll") for (int k = 0; k < 2; ++k) dst[n][k] = *(const PG8_LAS bf16x8*)(lds + PG8_SB(b, h) + boff + n * 2048 + k * 1024); } while (0)
#define PG8_MMA(ai, bj, At, Bt) do { __builtin_amdgcn_s_setprio(1); _Pragma("unroll") for (int m = 0; m < 4; ++m) _Pragma("unroll") for (int n = 0; n < 2; ++n) _Pragma("unroll") for (int k = 0; k < 2; ++k) \
        acc[ai][bj][m][n] = __builtin_amdgcn_mfma_f32_16x16x32_bf16(Bt[n][k], At[m][k], acc[ai][bj][m][n], 0, 0, 0); __builtin_amdgcn_s_setprio(0); } while (0)
#define PG8_WAIT_V(n) asm volatile("s_waitcnt vmcnt(" #n ")" ::: "memory")
#define PG8_WAIT_L(n) asm volatile("s_waitcnt lgkmcnt(" #n ")" ::: "memory")
#define PG8_BAR __builtin_amdgcn_s_barrier()
#define PG8_SCHED __builtin_amdgcn_sched_barrier(0)
#define PG8_GATHER_OFFS(dst, u) do { if (GATHER) { _Pragma("unroll") for (int _i = 0; _i < 2; ++_i) { int _R, _C; stage_rc(tid * 16 + _i * 8192, _R, _C); \
        _Pragma("unroll") for (int _h = 0; _h < 2; ++_h) { const int _r = _h * HALF + _R; const int _e = _r < (u).aux ? ((u).rows[_r] >> 1) : 0; dst[_h][_i] = (unsigned)(_e * lda + _C) * 2u; } } } } while (0)
    Unit cur, nxt; int ui = 0;
    if (!S.next(0, cur)) return;
    PG8_GATHER_OFFS(voffA, cur);
    f32x4 acc[2][2][4][2];
#pragma unroll
    for (int a = 0; a < 2; ++a)
#pragma unroll
        for (int b = 0; b < 2; ++b)
#pragma unroll
            for (int m = 0; m < 4; ++m)
#pragma unroll
                for (int n = 0; n < 2; ++n) acc[a][b][m][n] = (f32x4){0.f, 0.f, 0.f, 0.f};
    bf16x8 At[4][2], B0[2][2], B1[2][2];
    const char* cA = cur.A; const char* cB = cur.B;
    PG8_STAGE(PG8_SB(0, 0), cB, voffB); PG8_STAGE(PG8_SB(0, 1), cB + hstepB, voffB); PG8_STAGE(PG8_SA(0, 0), cA, voffA[0]); PG8_STAGE(PG8_SA(0, 1), cA + hstepA, voffA[1]);
    if (wr == 1) PG8_BAR;
    PG8_WAIT_V(2); PG8_BAR;
    PG8_STAGE(PG8_SB(1, 0), cB + kstep, voffB); PG8_STAGE(PG8_SA(1, 0), cA + kstep, voffA[0]); PG8_STAGE(PG8_SB(1, 1), cB + hstepB + kstep, voffB);
    PG8_WAIT_V(6); PG8_BAR;
    for (;;) {
        const bool has_next = S.next(ui + 1, nxt);
        const char* nA = has_next ? nxt.A : cA; const char* nB = has_next ? nxt.B : cB;

        const int nt = cur.nt;
#pragma unroll 1
        for (int t = 0; t < nt; t += 2) {
            const bool last = (t == nt - 2);
            const char* a1 = cA + (size_t)(t + 1) * kstep;
            const char* a2 = last ? nA : cA + (size_t)(t + 2) * kstep; const char* b2 = last ? nB : cB + (size_t)(t + 2) * kstep;
            const char* a3 = a2 + kstep; const char* b3 = b2 + kstep;

            PG8_LDB(B0, 0, 0); PG8_LDB(B1, 0, 1); PG8_SCHED; PG8_LDA(At, 0, 0); PG8_STAGE(PG8_SA(1, 1), a1 + hstepA, voffA[1]);
            if (GATHER && last && has_next) PG8_GATHER_OFFS(voffA, nxt);
            PG8_WAIT_V(8); PG8_WAIT_L(0); PG8_BAR; PG8_MMA(0, 0, At, B0); PG8_MMA(0, 1, At, B1); PG8_BAR; PG8_SCHED;
            PG8_LDA(At, 0, 1); PG8_STAGE(PG8_SB(0, 0), b2, voffB); PG8_STAGE(PG8_SB(0, 1), b2 + hstepB, voffB); PG8_STAGE(PG8_SA(0, 0), a2, voffA[0]);
            PG8_WAIT_V(8); PG8_WAIT_L(0); PG8_BAR; PG8_MMA(1, 0, At, B0); PG8_MMA(1, 1, At, B1); PG8_BAR; PG8_SCHED;
            PG8_LDB(B0, 1, 0); PG8_LDB(B1, 1, 1); PG8_SCHED; PG8_LDA(At, 1, 0); PG8_STAGE(PG8_SA(0, 1), a2 + hstepA, voffA[1]);
            PG8_WAIT_V(8); PG8_WAIT_L(0); PG8_BAR; PG8_MMA(0, 0, At, B0); PG8_MMA(0, 1, At, B1); PG8_BAR; PG8_SCHED;
            PG8_LDA(At, 1, 1); PG8_STAGE(PG8_SB(1, 0), b3, voffB); PG8_STAGE(PG8_SB(1, 1), b3 + hstepB, voffB); PG8_STAGE(PG8_SA(1, 0), a3, voffA[0]);
            PG8_WAIT_V(8); PG8_WAIT_L(0); PG8_BAR; PG8_MMA(1, 0, At, B0); PG8_MMA(1, 1, At, B1); PG8_BAR; PG8_SCHED;
        }
        if constexpr (ALIGN_EPI) { if (wr == 0) PG8_BAR; }
        { int fr_e = fr, fq_e = fq; asm volatile("" : "+v"(fr_e), "+v"(fq_e)); E(acc, cur, wr, wc, fr_e, fq_e); }
        if (!has_next) break;
        if (!epi_keep<Epi>(E, cur)) {
#pragma unroll
        for (int a = 0; a < 2; ++a)
#pragma unroll
            for (int b = 0; b < 2; ++b)
#pragma unroll
                for (int m = 0; m < 4; ++m)
#pragma unroll
                    for (int n = 0; n < 2; ++n) acc[a][b][m][n] = (f32x4){0.f, 0.f, 0.f, 0.f};
        }
        cur = nxt; cA = nA; cB = nB; ++ui;

        if constexpr (ALIGN_EPI) { if (wr == 1) PG8_BAR; }
    }
    PG8_WAIT_V(0);
    if constexpr (!ALIGN_EPI) { if (wr == 0) PG8_BAR; }
    PG8_BAR;
#undef PG8_SA
#undef PG8_SB
#undef PG8_STAGE
#undef PG8_LDA
#undef PG8_LDB
#undef PG8_MMA
#undef PG8_WAIT_V
#undef PG8_WAIT_L
#undef PG8_BAR
#undef PG8_SCHED
#undef PG8_GATHER_OFFS
}

__device__ __forceinline__ u32x4 pack8(const f32x4 v0, const f32x4 v1) { u32x4 w; w.x = cvt_pk_bf16(v0[0], v0[1]); w.y = cvt_pk_bf16(v0[2], v0[3]); w.z = cvt_pk_bf16(v1[0], v1[1]); w.w = cvt_pk_bf16(v1[2], v1[3]); return w; }
__device__ __forceinline__ void unpack8v(const u32x4 w, f32x4& v0, f32x4& v1) {
  v0[0] = __uint_as_float(w.x << 16); v0[1] = __uint_as_float(w.x & 0xffff0000u); v0[2] = __uint_as_float(w.y << 16); v0[3] = __uint_as_float(w.y & 0xffff0000u);
  v1[0] = __uint_as_float(w.z << 16); v1[1] = __uint_as_float(w.z & 0xffff0000u); v1[2] = __uint_as_float(w.w << 16); v1[3] = __uint_as_float(w.w & 0xffff0000u); }

__device__ __forceinline__ void rope8(f32x4& v0, f32x4& v1, const float* ct, const float* st, int xorm, bool first, bool active, int lane) {
  f32x4 p0, p1;
#pragma unroll
  for (int j = 0; j < 4; ++j) { p0[j] = __int_as_float(__builtin_amdgcn_ds_bpermute((lane ^ xorm) << 2, __float_as_int(v0[j]))); p1[j] = __int_as_float(__builtin_amdgcn_ds_bpermute((lane ^ xorm) << 2, __float_as_int(v1[j]))); }
  const f32x4 c0 = *(const f32x4*)ct, c1 = *(const f32x4*)(ct + 4), s0 = *(const f32x4*)st, s1 = *(const f32x4*)(st + 4);
  const float sg = first ? -1.f : 1.f;
  const f32x4 n0 = v0 * c0 + (p0 * s0) * sg, n1 = v1 * c1 + (p1 * s1) * sg;
  if (active) { v0 = n0; v1 = n1; }
}
enum { K_PLAIN = 0, K_SIG, K_ROPE_A, K_ROPE_I, K_ROPE_B, K_SSQ };
struct EpiIn {
  unsigned char* ws;
  __device__ __forceinline__ void operator()(const f32x4 (&acc)[2][2][4][2], const Unit& u, int wr, int wc, int fr, int fq) const {
    const float* rstd = (const float*)(ws + OFF_CTL + CTL_RSTD); const float* rt = (const float*)(ws + OFF_CTL + CTL_ROPE);
    const int pn = u.pn, lane = fr + 16 * fq;
    float rsv[8];
#pragma unroll
    for (int k = 0; k < 8; ++k) rsv[k] = rstd[u.pm * BM + (k >> 2) * HALF + wr * 64 + (k & 3) * 16 + fr];
#pragma unroll
    for (int bj = 0; bj < 2; ++bj) {
      bf16_t* base; int pitch, lc, kind = K_PLAIN, rg = 0; float* ssq = nullptr;
      const int gc = bj * 128 + wc * 32;
      if (pn < 2) { base = (bf16_t*)(ws + OFF_AQ); pitch = 512; lc = pn * 256 + gc; if (wc == 0) kind = K_ROPE_A; }
      else if (pn == 2) { base = (bf16_t*)(ws + (bj == 0 ? OFF_AK : OFF_AV)); pitch = 128; lc = wc * 32; if (bj == 0 && wc == 0) kind = K_ROPE_A; }
      else if (pn < 5) { base = (bf16_t*)(ws + OFF_AIQ); pitch = 512; lc = (pn - 3) * 256 + gc; if ((wc & 1) == 0) kind = K_ROPE_I; }
      else if (pn == 5) { if (bj == 0) { if (wc < 2) { base = (bf16_t*)(ws + OFF_AIK); pitch = 64; lc = wc * 32; if (wc == 0) kind = K_ROPE_I; }
                                         else { base = (bf16_t*)(ws + OFF_BKR); pitch = 64; lc = (wc - 2) * 32; kind = K_ROPE_B; rg = wc - 2; } }
                          else { base = (bf16_t*)(ws + OFF_BC); pitch = 384; lc = 256 + wc * 32; kind = K_SSQ; ssq = (float*)(ws + OFF_CTL + CTL_SSQKV); } }
      else if (pn == 6) { base = (bf16_t*)(ws + OFF_BC); pitch = 384; lc = gc; kind = K_SSQ; ssq = (float*)(ws + OFF_CTL + CTL_SSQQ) + bj * 4 * T; }
      else if (pn < 9) { base = (bf16_t*)(ws + OFF_CQ); pitch = 512; lc = (pn - 7) * 256 + gc; }
      else if (pn < 11) { base = (bf16_t*)(ws + OFF_CK); pitch = 512; lc = (pn - 9) * 256 + gc; }
      else if (pn < 13) { base = (bf16_t*)(ws + OFF_CV); pitch = 512; lc = (pn - 11) * 256 + gc; }
      else if (pn < 25) { base = (bf16_t*)(ws + OFF_G); pitch = 3072; lc = (pn - 13) * 256 + gc; kind = K_SIG; }
      else { base = (bf16_t*)(ws + OFF_AIWB); pitch = 256; lc = gc; }
#pragma unroll
      for (int ai = 0; ai < 2; ++ai)
#pragma unroll
        for (int m = 0; m < 4; ++m) {
          const int row = u.pm * BM + ai * HALF + wr * 64 + m * 16 + fr; const float rs = rsv[ai * 4 + m]; const int pos = row & (SEQ - 1);
          f32x4 v0 = acc[ai][bj][m][0] * rs, v1 = acc[ai][bj][m][1] * rs;
          if (kind == K_SIG) {
#pragma unroll
            for (int j = 0; j < 4; ++j) { v0[j] = __builtin_amdgcn_rcpf(1.f + __expf(-v0[j])); v1[j] = __builtin_amdgcn_rcpf(1.f + __expf(-v1[j])); } }
          else if (kind == K_ROPE_A) rope8(v0, v1, rt + RT_COSA + pos * 16 + 8 * (fq & 1), rt + RT_SINA + pos * 16 + 8 * (fq & 1), 32, fq < 2, true, lane);
          else if (kind == K_ROPE_I) rope8(v0, v1, rt + RT_COSI + pos * 8, rt + RT_SINI + pos * 8, 16, fq == 0, fq < 2, lane);
          else if (kind == K_ROPE_B) rope8(v0, v1, rt + RT_COSB + pos * 32 + 16 * rg + 8 * (fq & 1), rt + RT_SINB + pos * 32 + 16 * rg + 8 * (fq & 1), 32, fq < 2, true, lane);
          else if (kind == K_SSQ) { float q = 0.f;
#pragma unroll
            for (int j = 0; j < 4; ++j) q += v0[j] * v0[j] + v1[j] * v1[j];
            q += __int_as_float(__builtin_amdgcn_ds_bpermute((lane ^ 16) << 2, __float_as_int(q))); q += __int_as_float(__builtin_amdgcn_ds_bpermute((lane ^ 32) << 2, __float_as_int(q)));
            if (fq == 0) ssq[(size_t)row * 4 + wc] = q; }
          *(u32x4*)(base + (size_t)row * pitch + lc + 8 * fq) = pack8(v0, v1);
        }
    }
  }
};
template <int NP, int W, bool ROPE>
struct EpiUp {
  unsigned char* ws; bf16_t* O; int pitch; const float* ssq;
  __device__ __forceinline__ void operator()(const f32x4 (&acc)[2][2][4][2], const Unit& u, int wr, int wc, int fr, int fq) const {
    const float* rt = (const float*)(ws + OFF_CTL + CTL_ROPE); const int lane = fr + 16 * fq;
#pragma unroll
    for (int ai = 0; ai < 2; ++ai) {
      float rsv[4];
#pragma unroll
      for (int k = 0; k < 4; ++k) { const int row = u.pm * BM + ai * HALF + wr * 64 + k * 16 + fr; float q = 0.f;
#pragma unroll
        for (int p = 0; p < NP; ++p) { const f32x4 s4 = *(const f32x4*)(ssq + (size_t)p * 4 * T + (size_t)row * 4); q += (s4[0] + s4[1]) + (s4[2] + s4[3]); }
        rsv[k] = rsqrtf(q * (1.f / W) + EPS); }
#pragma unroll
      for (int m = 0; m < 4; ++m) { const int row = u.pm * BM + ai * HALF + wr * 64 + m * 16 + fr; const int pos = row & (SEQ - 1);
        const float rs = rsv[m];
#pragma unroll
        for (int bj = 0; bj < 2; ++bj) { f32x4 v0 = acc[ai][bj][m][0] * rs, v1 = acc[ai][bj][m][1] * rs;
          if (ROPE && u.pn == 2) { const int rg = wc & 1; rope8(v0, v1, rt + RT_COSB + pos * 32 + 16 * rg + 8 * (fq & 1), rt + RT_SINB + pos * 32 + 16 * rg + 8 * (fq & 1), 32, fq < 2, true, lane); }
          *(u32x4*)(O + (size_t)row * pitch + u.pn * BM + bj * HALF + wc * 32 + 8 * fq) = pack8(v0, v1); } } }
  }
};
struct EpiProj {
  unsigned char* ws;
  static __device__ __forceinline__ bool keep(const Unit& u) { return u.aux < 2; }
  __device__ __forceinline__ void operator()(f32x4 (&acc)[2][2][4][2], const Unit& u, int wr, int wc, int fr, int fq) const {
    const int b = u.aux;
#pragma unroll
    for (int ai = 0; ai < 2; ++ai) {
      u32x4 gn[4][2], gd[4][2];
#pragma unroll
      for (int m = 0; m < 4; ++m) { const int row = u.pm * BM + ai * HALF + wr * 64 + m * 16 + fr;
#pragma unroll
        for (int bj = 0; bj < 2; ++bj) { const int col = u.pn * BM + bj * HALF + wc * 32 + 8 * fq;
          gn[m][bj] = *(const u32x4*)((const bf16_t*)(ws + OFF_G) + (size_t)row * 3072 + b * 1024 + col);
          if (b < 2) gd[m][bj] = *(const u32x4*)((const bf16_t*)(ws + OFF_G) + (size_t)row * 3072 + (b + 1) * 1024 + col); } }
#pragma unroll
      for (int m = 0; m < 4; ++m) { const int row = u.pm * BM + ai * HALF + wr * 64 + m * 16 + fr;
#pragma unroll
        for (int bj = 0; bj < 2; ++bj) { const int col = u.pn * BM + bj * HALF + wc * 32 + 8 * fq;
          f32x4 g0, g1; unpack8v(gn[m][bj], g0, g1);
          if (b < 2) { f32x4 d0, d1; unpack8v(gd[m][bj], d0, d1);
#pragma unroll
            for (int j = 0; j < 4; ++j) { g0[j] *= __builtin_amdgcn_rcpf(fmaxf(d0[j], 1e-30f)); g1[j] *= __builtin_amdgcn_rcpf(fmaxf(d1[j], 1e-30f)); } }
          acc[ai][bj][m][0] *= g0; acc[ai][bj][m][1] *= g1;
          if (b == 2) *(u32x4*)((bf16_t*)(ws + OFF_MIX) + (size_t)row * 1024 + col) = pack8(acc[ai][bj][m][0], acc[ai][bj][m][1]); } }
    }
  }
};
struct EpiOut {
  float* x; bf16_t* xb;
  __device__ __forceinline__ void operator()(const f32x4 (&acc)[2][2][4][2], const Unit& u, int wr, int wc, int fr, int fq) const {
#pragma unroll
    for (int ai = 0; ai < 2; ++ai)
#pragma unroll
    for (int mh = 0; mh < 2; ++mh) {
      f32x4 xv[2][2][2];
#pragma unroll
      for (int m2 = 0; m2 < 2; ++m2) { const int m = mh * 2 + m2, row = u.pm * BM + ai * HALF + wr * 64 + m * 16 + fr;
#pragma unroll
        for (int bj = 0; bj < 2; ++bj) { const size_t off = (size_t)row * DM + u.pn * BM + bj * HALF + wc * 32 + 8 * fq; xv[m2][bj][0] = *(const f32x4*)(x + off); xv[m2][bj][1] = *(const f32x4*)(x + off + 4); } }
#pragma unroll
      for (int m2 = 0; m2 < 2; ++m2) { const int m = mh * 2 + m2, row = u.pm * BM + ai * HALF + wr * 64 + m * 16 + fr;
#pragma unroll
        for (int bj = 0; bj < 2; ++bj) { const size_t off = (size_t)row * DM + u.pn * BM + bj * HALF + wc * 32 + 8 * fq;
          const f32x4 a0 = xv[m2][bj][0] + acc[ai][bj][m][0], a1 = xv[m2][bj][1] + acc[ai][bj][m][1];
          *(f32x4*)(x + off) = a0; *(f32x4*)(x + off + 4) = a1; *(u32x4*)(xb + off) = pack8(a0, a1); } }
    }
  }
};
struct EpiUpBoth {
  unsigned char* ws;
  __device__ __forceinline__ void operator()(const f32x4 (&acc)[2][2][4][2], const Unit& u, int wr, int wc, int fr, int fq) const {
    if (u.aux == 0) { EpiUp<2, 256, true> e{ws, (bf16_t*)(ws + OFF_QB), 768, (const float*)(ws + OFF_CTL + CTL_SSQQ)}; e(acc, u, wr, wc, fr, fq); }
    else { EpiUp<1, 128, false> e{ws, (bf16_t*)(ws + OFF_KVB), 1024, (const float*)(ws + OFF_CTL + CTL_SSQKV)}; e(acc, u, wr, wc, fr, fq); }
  }
};
struct UpOrder {
  unsigned char* ws; int G, c;
  __device__ __forceinline__ bool next(int i, Unit& u) const {
    const int iw = c & 31, bq = c >> 5; const bool light = iw < 4 || iw >= 28;
    int L;
    if (light) { const int lw = bq * 8 + (iw < 4 ? iw : iw - 24); if (i >= 4) return false; L = i < 3 ? 3 * lw + i : 192 + 192 + lw; }
    else { const int hw = bq * 24 + (iw - 4); if (i >= 1) return false; L = 192 + hw; }
    u.rows = nullptr;
    if (L < 192) { u.pm = L / 3; u.pn = L % 3; u.aux = 0; u.nt = 4; u.A = (const char*)(ws + OFF_BC) + (size_t)u.pm * BM * 384 * 2; u.B = (const char*)(ws + OFF_WATT + WA_UQ) + (size_t)u.pn * BM * 256 * 2; }
    else { const int k = L - 192; u.pm = k >> 2; u.pn = k & 3; u.aux = 1; u.nt = 2; u.A = (const char*)(ws + OFF_BC) + (size_t)u.pm * BM * 384 * 2 + 512; u.B = (const char*)(ws + OFF_WATT + WA_UKV) + (size_t)u.pn * BM * 256 * 2; }
    return true; }
};
struct ProjOrder {
  unsigned char* ws; int G, c;
  __device__ __forceinline__ bool next(int i, Unit& u) const {
    const int b = i % 3; if (!static_tile(i / 3, G, c, T / BM, 4, u.pm, u.pn)) return false;
    const size_t oa = b == 0 ? OFF_AQ : b == 1 ? OFF_AIQ : OFF_CQ;
    u.A = (const char*)(ws + oa) + (size_t)u.pm * BM * 512 * 2; u.B = (const char*)(ws + OFF_WATT + WA_P) + ((size_t)b * 1024 + (size_t)u.pn * BM) * 512 * 2; u.rows = nullptr; u.aux = b; u.nt = 8; return true; }
};

__device__ __forceinline__ void moe_build_map(unsigned* cntp, PG8_LAS unsigned* tab, int tid) {
  if (tid < 64) { const int lane = tid;
    const unsigned c = lane < 32 ? __hip_atomic_load(cntp + lane, __ATOMIC_RELAXED, __HIP_MEMORY_SCOPE_AGENT) : 0u;
    const unsigned nt = (c + 255u) >> 8; unsigned incl = nt;
#pragma unroll
    for (int o = 1; o < 32; o <<= 1) { const unsigned v = (unsigned)__builtin_amdgcn_ds_bpermute(((lane - o) & 63) << 2, (int)incl); if ((lane & 31) >= o) incl += v; }
    const unsigned start = incl - nt;
    if (lane < 32) for (unsigned j = 0; j < nt; ++j) { unsigned valid = c - j * 256u; valid = valid > 256u ? 256u : valid; tab[start + j] = (unsigned)lane | (j << 8) | (valid << 16); }
    if (lane == 31) tab[255] = incl; }
  __syncthreads();
}
template <int NPN, bool DOWN>
struct MoeOrder {
  unsigned char* ws; int G, c; const PG8_LAS unsigned* tab; int lo, hi;
  __device__ __forceinline__ bool next(int i, Unit& u) const {
    const int L = lo + i * G + c, tile = L / NPN, pn = L % NPN; const int total = __builtin_amdgcn_readfirstlane((int)tab[255]); if (c < 0 || L >= hi || tile >= total) return false;
    const unsigned rec = (unsigned)__builtin_amdgcn_readfirstlane((int)tab[tile]);
    const int e = rec & 255u, j = (rec >> 8) & 255u, valid = rec >> 16;
    u.pm = tile; u.pn = pn; u.aux = valid; u.nt = DOWN ? 4 : 16; u.rows = (const int*)(ws + OFF_LIST) + (size_t)e * T + j * 256;
    if (!DOWN) { u.A = (const char*)(ws + OFF_XB); u.B = (const char*)(ws + OFF_WGU) + ((size_t)e * 512 + (size_t)pn * 256) * 1024 * 2; }
    else { u.A = (const char*)(ws + OFF_H) + (size_t)tile * 256 * 256 * 2; u.B = (const char*)(ws + OFF_WD) + ((size_t)e * 1024 + (size_t)pn * 256) * 256 * 2; }
    return true; }
};
struct EpiGU {
  unsigned char* ws;
  __device__ __forceinline__ void operator()(const f32x4 (&acc)[2][2][4][2], const Unit& u, int wr, int wc, int fr, int fq) const {
    const float* rstd = (const float*)(ws + OFF_CTL + CTL_RSTD); const float* tokw = (const float*)(ws + OFF_CTL + CTL_TOKW);
    int ent[8]; float rs[8], wv[8];
#pragma unroll
    for (int k = 0; k < 8; ++k) { const int r = (k >> 2) * HALF + wr * 64 + (k & 3) * 16 + fr; ent[k] = u.rows[r < u.aux ? r : u.aux - 1]; }
#pragma unroll
    for (int k = 0; k < 8; ++k) { rs[k] = rstd[ent[k] >> 1]; wv[k] = tokw[ent[k]]; }
#pragma unroll
    for (int ai = 0; ai < 2; ++ai)
#pragma unroll
      for (int m = 0; m < 4; ++m) { const int r = ai * HALF + wr * 64 + m * 16 + fr; const int k = ai * 4 + m;
        { const float rsk = rs[k], w = wv[k];
          f32x4 h0, h1;
#pragma unroll
          for (int j = 0; j < 4; ++j) { const float a0 = acc[ai][0][m][0][j] * rsk, a1 = acc[ai][0][m][1][j] * rsk;
            h0[j] = a0 * __builtin_amdgcn_rcpf(1.f + __expf(-a0)) * (acc[ai][1][m][0][j] * rsk) * w; h1[j] = a1 * __builtin_amdgcn_rcpf(1.f + __expf(-a1)) * (acc[ai][1][m][1][j] * rsk) * w; }
          *(u32x4*)((bf16_t*)(ws + OFF_H) + ((size_t)u.pm * 256 + r) * 256 + u.pn * 128 + wc * 32 + 8 * fq) = pack8(h0, h1); } }
  }
};
struct EpiDown {
  unsigned char* ws;
  __device__ __forceinline__ void operator()(const f32x4 (&acc)[2][2][4][2], const Unit& u, int wr, int wc, int fr, int fq) const {
    int ent[8];
#pragma unroll
    for (int k = 0; k < 8; ++k) { const int r = (k >> 2) * HALF + wr * 64 + (k & 3) * 16 + fr; ent[k] = u.rows[r < u.aux ? r : u.aux - 1]; }
#pragma unroll
    for (int ai = 0; ai < 2; ++ai)
#pragma unroll
      for (int m = 0; m < 4; ++m) { const int r = ai * HALF + wr * 64 + m * 16 + fr;
        { const int entry = r < u.aux ? ent[ai * 4 + m] : 2 * T;
#pragma unroll
          for (int bj = 0; bj < 2; ++bj) *(u32x4*)((bf16_t*)(ws + OFF_Y) + (size_t)entry * 1024 + u.pn * BM + bj * HALF + wc * 32 + 8 * fq) = pack8(acc[ai][bj][m][0], acc[ai][bj][m][1]); } }
  }
};
}

namespace att {
using bf16x8 = __attribute__((ext_vector_type(8))) short;
using s16x4  = __attribute__((ext_vector_type(4))) short;
using f32x16 = __attribute__((ext_vector_type(16))) float;
using u32x4  = __attribute__((ext_vector_type(4))) unsigned;
constexpr int KVBLK = 64;
constexpr float THR = 8.f, NEG = -1e30f, M_INIT = -1e6f;
#define ASBAR() __builtin_amdgcn_sched_barrier(0)
__device__ __forceinline__ constexpr int crow_c(int r) { return (r & 3) + 8 * (r >> 2); }
__device__ __forceinline__ unsigned cvtpk(float lo, float hi) { unsigned r; asm volatile("v_cvt_pk_bf16_f32 %0, %1, %2" : "=v"(r) : "v"(lo), "v"(hi)); return r; }
template <int MODE> struct Cfg {
  static constexpr int DQK = MODE == 1 ? 192 : 128, ND0 = DQK / 16, KP = DQK * 2, SHM_K = 64 * KP;
  static constexpr float SCALE = MODE == 1 ? 0.07216878364870322f : 0.088388347648318440f;
};
template <int MODE>
__device__ __forceinline__ void partialSM(f32x16& p0, f32x16& p1, float& m_reg, float& mn, float& alpha) {
  constexpr float SC = Cfg<MODE>::SCALE, C = SC * 1.4426950408889634f;
#pragma unroll
  for (int r = 0; r < 16; ++r) { p0[r] *= C; p1[r] *= C; }
  float pmax = p0[0];
#pragma unroll
  for (int r = 1; r < 16; ++r) pmax = fmaxf(pmax, p0[r]);
#pragma unroll
  for (int r = 0; r < 16; ++r) pmax = fmaxf(pmax, p1[r]);
  { auto rr = __builtin_amdgcn_permlane32_swap(__float_as_uint(pmax), __float_as_uint(pmax), false, false);
    pmax = fmaxf(__uint_as_float(rr[0]), __uint_as_float(rr[1])); }
  if (__builtin_expect(__all(pmax - m_reg <= THR * 1.4426950408889634f), 1)) { mn = m_reg; alpha = 1.f; }
  else { mn = fmaxf(m_reg, pmax); alpha = __builtin_amdgcn_exp2f(m_reg - mn); m_reg = mn; }
#pragma unroll
  for (int r = 0; r < 16; ++r) { p0[r] -= mn; p1[r] -= mn; }
#pragma unroll
  for (int r = 0; r < 16; ++r) p0[r] = __builtin_amdgcn_exp2f(p0[r]);
}
__device__ __forceinline__ void finishSM(f32x16& p0, f32x16& p1, float alpha, float& l_reg, bf16x8& pa0, bf16x8& pa1, bf16x8& pa2, bf16x8& pa3) {
#pragma unroll
  for (int r = 0; r < 16; ++r) p1[r] = __builtin_amdgcn_exp2f(p1[r]);
  float ps = 0;
#pragma unroll
  for (int r = 0; r < 16; ++r) ps += p0[r];
#pragma unroll
  for (int r = 0; r < 16; ++r) ps += p1[r];
  { auto rr = __builtin_amdgcn_permlane32_swap(__float_as_uint(ps), __float_as_uint(ps), false, false);
    ps = __uint_as_float(rr[0]) + __uint_as_float(rr[1]); }
  l_reg = l_reg * alpha + ps;
#define PK4(P, BASE, OUT) do { unsigned a0 = cvtpk(P[BASE + 0], P[BASE + 1]), a1 = cvtpk(P[BASE + 2], P[BASE + 3]);   \
    unsigned b0 = cvtpk(P[BASE + 4], P[BASE + 5]), b1 = cvtpk(P[BASE + 6], P[BASE + 7]);                              \
    auto r0 = __builtin_amdgcn_permlane32_swap(a0, b0, false, false); auto r1 = __builtin_amdgcn_permlane32_swap(a1, b1, false, false); \
    u32x4 w = {r0[0], r1[0], r0[1], r1[1]}; OUT = *reinterpret_cast<bf16x8*>(&w); } while (0)
  PK4(p0, 0, pa0); PK4(p0, 8, pa1); PK4(p1, 0, pa2); PK4(p1, 8, pa3);
#undef PK4
}
#define KSWZ(row, colB, KP) ((row) * (KP) + ((colB) ^ (((row) & 7) << 4)))
template <int MODE>
__device__ __forceinline__ void qkt(f32x16& p0, f32x16& p1, const char* Ks, const bf16x8* qr, const char* qx  , int r32, int hi) {
  constexpr int KP = Cfg<MODE>::KP;
  p0 = f32x16{}; p1 = f32x16{};
#pragma unroll
  for (int d0 = 0; d0 < Cfg<MODE>::ND0; ++d0) { const int cb = (d0 * 16 + hi * 8) * 2;
    bf16x8 b0 = *reinterpret_cast<const bf16x8*>(Ks + KSWZ(r32, cb, KP));
    bf16x8 b1 = *reinterpret_cast<const bf16x8*>(Ks + KSWZ(32 + r32, cb, KP));
    const bf16x8 q = d0 < 8 ? qr[d0 < 8 ? d0 : 0] : *reinterpret_cast<const bf16x8*>(qx + (d0 - 8) * 32);
    p0 = __builtin_amdgcn_mfma_f32_32x32x16_bf16(b0, q, p0, 0, 0, 0);
    p1 = __builtin_amdgcn_mfma_f32_32x32x16_bf16(b1, q, p1, 0, 0, 0); }
}
__device__ __forceinline__ int v_st(int k, int c) { const int kk = (k & ~0xC) | ((k & 4) << 1) | ((k & 8) >> 1); return ((kk >> 3) * 4 + (c >> 5)) * 512 + ((kk & 7) * 32 + (c & 31)) * 2; }
__device__ __forceinline__ int v_rd_base(int lane) { return ((lane & 3) << 3) | (((lane >> 2) & 3) << 6) | (((lane >> 4) & 1) << 5) | (((lane >> 5) & 1) << 8); }
constexpr int v_rd_off(int d0, int ks, int half) { return d0 * 512 + ks * 4096 + half * 2048; }
template <int OFF> __device__ __forceinline__ s16x4 tr_read(int vb) {
  s16x4 r; asm volatile("ds_read_b64_tr_b16 %0, %1 offset:%2" : "=&v"(r) : "v"(vb), "i"(OFF) : "memory"); return r;
}
template <int D0> __device__ __forceinline__ void pv_one(f32x16& od, int vb, bf16x8 pa0, bf16x8 pa1, bf16x8 pa2, bf16x8 pa3) {
  const s16x4 l0 = tr_read<v_rd_off(D0, 0, 0)>(vb), h0 = tr_read<v_rd_off(D0, 0, 1)>(vb), l1 = tr_read<v_rd_off(D0, 1, 0)>(vb), h1 = tr_read<v_rd_off(D0, 1, 1)>(vb);
  const s16x4 l2 = tr_read<v_rd_off(D0, 2, 0)>(vb), h2 = tr_read<v_rd_off(D0, 2, 1)>(vb), l3 = tr_read<v_rd_off(D0, 3, 0)>(vb), h3 = tr_read<v_rd_off(D0, 3, 1)>(vb);
  asm volatile("s_waitcnt lgkmcnt(0)" ::: "memory"); ASBAR();
#define PK(L, H) (bf16x8){L[0], L[1], L[2], L[3], H[0], H[1], H[2], H[3]}
  od = __builtin_amdgcn_mfma_f32_32x32x16_bf16(pa0, PK(l0, h0), od, 0, 0, 0);
  od = __builtin_amdgcn_mfma_f32_32x32x16_bf16(pa1, PK(l1, h1), od, 0, 0, 0);
  od = __builtin_amdgcn_mfma_f32_32x32x16_bf16(pa2, PK(l2, h2), od, 0, 0, 0);
  od = __builtin_amdgcn_mfma_f32_32x32x16_bf16(pa3, PK(l3, h3), od, 0, 0, 0);
#undef PK
}
__device__ __forceinline__ void pv_d0(f32x16* o, int vb, bf16x8 pa0, bf16x8 pa1, bf16x8 pa2, bf16x8 pa3) {
  pv_one<0>(o[0], vb, pa0, pa1, pa2, pa3); pv_one<1>(o[1], vb, pa0, pa1, pa2, pa3); pv_one<2>(o[2], vb, pa0, pa1, pa2, pa3); pv_one<3>(o[3], vb, pa0, pa1, pa2, pa3);
}
template <int MODE>
__device__ __forceinline__ void post_scores(f32x16& p0, f32x16& p1, int jt, int jlo_w, int jhi_w, int cw, const char* xl, int qloc, int hi) {
  if (MODE == 0) {
    const uint2 w = *reinterpret_cast<const uint2*>(xl + qloc * 264 + jt * 8);
    const unsigned wl = w.x >> (4 * hi), wh = w.y >> (4 * hi);
#pragma unroll
    for (int r = 0; r < 16; ++r) { const unsigned m0 = (unsigned)__builtin_amdgcn_sbfe((int)wl, crow_c(r), 1), m1 = (unsigned)__builtin_amdgcn_sbfe((int)wh, crow_c(r), 1);
      p0[r] = __uint_as_float((__float_as_uint(p0[r]) & m0) | (__float_as_uint(NEG) & ~m0)); p1[r] = __uint_as_float((__float_as_uint(p1[r]) & m1) | (__float_as_uint(NEG) & ~m1)); }
  } else {
    if (jt > jhi_w || jt < jlo_w) {
#pragma unroll
      for (int r = 0; r < 16; ++r) { p0[r] = NEG; p1[r] = NEG; }
    } else if (MODE == 2) {
      const float* tab = reinterpret_cast<const float*>(xl);
      const int dj = cw - jt;
      if (dj >= 3) { const float bf = tab[256];
#pragma unroll
        for (int r = 0; r < 16; ++r) { p0[r] += bf; p1[r] += bf; } }
      else { const int dbase = dj * 64 + qloc - 4 * hi;
#pragma unroll
        for (int r = 0; r < 16; ++r) { int d0 = dbase - crow_c(r), d1 = d0 - 32; d0 = d0 > 128 ? 128 : d0; d1 = d1 > 128 ? 128 : d1; p0[r] += tab[d0 + 128]; p1[r] += tab[d1 + 128]; } }
    }
  }
}
template <int MODE>
__device__ __forceinline__ void attn_unit(unsigned char* ws, const float* relb, const int tid, char* lds, const int b, const int hx, const int cg, const bool dry = false) {
  using C = Cfg<MODE>;
  constexpr int KP = C::KP, SHM_K = C::SHM_K, SHM_V = 16384, ND0 = C::ND0;
  const int wid = __builtin_amdgcn_readfirstlane(tid >> 6), lane = tid & 63, r32 = lane & 31, hi = lane >> 5;
  char* V_lds = lds; char* K_lds = lds + 2 * SHM_V;
  float* wsc = reinterpret_cast<float*>(lds + 2 * SHM_V + 2 * SHM_K) + wid * 64; float* li_l = wsc; float* al_l = wsc + 32;
  char* xl = lds + 2 * SHM_V + 2 * SHM_K + 2048;
  const size_t tb = (size_t)b * SEQ;
  const int cw = MODE == 0 ? cg : 4 * cg + (wid >> 1);
  const int qloc = (wid & 1) * 32 + r32;
  const size_t tok = tb + (size_t)cw * 64 + qloc;
  const int j0 = MODE == 2 ? (4 * cg - 8 > 0 ? 4 * cg - 8 : 0) : 0;
  const int NT = MODE == 0 ? ((cg + 2) & ~1) : (4 * cg + 4 - j0);
  const int jlo_w = MODE == 2 ? (cw - 8 > 0 ? cw - 8 : 0) : 0, jhi_w = cw;
  const bf16_t* Kh; const bf16_t* Vh; const bf16_t* Kr = nullptr; int LDK;
  if (MODE == 0) { Kh = (const bf16_t*)(ws + OFF_AK) + tb * 128; Vh = (const bf16_t*)(ws + OFF_AV) + tb * 128; LDK = 128; }
  else if (MODE == 1) { Kh = (const bf16_t*)(ws + OFF_KVB) + tb * 1024 + hx * 256; Vh = Kh + 128; Kr = (const bf16_t*)(ws + OFF_BKR) + tb * 64; LDK = 1024; }
  else { Kh = (const bf16_t*)(ws + OFF_CK) + tb * 512 + hx * 128; Vh = (const bf16_t*)(ws + OFF_CV) + tb * 512 + hx * 128; LDK = 512; }
  __syncthreads();
  if (MODE == 0) { const uint2* mb = (const uint2*)(ws + OFF_MASK) + (tb + (size_t)cg * 64) * 32;
    for (int i = tid; i < 64 * 32; i += 512) { const int q = i >> 5, j = i & 31; *reinterpret_cast<uint2*>(xl + q * 264 + j * 8) = mb[i]; } }
  if (MODE == 2) { for (int i = tid; i < 257; i += 512) reinterpret_cast<float*>(xl)[i] = relb[hx * 257 + i] * (1.f / C::SCALE); }
  float m_reg = M_INIT, l_reg = 0; f32x16 o[4] = {}; bf16x8 qr[8];
  const char* qx = xl + wid * 4608 + r32 * 144 + hi * 16;
  { const bf16_t* Qw;
    if (MODE == 0) Qw = (const bf16_t*)(ws + OFF_AQ) + tok * 512 + (wid >> 1) * 128 + hi * 8;
    else if (MODE == 1) Qw = (const bf16_t*)(ws + OFF_QB) + tok * 768 + hx * 128 + hi * 8;
    else Qw = (const bf16_t*)(ws + OFF_CQ) + tok * 512 + hx * 128 + hi * 8;
#pragma unroll
    for (int d0 = 0; d0 < 8; ++d0) qr[d0] = *reinterpret_cast<const bf16x8*>(Qw + d0 * 16);
    if (MODE == 1) { const bf16_t* Qr = (const bf16_t*)(ws + OFF_QB) + tok * 768 + 512 + hx * 64 + hi * 8;
#pragma unroll
      for (int d0 = 8; d0 < ND0; ++d0) *reinterpret_cast<bf16x8*>(const_cast<char*>(qx) + (d0 - 8) * 32) = *reinterpret_cast<const bf16x8*>(Qr + (d0 - 8) * 16); } }
  const int sr = tid >> 4, sc = (tid & 15) * 8, vst0 = v_st(sr, sc), vst1 = v_st(32 + sr, sc);
  const int vb0 = (int)(uintptr_t)V_lds + v_rd_base(lane);
  constexpr int NPI = SHM_K / 8192;
  unsigned koff[NPI], kstr[NPI];
#pragma unroll
  for (int i = 0; i < NPI; ++i) { const int L = (i * 8 + wid) * 1024 + lane * 16, row = L / KP, cs = L % KP, colB = cs ^ ((row & 7) << 4);
    if (MODE == 1 && colB >= 256) { koff[i] = (unsigned)(OFF_BKR + (tb + (size_t)j0 * 64 + row) * 128 + (colB - 256)); kstr[i] = 64 * 128; }
    else { koff[i] = (unsigned)((MODE == 0 ? OFF_AK : MODE == 1 ? OFF_KVB : OFF_CK) + (tb + (size_t)j0 * 64 + row) * (size_t)LDK * 2 + (MODE == 0 ? 0 : MODE == 1 ? hx * 512 : hx * 256) + colB); kstr[i] = 64 * LDK * 2; } }
  bf16x8 vs0, vs1;
#define SLOAD(jrel, bf) do { const int k0_ = kbase + (jrel) * KVBLK; \
    vs0 = *reinterpret_cast<const bf16x8*>(&Vh[(size_t)(k0_ + sr) * LDK + sc]); vs1 = *reinterpret_cast<const bf16x8*>(&Vh[(size_t)(k0_ + 32 + sr) * LDK + sc]); \
    _Pragma("unroll") for (int i_ = 0; i_ < NPI; ++i_) { __builtin_amdgcn_global_load_lds((const unsigned*)(ws + koff[i_]), \
        (__attribute__((address_space(3))) unsigned*)(K_lds + (bf) * SHM_K + (i_ * 8 + wid) * 1024), 16, 0, 0); koff[i_] += (MODE == 1 ? kstr[i_] : (unsigned)(64 * LDK * 2)); } } while (0)
#define SWRITE(bf) do { *reinterpret_cast<bf16x8*>(V_lds + (bf) * SHM_V + vst0) = vs0; *reinterpret_cast<bf16x8*>(V_lds + (bf) * SHM_V + vst1) = vs1; } while (0)
#define RESC(a) do { if (__any((a) < 1.f)) { if (hi == 0) al_l[r32] = (a); asm volatile("s_waitcnt lgkmcnt(0)" ::: "memory"); \
    _Pragma("unroll") for (int d = 0; d < 4; ++d) _Pragma("unroll") for (int r = 0; r < 16; ++r) o[d][r] *= al_l[crow_c(r) + 4 * hi]; } } while (0)
#define POST(P0, P1, jrel) post_scores<MODE>(P0, P1, j0 + (jrel), jlo_w, jhi_w, cw, xl, qloc, hi)
  const int kbase = j0 * KVBLK; (void)kbase;
  bf16x8 pa0, pa1, pa2, pa3;
  if (MODE != 2) {
    f32x16 p0, p1; float mn, al;
    SLOAD(0, 0); asm volatile("s_waitcnt vmcnt(0)" ::: "memory"); SWRITE(0); __syncthreads();
    for (int j = 0; j < NT; j += 2) {
      SLOAD(j + 1, 1); ASBAR();
      qkt<MODE>(p0, p1, K_lds, qr, qx, r32, hi); POST(p0, p1, j); partialSM<MODE>(p0, p1, m_reg, mn, al); RESC(al);
      finishSM(p0, p1, al, l_reg, pa0, pa1, pa2, pa3); ASBAR();
      pv_d0(o, vb0, pa0, pa1, pa2, pa3);
      asm volatile("s_waitcnt vmcnt(0)" ::: "memory"); SWRITE(1); __syncthreads();
      const bool more = j + 2 < NT;
      if (more) SLOAD(j + 2, 0);
      ASBAR();
      qkt<MODE>(p0, p1, K_lds + SHM_K, qr, qx, r32, hi); POST(p0, p1, j + 1); partialSM<MODE>(p0, p1, m_reg, mn, al); RESC(al);
      finishSM(p0, p1, al, l_reg, pa0, pa1, pa2, pa3); ASBAR();
      pv_d0(o, vb0 + SHM_V, pa0, pa1, pa2, pa3);
      asm volatile("s_waitcnt vmcnt(0)" ::: "memory"); if (more) SWRITE(0); __syncthreads();
    }
  } else {
    f32x16 pA0, pA1, pB0, pB1; float mnA, mnB, alA, alB;
    SLOAD(0, 0); asm volatile("s_waitcnt vmcnt(0)" ::: "memory"); SWRITE(0); __syncthreads();
    qkt<MODE>(pA0, pA1, K_lds, qr, qx, r32, hi); POST(pA0, pA1, 0); partialSM<MODE>(pA0, pA1, m_reg, mnA, alA);
    SLOAD(1, 1);
    asm volatile("s_waitcnt vmcnt(0)" ::: "memory"); SWRITE(1); __syncthreads();
    for (int j = 1; j + 1 < NT; j += 2) {
      ASBAR(); qkt<MODE>(pB0, pB1, K_lds + SHM_K, qr, qx, r32, hi); POST(pB0, pB1, j);
      finishSM(pA0, pA1, alA, l_reg, pa0, pa1, pa2, pa3); ASBAR();
      SLOAD(j + 1, 0); ASBAR();
      pv_d0(o, vb0, pa0, pa1, pa2, pa3); partialSM<MODE>(pB0, pB1, m_reg, mnB, alB);
      __syncthreads(); asm volatile("s_waitcnt vmcnt(0)" ::: "memory"); SWRITE(0);
      RESC(alB); __syncthreads();
      ASBAR(); qkt<MODE>(pA0, pA1, K_lds, qr, qx, r32, hi); POST(pA0, pA1, j + 1);
      finishSM(pB0, pB1, alB, l_reg, pa0, pa1, pa2, pa3); ASBAR();
      SLOAD(j + 2, 1); ASBAR();
      pv_d0(o, vb0 + SHM_V, pa0, pa1, pa2, pa3); partialSM<MODE>(pA0, pA1, m_reg, mnA, alA);
      __syncthreads(); asm volatile("s_waitcnt vmcnt(0)" ::: "memory"); SWRITE(1);
      RESC(alA); __syncthreads();
    }
    ASBAR(); qkt<MODE>(pB0, pB1, K_lds + SHM_K, qr, qx, r32, hi); POST(pB0, pB1, NT - 1);
    finishSM(pA0, pA1, alA, l_reg, pa0, pa1, pa2, pa3); ASBAR();
    pv_d0(o, vb0, pa0, pa1, pa2, pa3); partialSM<MODE>(pB0, pB1, m_reg, mnB, alB);
    __syncthreads(); RESC(alB);
    finishSM(pB0, pB1, alB, l_reg, pa0, pa1, pa2, pa3); ASBAR();
    pv_d0(o, vb0 + SHM_V, pa0, pa1, pa2, pa3);
  }
  int lane_e = lane; asm volatile("" : "+v"(lane_e));
  const int r32e = lane_e & 31, hie = lane_e >> 5;
  if (hi == 0) li_l[r32] = l_reg; asm volatile("s_waitcnt lgkmcnt(0)" ::: "memory");
  float rli[16];
#pragma unroll
  for (int r = 0; r < 16; ++r) rli[r] = __builtin_amdgcn_rcpf(li_l[crow_c(r) + 4 * hi]);
  __syncthreads();
  char* Ost = lds + wid * 8192;
#pragma unroll
  for (int r = 0; r < 16; ++r) { const int orow = crow_c(r) + 4 * hie;
#pragma unroll
    for (int d0 = 0; d0 < 4; ++d0) *reinterpret_cast<bf16_t*>(Ost + orow * 256 + (d0 * 32 + r32e) * 2) = f2bf(o[d0][r] * rli[r]); }
  asm volatile("s_waitcnt lgkmcnt(0)" ::: "memory");
  { bf16_t* Ob; int ldo;
    const size_t tok0 = tb + (size_t)cw * 64 + (wid & 1) * 32;
    if (MODE == 0) { Ob = (bf16_t*)(ws + OFF_AQ) + tok0 * 512 + (wid >> 1) * 128; ldo = 512; }
    else if (MODE == 1) { Ob = (bf16_t*)(ws + OFF_AIQ) + tok0 * 512 + hx * 128; ldo = 512; }
    else { Ob = (bf16_t*)(ws + OFF_CQ) + tok0 * 512 + hx * 128; ldo = 512; }
#pragma unroll
    for (int i = 0; i < 8; ++i) { const int ch = i * 64 + lane_e, row = ch >> 4, c16 = ch & 15;
      const u32x4 ov = *reinterpret_cast<const u32x4*>(Ost + row * 256 + c16 * 16); if (!dry) *reinterpret_cast<u32x4*>(Ob + (size_t)row * ldo + c16 * 8) = ov; } }
#undef SLOAD
#undef SWRITE
#undef RESC
#undef POST
}
}

namespace idx {
using bf16x8 = __attribute__((ext_vector_type(8))) short;
using f32x4 = __attribute__((ext_vector_type(4))) float;
__device__ __forceinline__ unsigned ordkey(float f) { const unsigned u = __float_as_uint(f); return (u & 0x80000000u) ? ~u : (u | 0x80000000u); }
__device__ __forceinline__ void select2(const unsigned (&key)[2][32], const int nw, unsigned* h0p, unsigned* h1p, const int lane_in, unsigned (&thr)[2], bool (&allsel)[2]) {
  unsigned prefix[2] = {0u, 0u}; int rneed[2] = {256, 256}; bool done[2] = {false, false};
  thr[0] = thr[1] = 0u; allsel[0] = allsel[1] = false;
#pragma unroll
  for (int pass = 0; pass < 3; ++pass) {
    if (!(done[0] && done[1])) {
      int lane = lane_in; asm volatile("" : "+v"(lane));
      const int sh = pass == 0 ? 21 : pass == 1 ? 10 : 0, bits = pass == 2 ? 10 : 11; const unsigned nbm = (1u << bits) - 1u;
#pragma unroll
      for (int i = 0; i < 8; ++i) { *reinterpret_cast<uint4*>(reinterpret_cast<char*>(h0p) + (i * 64 + lane) * 16) = make_uint4(0u, 0u, 0u, 0u); *reinterpret_cast<uint4*>(reinterpret_cast<char*>(h1p) + (i * 64 + lane) * 16) = make_uint4(0u, 0u, 0u, 0u); }
#pragma unroll
      for (int i = 0; i < 32; ++i) if (i < nw) {
#pragma unroll
        for (int q = 0; q < 2; ++q) { const bool match = pass == 0 ? true : (key[q][i] >> (sh + bits)) == prefix[q];
          if (match) { const unsigned d = (key[q][i] >> sh) & nbm; atomicAdd(&(q ? h1p : h0p)[(d & ~31u) | ((d & 31u) ^ ((d >> 5) & 31u))], 1u); } } }
      unsigned tl[2] = {0u, 0u};
#pragma unroll
      for (int i = 0; i < 32; ++i) { tl[0] += h0p[32 * lane + (i ^ (lane & 31))]; tl[1] += h1p[32 * lane + (i ^ (lane & 31))]; }
      unsigned S[2] = {tl[0], tl[1]};
#pragma unroll
      for (int o = 1; o < 64; o <<= 1) {
        const unsigned v0 = (unsigned)__builtin_amdgcn_ds_bpermute(((lane + o) & 63) << 2, (int)S[0]), v1 = (unsigned)__builtin_amdgcn_ds_bpermute(((lane + o) & 63) << 2, (int)S[1]);
        if (lane + o < 64) { S[0] += v0; S[1] += v1; } }
      int Ls[2], rls[2];
#pragma unroll
      for (int q = 0; q < 2; ++q) { const u64 mk = __ballot((int)S[q] >= rneed[q]); Ls[q] = __builtin_amdgcn_readfirstlane(63 - __clzll(mk));
        rls[q] = __builtin_amdgcn_readlane(rneed[q] - (int)(S[q] - tl[q]), Ls[q]); }
      const int li = lane & 31;
      unsigned hbv[2] = {h0p[32 * Ls[0] + (li ^ (Ls[0] & 31))], h1p[32 * Ls[1] + (li ^ (Ls[1] & 31))]};
      unsigned P[2] = {hbv[0], hbv[1]};
#pragma unroll
      for (int o = 1; o < 32; o <<= 1) {
        const unsigned v0 = (unsigned)__builtin_amdgcn_ds_bpermute(((lane + o) & 63) << 2, (int)P[0]), v1 = (unsigned)__builtin_amdgcn_ds_bpermute(((lane + o) & 63) << 2, (int)P[1]);
        if (li + o < 32) { P[0] += v0; P[1] += v1; } }
#pragma unroll
      for (int q = 0; q < 2; ++q) {
        const unsigned mk2 = (unsigned)__ballot((int)P[q] >= rls[q]);
        const int bi = __builtin_amdgcn_readfirstlane(31 - __clz(mk2));
        const int hbs = __builtin_amdgcn_readlane((int)hbv[q], bi), Pbi = __builtin_amdgcn_readlane((int)P[q], bi);
        const int rn = rls[q] - (Pbi - hbs);
        if (!done[q]) { rneed[q] = rn; prefix[q] = (prefix[q] << bits) | (unsigned)(32 * Ls[q] + bi); thr[q] = prefix[q] << sh;
          if (hbs == rn) { done[q] = true; allsel[q] = true; } }
      }
    }
  }
}
__device__ __forceinline__ u64 mask_words(const unsigned (&key)[32], const unsigned thr, const bool allsel, const int lane) {
  u64 myword = 0ull;
  if (allsel) {
#pragma unroll
    for (int i = 0; i < 32; ++i) { const u64 word = __ballot(key[i] >= thr); if (lane == i) myword = word; }
  } else {
    int cgt = 0;
#pragma unroll
    for (int i = 0; i < 32; ++i) cgt += __popcll(__ballot(key[i] > thr));
    const int need = 256 - cgt; int taken = 0;
#pragma unroll
    for (int i = 0; i < 32; ++i) {
      const bool gt = key[i] > thr, eq = key[i] == thr; const u64 em = __ballot(eq);
      const int before = taken + (int)__builtin_amdgcn_mbcnt_hi((unsigned)(em >> 32), __builtin_amdgcn_mbcnt_lo((unsigned)em, 0u));
      const u64 word = __ballot(gt || (eq && before < need)); taken += __popcll(em);
      if (lane == i) myword = word;
    }
  }
  return myword;
}
__device__ __forceinline__ void indexer_unit(unsigned char* ws, const int tid, char* lds, const int b, const int c, const int half) {
  const int wid = __builtin_amdgcn_readfirstlane(tid >> 6), lane = tid & 63, l15 = lane & 15, G = lane >> 4;
  const size_t tb = (size_t)b * SEQ;
  const int nk = (c + 1) * 64, nw = c + 1, nt16 = nk / 16;
  u64* mrow = (u64*)(ws + OFF_MASK) + (tb + (size_t)c * 64 + half * 32) * 32;
  if (c < 4) {
    for (int i = tid; i < 32 * 32; i += 512) mrow[i] = (i & 31) <= c ? ~0ull : 0ull;
    return;
  }
  float* sc = reinterpret_cast<float*>(lds);
  const bf16_t* aiq = (const bf16_t*)(ws + OFF_AIQ); const bf16_t* aik = (const bf16_t*)(ws + OFF_AIK) + tb * 64; const bf16_t* aiwb = (const bf16_t*)(ws + OFF_AIWB);
  for (int r = 0; r < 2; ++r) {
    for (int hh = 0; hh < 2; ++hh) {
      const int qbase = c * 64 + half * 32 + r * 16 + hh * 8;
      bf16x8 a[2][2][2]; f32x4 w[2][2];
#pragma unroll
      for (int p = 0; p < 2; ++p) { const size_t tq = tb + qbase + 4 * p + (l15 >> 2); const int h = l15 & 3;
#pragma unroll
        for (int hg = 0; hg < 2; ++hg)
#pragma unroll
          for (int ks = 0; ks < 2; ++ks) a[p][hg][ks] = *reinterpret_cast<const bf16x8*>(aiq + tq * 512 + (h + 4 * hg) * 64 + 8 * G + 32 * ks);
        { const uint4 wq = *reinterpret_cast<const uint4*>(aiwb + (tb + qbase + 4 * p + G) * 256);
          w[p][0] = (f32x4){__uint_as_float(wq.x << 16), __uint_as_float(wq.x & 0xffff0000u), __uint_as_float(wq.y << 16), __uint_as_float(wq.y & 0xffff0000u)};
          w[p][1] = (f32x4){__uint_as_float(wq.z << 16), __uint_as_float(wq.z & 0xffff0000u), __uint_as_float(wq.w << 16), __uint_as_float(wq.w & 0xffff0000u)}; } }
      bf16x8 cb[4][2], nb[4][2];
#define IDX_LOADB(dst, t0) do { _Pragma("unroll") for (int k_ = 0; k_ < 4; ++k_) { int tk_ = (t0) + 8 * k_; tk_ = tk_ < nt16 ? tk_ : nt16 - 1; \
        const bf16_t* kp_ = aik + (size_t)(tk_ * 16 + l15) * 64 + 8 * G; dst[k_][0] = *reinterpret_cast<const bf16x8*>(kp_); dst[k_][1] = *reinterpret_cast<const bf16x8*>(kp_ + 32); } } while (0)
      IDX_LOADB(cb, wid);
      for (int t0 = wid; t0 < nt16; t0 += 32) {
        IDX_LOADB(nb, t0 + 32);
#pragma unroll
        for (int k = 0; k < 4; ++k) { const int tk = t0 + 8 * k;
          if (tk < nt16) {
#pragma unroll
            for (int p = 0; p < 2; ++p) {
              f32x4 c0 = {0.f, 0.f, 0.f, 0.f}, c1 = {0.f, 0.f, 0.f, 0.f};
              c0 = __builtin_amdgcn_mfma_f32_16x16x32_bf16(a[p][0][0], cb[k][0], c0, 0, 0, 0); c0 = __builtin_amdgcn_mfma_f32_16x16x32_bf16(a[p][0][1], cb[k][1], c0, 0, 0, 0);
              c1 = __builtin_amdgcn_mfma_f32_16x16x32_bf16(a[p][1][0], cb[k][0], c1, 0, 0, 0); c1 = __builtin_amdgcn_mfma_f32_16x16x32_bf16(a[p][1][1], cb[k][1], c1, 0, 0, 0);
              float sv = 0.f;
#pragma unroll
              for (int j = 0; j < 4; ++j) { const float r0 = __builtin_amdgcn_fmed3f(c0[j], 0.f, __builtin_inff()), r1 = __builtin_amdgcn_fmed3f(c1[j], 0.f, __builtin_inff());
                sv = __builtin_fmaf(r0, w[p][0][j], sv); sv = __builtin_fmaf(r1, w[p][1][j], sv); }
              sc[(8 * hh + 4 * p + G) * 2048 + tk * 16 + l15] = sv; } } }
#pragma unroll
        for (int k = 0; k < 4; ++k) { cb[k][0] = nb[k][0]; cb[k][1] = nb[k][1]; }
      }
#undef IDX_LOADB
    }
    __syncthreads();
    unsigned key[2][32];
#pragma unroll
    for (int i = 0; i < 32; ++i) { const unsigned k0 = ordkey(sc[wid * 2048 + i * 64 + lane]), k1 = ordkey(sc[(wid + 8) * 2048 + i * 64 + lane]);
      key[0][i] = i < nw ? k0 : 0u; key[1][i] = i < nw ? k1 : 0u; }
    asm volatile("s_waitcnt lgkmcnt(0)" ::: "memory");
    unsigned thr[2]; bool allsel[2];
    select2(key, nw, reinterpret_cast<unsigned*>(sc + wid * 2048), reinterpret_cast<unsigned*>(sc + (wid + 8) * 2048), lane, thr, allsel);
    const u64 w0 = mask_words(key[0], thr[0], allsel[0], lane), w1 = mask_words(key[1], thr[1], allsel[1], lane);
    if (lane < 32) { mrow[(size_t)(r * 16 + wid) * 32 + lane] = w0; mrow[(size_t)(r * 16 + wid + 8) * 32 + lane] = w1; }
    __syncthreads();
  }
}
}

#define XB_TMO      128
#define XB_XCNT(j)  (256  + 64 * (j))
#define XB_XSUB(j)  (1280 + 64 * (j))
#define XB_XGEN(j)  (2304 + 64 * (j))
#define XB_TOP      3328
#define XB_TOPGEN   3392
#define XCD_BAR_WORDS 3456
#define XB_SPIN_CAP (1u << 18)
#define LAS __attribute__((address_space(3)))

__device__ __forceinline__ unsigned xb_ld(unsigned* p)              { return __hip_atomic_load(p, __ATOMIC_RELAXED, __HIP_MEMORY_SCOPE_AGENT); }
__device__ __forceinline__ unsigned xb_add(unsigned* p, unsigned v) { return __hip_atomic_fetch_add(p, v, __ATOMIC_RELAXED, __HIP_MEMORY_SCOPE_AGENT); }
__device__ __forceinline__ unsigned xb_xcc_id() { return (unsigned)__builtin_amdgcn_s_getreg((3 << 11) | 20) & 0xFu; }
#define XB_SPIN(cond, bar) do { unsigned _sp = 0; while (cond) { __builtin_amdgcn_s_sleep(1); \
    if ((++_sp & 255u) == 0u) { if (xb_ld(&(bar)[XB_TMO])) break; if (_sp > XB_SPIN_CAP) { atomicAdd(&(bar)[XB_TMO], 1u); break; } } } } while (0)

struct XcdBarrier { unsigned* bar; unsigned x; volatile LAS unsigned* st; };

__device__ __forceinline__ XcdBarrier xcd_barrier_post(unsigned* bar, volatile LAS unsigned* st, int tid) {
    XcdBarrier b; b.bar = bar; b.x = xb_xcc_id(); b.st = st;
    if (tid == 0) (void)xb_add(&bar[XB_XCNT(b.x)], 1u);
    return b;
}
__device__ __forceinline__ void xcd_barrier_complete(unsigned* bar, unsigned x, unsigned& nloc, unsigned& nx) {
    const unsigned G = gridDim.x * gridDim.y * gridDim.z;
    unsigned sum, cnt, mine, sp = 0u;
    for (;;) {
        sum = 0u; cnt = 0u; mine = 0u;
#pragma unroll
        for (unsigned j = 0; j < 16; ++j) { const unsigned c = xb_ld(&bar[XB_XCNT(j)]); sum += c; cnt += (c > 0u) ? 1u : 0u; mine = (j == x) ? c : mine; }
        if (sum == G) break;
        __builtin_amdgcn_s_sleep(1);
        if ((++sp & 255u) == 0u) { if (xb_ld(&bar[XB_TMO])) break; if (sp > XB_SPIN_CAP) { atomicAdd(&bar[XB_TMO], 1u); break; } }
    }
    nloc = mine > 0u ? mine : 1u; nx = cnt > 0u ? cnt : 1u;
}
__device__ __forceinline__ void xcd_barrier(const XcdBarrier& b, int tid) {
    asm volatile("s_waitcnt vmcnt(0)" ::: "memory");
    __syncthreads();
    if (tid == 0) {
        unsigned* bar = b.bar;
        __builtin_amdgcn_s_waitcnt(0);
        unsigned nloc = b.st[0], nx = b.st[1];
        if (nloc == 0u) { xcd_barrier_complete(bar, b.x, nloc, nx); b.st[0] = nloc; b.st[1] = nx; }
        const unsigned old = xb_add(&bar[XB_XSUB(b.x)], 1u);
        const unsigned gen = old / nloc;
        if (old + 1u == (gen + 1u) * nloc) {
            __builtin_amdgcn_fence(__ATOMIC_RELEASE, "agent");
            asm volatile("s_waitcnt vmcnt(0)" ::: "memory");
            const unsigned og = xb_add(&bar[XB_TOP], 1u);
            const unsigned tg = og / nx;
            if (og + 1u == (tg + 1u) * nx) xb_add(&bar[XB_TOPGEN], 1u);
            else XB_SPIN(xb_ld(&bar[XB_TOPGEN]) == tg, bar);
            __builtin_amdgcn_fence(__ATOMIC_ACQUIRE, "agent");
            xb_add(&bar[XB_XGEN(b.x)], 1u);
            asm volatile("s_waitcnt vmcnt(0)" ::: "memory");
        } else {
            XB_SPIN(xb_ld(&bar[XB_XGEN(b.x)]) == gen, bar);
            __builtin_amdgcn_fence(__ATOMIC_ACQUIRE, "agent");
            asm volatile("s_waitcnt vmcnt(0)" ::: "memory");
        }
    }
    __syncthreads();
}

#ifndef RP_PREP
#define RP_PREP 1
#endif
#ifndef RP_P1
#define RP_P1 1
#endif
#ifndef RP_ATT
#define RP_ATT 1
#endif
#ifndef RP_MOE
#define RP_MOE 1
#endif
#ifndef RP_IDX
#define RP_IDX 1
#endif
#ifndef RP_RT
#define RP_RT 1
#endif
#ifndef RP_P4
#define RP_P4 1
#endif
#ifndef RP_UP
#define RP_UP 1
#endif
#ifndef RP_AIW
#define RP_AIW 1
#endif
#ifndef RP_BAR
#define RP_BAR 1
#endif
constexpr int NTHR = 512;
constexpr int LDS_BYTES = 163840;
constexpr int GEMM_LDS_OFF = 1024;
constexpr int XLDS_OFF = 1024 + 131072;
struct Args { const float* in[21]; float* x; unsigned char* ws; };

#define VB_LOOP2(NVB, BODY) do { for (int _i = blockIdx.x; _i < (NVB) / 4; _i += gridDim.x) { const int vb = 4 * _i + 2 * half; BODY; } } while (0)
#define VB_LOOP(NVB, BODY) do { for (int _i = blockIdx.x; _i < (NVB) / 2; _i += gridDim.x) { const int vb = 2 * _i + half; BODY; } } while (0)
#define ROW_LOOP(NROW, BODY) do { for (int row = blockIdx.x * 8 + wave; row < (NROW); row += gridDim.x * 8) { BODY; } } while (0)
#define ELEM_LOOP(N, BODY) do { for (int idx = blockIdx.x * NTHR + tid512; idx < (N); idx += gridDim.x * NTHR) { BODY; } } while (0)

#define AIN(k) as_global(a.in[k])
typedef const __attribute__((address_space(4))) Args* KArgs;
#define PH_BEGIN() KArgs ap_ = (KArgs)__builtin_amdgcn_kernarg_segment_ptr(); asm volatile("" : "+s"(ap_)); const __attribute__((address_space(4))) Args& a = *ap_; \
  int wv_ = wave_u; asm volatile("" : "+s"(wv_)); unsigned z_ = 0u; asm volatile("" : "+v"(z_)); int tid512 = wv_ * 64 + (int)__builtin_amdgcn_mbcnt_hi(~0u, __builtin_amdgcn_mbcnt_lo(~0u, z_)); asm volatile("" : "+v"(tid512)); \
  const int half = tid512 >> 8, tid = tid512 & 255, wave = tid512 >> 6, lane = tid512 & 63; (void)half; (void)tid; (void)wave; (void)lane; \
  size_t zo_ = 0; asm volatile("" : "+s"(zo_)); unsigned char* ws = as_global(a.ws) + zo_; float* x = as_global(a.x) + zo_; \
  char* sm = lds + 1024 + half * 36864; (void)sm; float* rstd = (float*)(ws + OFF_CTL + CTL_RSTD); (void)rstd;

__device__ __forceinline__ void prep_attn_weights(const __attribute__((address_space(4))) Args& a, unsigned char* ws, int l, int half, int tid, char* sm) {
  const float* g_attn = AIN(1) + l * 1024; const float* w_in = AIN(2) + (size_t)l * 1024 * NIN;
  { TrDesc d{w_in, nullptr, g_attn, (bf16_t*)(ws + OFF_WATT + WA_IN), NIN, 1024, NZP, 1}; VB_LOOP2(1664, b_transpose2(d, 0, 0, vb, tid, sm)); }
  { TrDesc d{AIN(4) + (size_t)l * 256 * 768, nullptr, AIN(3) + l * 256, (bf16_t*)(ws + OFF_WATT + WA_UQ), 768, 256, 768, 2}; VB_LOOP2(48, b_transpose2(d, 0, 0, vb, tid, sm)); }
  { TrDesc d{AIN(6) + (size_t)l * 128 * 1024, nullptr, AIN(5) + l * 128, (bf16_t*)(ws + OFF_WATT + WA_UKV), 1024, 128, 1024, 0, 256}; VB_LOOP2(32, b_transpose2(d, 0, 0, vb, tid, sm)); }
  { TrDesc d{AIN(8) + (size_t)l * 512 * 1024, nullptr, nullptr, (bf16_t*)(ws + OFF_WATT + WA_P), 1024, 512, 1024, 0}; VB_LOOP2(128, b_transpose2(d, 0, 0, vb, tid, sm)); }
  { TrDesc d{AIN(9) + (size_t)l * 512 * 1024, nullptr, nullptr, (bf16_t*)(ws + OFF_WATT + WA_P) + (size_t)1024 * 512, 1024, 512, 1024, 0}; VB_LOOP2(128, b_transpose2(d, 0, 0, vb, tid, sm)); }
  { TrDesc d{AIN(10) + (size_t)l * 512 * 1024, nullptr, nullptr, (bf16_t*)(ws + OFF_WATT + WA_P) + (size_t)2 * 1024 * 512, 1024, 512, 1024, 0}; VB_LOOP2(128, b_transpose2(d, 0, 0, vb, tid, sm)); }
  { TrDesc d{AIN(11) + (size_t)l * 1024 * 1024, nullptr, nullptr, (bf16_t*)(ws + OFF_WATT + WA_O), 1024, 1024, 1024, 0}; VB_LOOP2(256, b_transpose2(d, 0, 0, vb, tid, sm)); }
}

#define GRID_BAR() do { PH_BEGIN(); XcdBarrier bar_; bar_.bar = (unsigned*)(ws + OFF_CTL + CTL_BAR); bar_.x = xb_xcc_id(); bar_.st = (volatile LAS unsigned*)lds; xcd_barrier(bar_, tid512); } while (0)
template <int l>
__device__ __forceinline__ void layer_phases(const int wave_u, char* lds) {
#define PH_P1() { PH_BEGIN(); __syncthreads(); \
      { pg8::InOrder S{(const char*)(ws + OFF_XB), (const char*)(ws + OFF_WATT + WA_IN), (int)gridDim.x, (int)blockIdx.x}; pg8::EpiIn E{ws}; \
        pg8::gemm_phase<pg8::EpiIn, pg8::InOrder, true, false, 1024, 1024, 1024>(tid512, (PG8_LAS unsigned char*)lds + GEMM_LDS_OFF, S, E); } }
    PH_P1();
#if RP_P1 > 1
    PH_P1();
#endif
#if RP_BAR > 1
    GRID_BAR(); GRID_BAR(); GRID_BAR(); GRID_BAR(); GRID_BAR(); GRID_BAR(); GRID_BAR(); GRID_BAR(); GRID_BAR(); GRID_BAR();
#endif
    GRID_BAR();
#define PH_UP() { PH_BEGIN(); __syncthreads(); pg8::UpOrder S{ws, (int)gridDim.x, (int)blockIdx.x}; pg8::EpiUpBoth E{ws}; \
      pg8::gemm_phase<pg8::EpiUpBoth, pg8::UpOrder, true, false, 384, 256, 256>(tid512, (PG8_LAS unsigned char*)lds + GEMM_LDS_OFF, S, E); }
    PH_UP();
#if RP_UP > 1
    PH_UP();
#endif
#define PH_IDX() { PH_BEGIN(); __syncthreads(); const int w = blockIdx.x, bb = w >> 5, i = w & 31;        \
      idx::indexer_unit(ws, tid512, lds + GEMM_LDS_OFF, bb, i, 0); idx::indexer_unit(ws, tid512, lds + GEMM_LDS_OFF, bb, 31 - i, 1); }
    PH_IDX();
#if RP_IDX > 1
    PH_IDX();
#endif
    GRID_BAR();
#define PH_ATT(dry) \
    { PH_BEGIN(); const int w = blockIdx.x, bb = w >> 5, i = w & 31; att::attn_unit<0>(ws, nullptr, tid512, lds + GEMM_LDS_OFF, bb, 0, i, dry); } \
    { PH_BEGIN(); const int w = blockIdx.x, bb = w >> 5, i = w & 31; att::attn_unit<1>(ws, nullptr, tid512, lds + GEMM_LDS_OFF, bb, i & 3, 7 - (i >> 2), dry); } \
    { PH_BEGIN(); const float* relb_ = AIN(7) + l * 4 * 257; const int w = blockIdx.x, bb = w >> 5, i = w & 31; att::attn_unit<2>(ws, relb_, tid512, lds + GEMM_LDS_OFF, bb, i & 3, i >> 2, dry); }
#if RP_ATT > 1
    PH_ATT(true);
#endif
    PH_ATT(false);
    GRID_BAR();
    { PH_BEGIN(); if (blockIdx.x == 0 && tid512 < 128) ((unsigned*)(ws + OFF_CTL + CTL_CNT))[tid512] = 0u; }
#define PH_P4()     { PH_BEGIN(); __syncthreads(); \
      pg8::ProjOrder S{ws, (int)gridDim.x, (int)blockIdx.x}; pg8::EpiProj E{ws}; \
      pg8::gemm_phase<pg8::EpiProj, pg8::ProjOrder, false, false, 512, 512, 512>(tid512, (PG8_LAS unsigned char*)lds + GEMM_LDS_OFF, S, E); }
    PH_P4();
#if RP_P4 > 1
    PH_P4();
#endif
    GRID_BAR();
    { PH_BEGIN(); __syncthreads();
      pg8::PlainOrder S{(const char*)(ws + OFF_MIX), (const char*)(ws + OFF_WATT + WA_O), 1024, 1024, T / 256, 4, (int)gridDim.x, (int)blockIdx.x, 16}; pg8::EpiOut E{x, (bf16_t*)(ws + OFF_XB)};
      pg8::gemm_phase<pg8::EpiOut, pg8::PlainOrder, false, false, 1024, 1024, 1024>(tid512, (PG8_LAS unsigned char*)lds + GEMM_LDS_OFF, S, E); }
    GRID_BAR();
#define PH_RT(DRY)     { PH_BEGIN(); const float* g_ = AIN(12) + l * 1024; const float* wg_ = AIN(13) + (size_t)l * 1024 * 4; const float* bg_ = AIN(14) + l * 4; const float* wr_ = AIN(15) + (size_t)l * 1024 * 32; const float* br_ = AIN(16) + l * 32; \
      __syncthreads(); float* wt_ = (float*)(lds + GEMM_LDS_OFF); router_stage(g_, wg_, wr_, wt_, tid512); __syncthreads(); \
      for (int t0 = blockIdx.x * 64; t0 < T; t0 += gridDim.x * 64) \
        router_mfma((const float*)x, wt_, lds + GEMM_LDS_OFF + ROUTER_LDS, bg_, br_, (int*)(ws + OFF_CTL + CTL_TOKE), (float*)(ws + OFF_CTL + CTL_TOKW), rstd, (unsigned*)(ws + OFF_CTL + CTL_CNT), (int*)(ws + OFF_LIST), t0 + (wave & 3) * 16, wave, lane, DRY); \
      __syncthreads(); }
#if RP_RT > 1
    PH_RT(true);
#endif
    PH_RT(false);
#if RP_PREP > 1
    { PH_BEGIN();
      { TrDesc d{AIN(17) + (size_t)l * 32 * 1024 * 256, AIN(18) + (size_t)l * 32 * 1024 * 256, AIN(12) + l * 1024, (bf16_t*)(ws + OFF_WGU), 256, 1024, 512, 3};
        VB_LOOP2(128 * 32, b_transpose2(d, (size_t)1024 * 256, (size_t)512 * 1024, vb, tid, sm)); }
      { TrDesc d{AIN(19) + (size_t)l * 32 * 256 * 1024, nullptr, nullptr, (bf16_t*)(ws + OFF_WD), 1024, 256, 1024, 0};
        VB_LOOP2(64 * 32, b_transpose2(d, (size_t)256 * 1024, (size_t)1024 * 256, vb, tid, sm)); } }
#endif
    { PH_BEGIN();
      { TrDesc d{AIN(17) + (size_t)l * 32 * 1024 * 256, AIN(18) + (size_t)l * 32 * 1024 * 256, AIN(12) + l * 1024, (bf16_t*)(ws + OFF_WGU), 256, 1024, 512, 3};
        VB_LOOP2(128 * 32, b_transpose2(d, (size_t)1024 * 256, (size_t)512 * 1024, vb, tid, sm)); }
      { TrDesc d{AIN(19) + (size_t)l * 32 * 256 * 1024, nullptr, nullptr, (bf16_t*)(ws + OFF_WD), 1024, 256, 1024, 0};
        VB_LOOP2(64 * 32, b_transpose2(d, (size_t)256 * 1024, (size_t)1024 * 256, vb, tid, sm)); } }
    GRID_BAR();
#define MOE_TAB ((PG8_LAS unsigned*)((PG8_LAS unsigned char*)lds + XLDS_OFF))
#define PH_MOE_A() { PH_BEGIN(); __syncthreads(); pg8::moe_build_map((unsigned*)(ws + OFF_CTL + CTL_CNT), MOE_TAB, tid512); \
      pg8::MoeOrder<2, false> S{ws, (int)gridDim.x, (int)blockIdx.x, MOE_TAB, 0, 256}; pg8::EpiGU E{ws}; \
      pg8::gemm_phase<pg8::EpiGU, pg8::MoeOrder<2, false>, true, true, 1024, 1024, 1024>(tid512, (PG8_LAS unsigned char*)lds + GEMM_LDS_OFF, S, E, (PG8_LAS unsigned char*)lds + XLDS_OFF + 1024); }
#define PH_MOE_B() \
    { PH_BEGIN(); __syncthreads(); pg8::moe_build_map((unsigned*)(ws + OFF_CTL + CTL_CNT), MOE_TAB, tid512); \
      pg8::MoeOrder<2, false> S{ws, (int)gridDim.x, (int)blockIdx.x, MOE_TAB, 256, 1 << 30}; pg8::EpiGU E{ws}; \
      pg8::gemm_phase<pg8::EpiGU, pg8::MoeOrder<2, false>, true, true, 1024, 1024, 1024>(tid512, (PG8_LAS unsigned char*)lds + GEMM_LDS_OFF, S, E, (PG8_LAS unsigned char*)lds + XLDS_OFF + 1024); \
      const int nt_ = __builtin_amdgcn_readfirstlane((int)MOE_TAB[255]); const int L_ = 256 + (int)blockIdx.x;       \
      asm volatile("s_waitcnt vmcnt(0)" ::: "memory"); __syncthreads(); \
      if (L_ < 2 * nt_ && tid512 == 0) { __builtin_amdgcn_fence(__ATOMIC_RELEASE, "agent"); asm volatile("s_waitcnt vmcnt(0)" ::: "memory"); \
        __hip_atomic_fetch_add((unsigned*)(ws + OFF_CTL + CTL_CNT) + 64 + (L_ / 2 - 128), 1u, __ATOMIC_RELAXED, __HIP_MEMORY_SCOPE_AGENT); } } \
    { PH_BEGIN(); __syncthreads(); const int nt_ = __builtin_amdgcn_readfirstlane((int)MOE_TAB[255]); const int nx_ = 2 * nt_ > 256 ? 2 * nt_ - 256 : 0; \
      pg8::MoeOrder<4, true> S{ws, (int)gridDim.x - nx_, (int)blockIdx.x - nx_, MOE_TAB, 0, 512}; pg8::EpiDown E{ws}; \
      pg8::gemm_phase<pg8::EpiDown, pg8::MoeOrder<4, true>, true, false, 256, 256, 256>(tid512, (PG8_LAS unsigned char*)lds + GEMM_LDS_OFF, S, E); } \
    { PH_BEGIN(); __syncthreads(); const int nt_ = __builtin_amdgcn_readfirstlane((int)MOE_TAB[255]); const int L_ = 512 + (int)blockIdx.x; \
      if (L_ < 4 * nt_) { if (tid512 == 0) { unsigned* fl_ = (unsigned*)(ws + OFF_CTL + CTL_CNT) + 64 + (L_ / 4 - 128); unsigned sp_ = 0; \
          while (__hip_atomic_load(fl_, __ATOMIC_RELAXED, __HIP_MEMORY_SCOPE_AGENT) < 2u && ++sp_ < (1u << 22)) __builtin_amdgcn_s_sleep(1); \
          __builtin_amdgcn_fence(__ATOMIC_ACQUIRE, "agent"); asm volatile("s_waitcnt vmcnt(0)" ::: "memory"); } } \
      __syncthreads(); \
      pg8::MoeOrder<4, true> S{ws, (int)gridDim.x, (int)blockIdx.x, MOE_TAB, 512, 1 << 30}; pg8::EpiDown E{ws}; \
      pg8::gemm_phase<pg8::EpiDown, pg8::MoeOrder<4, true>, true, false, 256, 256, 256>(tid512, (PG8_LAS unsigned char*)lds + GEMM_LDS_OFF, S, E); }
#if RP_MOE > 1
    PH_MOE_A(); GRID_BAR();
#endif
    PH_MOE_A();
    GRID_BAR();
    PH_MOE_B();
    GRID_BAR();
    if (l == 0) { { PH_BEGIN(); ROW_LOOP(T, b_finalize<false>(x, ws, nullptr, row, lane)); } { PH_BEGIN(); prep_attn_weights(a, ws, 1, half, tid, sm); } if (RP_PREP > 1) { PH_BEGIN(); prep_attn_weights(a, ws, 1, half, tid, sm); } GRID_BAR(); }
    else { PH_BEGIN(); const float* gf_ = AIN(20); ROW_LOOP(T, b_finalize<true>(x, ws, gf_, row, lane)); }
}

__global__ void __launch_bounds__(NTHR, 2) mk_fwd(Args a_in) {
  extern __shared__ __attribute__((aligned(16))) char lds[];
  const int wave_u = __builtin_amdgcn_readfirstlane((int)threadIdx.x >> 6);
  { PH_BEGIN();
    if (tid512 == 0) { ((volatile LAS unsigned*)lds)[0] = 0u; ((volatile LAS unsigned*)lds)[1] = 0u; ((volatile LAS unsigned*)lds)[2] = 0u; ((volatile LAS unsigned*)lds)[3] = 0u; }
    __syncthreads();
    (void)xcd_barrier_post((unsigned*)(ws + OFF_CTL + CTL_BAR), (volatile LAS unsigned*)lds, tid512); }
  { PH_BEGIN(); ELEM_LOOP(2048 * 56, b_rope_tables((float*)(ws + OFF_CTL + CTL_ROPE), idx)); }
  { PH_BEGIN(); const float* xin = AIN(0); ROW_LOOP(T, b_x_init(xin, x, (bf16_t*)(ws + OFF_XB), rstd, row, lane)); }
  { PH_BEGIN(); prep_attn_weights(a, ws, 0, half, tid, sm); }
  if (RP_PREP > 1) { PH_BEGIN(); prep_attn_weights(a, ws, 0, half, tid, sm); }
  GRID_BAR();
  layer_phases<0>(wave_u, lds);
  layer_phases<1>(wave_u, lds);
}

extern "C" void kernel_launch(void* const* d_in, const int* in_sizes, int n_in, void* d_out, int out_size, void* d_ws, size_t ws_size, hipStream_t stream) {
  if (ws_size < WS_END) { fprintf(stderr, "kernel_launch: workspace too small: %zu < %zu\n", ws_size, WS_END); return; }
  static int grid = 0;
  if (!grid) {
    int dev = 0, cus = 0, per_cu = 0;
    hipGetDevice(&dev);
    hipDeviceGetAttribute(&cus, hipDeviceAttributeMultiprocessorCount, dev);
    hipFuncSetAttribute((const void*)mk_fwd, hipFuncAttributeMaxDynamicSharedMemorySize, LDS_BYTES);
    hipOccupancyMaxActiveBlocksPerMultiprocessor(&per_cu, (const void*)mk_fwd, NTHR, LDS_BYTES);
    if (per_cu < 1) { fprintf(stderr, "kernel_launch: occupancy query says %d blocks per CU\n", per_cu); return; }
    if (cus < 256) { fprintf(stderr, "kernel_launch: this kernel is laid out for 256 workgroups, one per CU; the device reports %d CUs\n", cus); return; }
    grid = 256;
  }
  Args a{};
  for (int i = 0; i < 21; ++i) a.in[i] = (const float*)d_in[i];
  a.x = (float*)d_out; a.ws = (unsigned char*)d_ws;
  hipMemsetAsync((unsigned char*)d_ws + OFF_CTL + CTL_BAR, 0, XCD_BAR_WORDS * sizeof(unsigned), stream);
  hipLaunchKernelGGL(mk_fwd, dim3(grid), dim3(NTHR), LDS_BYTES, stream, a);
}
```

```cpp
#include <hip/hip_runtime.h>
#include <hip/hip_bf16.h>
#include <cstdint>
#include <cstdio>

typedef unsigned short bf16_t;
typedef unsigned long long u64;

constexpr int T = 16384, DM = 1024, SEQ = 2048, NB = 8;
constexpr int NIN = 6408, NZ = 6400, NZP = 6656;
constexpr float EPS = 1e-6f;

constexpr size_t MiB = (size_t)1 << 20;
constexpr size_t OFF_CTL = 0;
constexpr size_t OFF_WATT = 4 * MiB;
constexpr size_t OFF_XB = 23 * MiB;
constexpr size_t OFF_AQ = 55 * MiB;
constexpr size_t OFF_CQ = 71 * MiB;
constexpr size_t OFF_QB = 87 * MiB;
constexpr size_t OFF_ZA = 111 * MiB;
constexpr size_t OFF_AK = OFF_ZA;
constexpr size_t OFF_AV = OFF_AK + 4 * MiB;
constexpr size_t OFF_AIQ = OFF_AV + 4 * MiB;
constexpr size_t OFF_AIK = OFF_AIQ + 16 * MiB;
constexpr size_t OFF_BKR = OFF_AIK + 2 * MiB;
constexpr size_t OFF_BCKV = OFF_BKR + 2 * MiB;
constexpr size_t OFF_BCQ = OFF_BCKV + 4 * MiB;
constexpr size_t OFF_BC = OFF_BCKV;
constexpr size_t OFF_CK = OFF_BCQ + 8 * MiB;
constexpr size_t OFF_CV = OFF_CK + 16 * MiB;
constexpr size_t OFF_KVB = 183 * MiB;
constexpr size_t OFF_MASK = 215 * MiB;
constexpr size_t OFF_G = 219 * MiB;
constexpr size_t OFF_AIWB = 315 * MiB;
constexpr size_t WS_END = 323 * MiB;
constexpr size_t OFF_MIX = OFF_KVB;
constexpr size_t OFF_WMOE = OFF_ZA;
constexpr size_t OFF_WGU = OFF_WMOE;
constexpr size_t OFF_WD = OFF_WMOE + 32 * MiB;
constexpr size_t OFF_Y = OFF_G;
constexpr size_t OFF_LIST = OFF_MASK;
constexpr size_t OFF_H = OFF_AQ;
constexpr size_t CTL_BAR = 0;
constexpr size_t CTL_CNT = 16 * 1024;
constexpr size_t CTL_ROPE = 64 * 1024;
constexpr size_t CTL_RSTD = 1 * MiB;
constexpr size_t CTL_RSTDQ = CTL_RSTD + 64 * 1024;
constexpr size_t CTL_RSTDKV = CTL_RSTDQ + 64 * 1024;
constexpr size_t CTL_AIW = CTL_RSTDKV + 64 * 1024;
constexpr size_t CTL_SSQ = 2 * MiB;
constexpr size_t CTL_SSQQ = CTL_SSQ;
constexpr size_t CTL_SSQKV = CTL_SSQ + 512 * 1024;
constexpr size_t CTL_TOKE = 3 * MiB;
constexpr size_t CTL_TOKW = CTL_TOKE + 128 * 1024;
constexpr size_t CTL_WIW = 3 * MiB + 512 * 1024;
constexpr size_t WA_IN = 0;
constexpr size_t WA_UQ = 13 * MiB;
constexpr size_t WA_UKV = WA_UQ + 512 * 1024;
constexpr size_t WA_P = 14 * MiB;
constexpr size_t WA_O = 17 * MiB;
constexpr int RT_COSA = 0, RT_SINA = 2048 * 16, RT_COSI = 2048 * 32, RT_SINI = 2048 * 40, RT_COSB = 2048 * 48, RT_SINB = 2048 * 80;

template <class Tp> __device__ __forceinline__ Tp* as_global(Tp* p) { return (Tp*)(__attribute__((address_space(1))) Tp*)p; }
__device__ __forceinline__ float bf2f(bf16_t v) { return __uint_as_float(((unsigned)v) << 16); }
__device__ __forceinline__ bf16_t f2bf(float f) { unsigned u = __float_as_uint(f); return (bf16_t)((u + 0x7fffu + ((u >> 16) & 1u)) >> 16); }
__device__ __forceinline__ float shx(float v, int m, int lane) { return __int_as_float(__builtin_amdgcn_ds_bpermute((lane ^ m) << 2, __float_as_int(v))); }
__device__ __forceinline__ float wave_sum(float v, int lane) {
  v += shx(v, 32, lane); v += shx(v, 16, lane); v += shx(v, 8, lane); v += shx(v, 4, lane); v += shx(v, 2, lane); v += shx(v, 1, lane); return v;
}
__host__ __device__ __forceinline__ int zmap(int c) {
  if (c < 1344) return c;
  if (c < 1408) { int n = c - 1344, g = n >> 5, r = n & 31; return 1736 + (r < 16 ? 16 * g + r : 32 + 16 * g + (r - 16)); }
  if (c < 1536) return 1608 + (c - 1408);
  if (c < 1792) return 1352 + (c - 1536);
  return c + 8;
}
__host__ __device__ __forceinline__ int uqmap(int c) {
  if (c < 512) { int h = c >> 7, d = c & 127; return h * 192 + d; }
  int n = c - 512, h = n >> 6, m = n & 63, g = m >> 5, r = m & 31;
  return h * 192 + 128 + (r < 16 ? 16 * g + r : 32 + 16 * g + (r - 16));
}
__host__ __device__ __forceinline__ int gumap(int n, int& isup) { int pn = n >> 8, j = n & 255; isup = j >= 128; return 128 * pn + (j & 127); }

struct TrDesc { const float* src; const float* src2; const float* scale; bf16_t* dst; int ld; int K; int N; int kind; int dp = 0; };
struct TrRegs { float4 v[4]; float sc[4]; };
__device__ __forceinline__ void tt_load(const TrDesc& d, int tn, int tk, int tid, TrRegs& R) {
  const int n0 = tn * 64, k0 = tk * 64;
  const int n4 = (tid & 15) * 4, kq = tid >> 4;
  const int n = n0 + n4;
  const float* s = d.src; int col; float cs = 1.f;
  if (d.kind == 0) col = n; else if (d.kind == 1) { if (n >= NZ) { col = n < NZ + 8 ? 1344 + (n - NZ) : 0; cs = n < NZ + 8 ? 0.35355339059327373f * 0.125f : 0.f; } else col = zmap(n); } else if (d.kind == 2) col = uqmap(n);
  else { int isup; col = gumap(n, isup); if (isup) s = d.src2; }
  const bool vec = ((((size_t)d.ld * 4) & 15) == 0) && ((col & 3) == 0);
#pragma unroll
  for (int i = 0; i < 4; ++i) { const int kk = kq + 16 * i; const float* p = s + (size_t)(k0 + kk) * d.ld + col;
    if (vec) R.v[i] = *(const float4*)p; else { R.v[i].x = p[0]; R.v[i].y = p[1]; R.v[i].z = p[2]; R.v[i].w = p[3]; }
    R.sc[i] = (d.scale ? d.scale[k0 + kk] : 1.f) * cs; }
}
__device__ __forceinline__ void tt_lds(const TrRegs& R, float (*tile)[65], int tid) {
  const int n4 = (tid & 15) * 4, kq = tid >> 4;
#pragma unroll
  for (int i = 0; i < 4; ++i) { const int kk = kq + 16 * i; const float sc = R.sc[i];
    tile[kk][n4] = R.v[i].x * sc; tile[kk][n4 + 1] = R.v[i].y * sc; tile[kk][n4 + 2] = R.v[i].z * sc; tile[kk][n4 + 3] = R.v[i].w * sc; }
}
__device__ __forceinline__ void tt_store(const TrDesc& d, int tn, int tk, float (*tile)[65], int tid) {
  const int n0 = tn * 64, k0 = tk * 64;
  const int dp = d.dp ? d.dp : d.K;
#pragma unroll
  for (int i = 0; i < 2; ++i) { const int e = tid + 256 * i, nn = e >> 3, k8 = (e & 7) * 8;
    uint4 w;
    w.x = (unsigned)f2bf(tile[k8 + 0][nn]) | ((unsigned)f2bf(tile[k8 + 1][nn]) << 16); w.y = (unsigned)f2bf(tile[k8 + 2][nn]) | ((unsigned)f2bf(tile[k8 + 3][nn]) << 16);
    w.z = (unsigned)f2bf(tile[k8 + 4][nn]) | ((unsigned)f2bf(tile[k8 + 5][nn]) << 16); w.w = (unsigned)f2bf(tile[k8 + 6][nn]) | ((unsigned)f2bf(tile[k8 + 7][nn]) << 16);
    *(uint4*)(d.dst + (size_t)(n0 + nn) * dp + k0 + k8) = w; }
}
__device__ __forceinline__ void b_transpose2(TrDesc d, size_t src_stride, size_t dst_stride, int vb, int tid, char* sm) {
  float (*tileA)[65] = (float (*)[65])sm; float (*tileB)[65] = (float (*)[65])(sm + 64 * 65 * 4);
  const int ntk = d.K / 64, per = (d.N / 64) * ntk;
  TrDesc da = d, db = d;
  { const int e = vb / per; da.src += (size_t)e * src_stride; if (da.src2) da.src2 += (size_t)e * src_stride; da.dst += (size_t)e * dst_stride; }
  { const int e = (vb + 1) / per; db.src += (size_t)e * src_stride; if (db.src2) db.src2 += (size_t)e * src_stride; db.dst += (size_t)e * dst_stride; }
  const int ta = vb % per, tb = (vb + 1) % per;
  TrRegs ra, rb; tt_load(da, ta / ntk, ta % ntk, tid, ra); tt_load(db, tb / ntk, tb % ntk, tid, rb);
  tt_lds(ra, tileA, tid); tt_lds(rb, tileB, tid);
  __syncthreads();
  tt_store(da, ta / ntk, ta % ntk, tileA, tid); tt_store(db, tb / ntk, tb % ntk, tileB, tid);
  __syncthreads();
}
__device__ __forceinline__ void b_rope_tables(float* rt, int i) {
  int pos = i / 56, j = i % 56; int rot, idx, oc, os;
  if (j < 16) { rot = 32; idx = j; oc = RT_COSA + pos * 16 + idx; os = RT_SINA + pos * 16 + idx; }
  else if (j < 24) { rot = 16; idx = j - 16; oc = RT_COSI + pos * 8 + idx; os = RT_SINI + pos * 8 + idx; }
  else { rot = 64; idx = j - 24; oc = RT_COSB + pos * 32 + idx; os = RT_SINB + pos * 32 + idx; }
  float inv = (float)pow(500000.0, -(double)(2 * idx) / (double)rot);
  float ang = (float)pos * inv;
  rt[oc] = (float)cos((double)ang); rt[os] = (float)sin((double)ang);
}
__device__ __forceinline__ void b_x_init(const float* xin, float* x, bf16_t* xb, float* rstd, int row, int lane) {
  const float4* s = (const float4*)(xin + (size_t)row * DM); float4* d = (float4*)(x + (size_t)row * DM);
  float ss = 0.f;
#pragma unroll
  for (int i = 0; i < 4; ++i) { float4 v = s[lane + 64 * i]; d[lane + 64 * i] = v; ss += v.x * v.x + v.y * v.y + v.z * v.z + v.w * v.w;
    bf16_t* o = xb + (size_t)row * DM + (lane + 64 * i) * 4; o[0] = f2bf(v.x); o[1] = f2bf(v.y); o[2] = f2bf(v.z); o[3] = f2bf(v.w); }
  ss = wave_sum(ss, lane);
  if (lane == 0) rstd[row] = rsqrtf(ss * (1.f / DM) + EPS);
}

constexpr int RT_P = 1028;
constexpr int ROUTER_LDS = 36 * RT_P * 4;
__device__ __forceinline__ void router_stage(const float* g, const float* wg, const float* wr, float* wt, int tid) {
  for (int i = tid; i < 1024 * 32; i += 512) { const int k = i >> 5, j = i & 31; wt[(4 + j) * RT_P + k] = g[k] * wr[i]; }
  for (int i = tid; i < 1024 * 4; i += 512) { const int k = i >> 2, j = i & 3; wt[j * RT_P + k] = g[k] * wg[i]; }
}
__device__ __forceinline__ void router_select(const float (&acc)[36], const float rs, const float* bg, const float* br, int t, int* toke, float* tokw, float* rstd_out, unsigned* cnt, int* list, bool dry) {
  float lg[4]; float mx = -INFINITY;
#pragma unroll
  for (int j = 0; j < 4; ++j) { lg[j] = acc[j] * rs + bg[j]; mx = fmaxf(mx, lg[j]); }
  float sm = 0.f, best = -1.f; int gs = 0;
#pragma unroll
  for (int j = 0; j < 4; ++j) { const float p = __expf(lg[j] - mx); sm += p; if (p > best) { best = p; gs = j; } }
  const float pg = best / sm;
  const float m0 = gs == 0 ? 1.f : 0.f, m1 = gs == 1 ? 1.f : 0.f, m2 = gs == 2 ? 1.f : 0.f, m3 = gs == 3 ? 1.f : 0.f;
  float e[8]; float emx = -INFINITY;
#pragma unroll
  for (int j = 0; j < 8; ++j) { e[j] = ((acc[4 + j] * m0 + acc[12 + j] * m1) + (acc[20 + j] * m2 + acc[28 + j] * m3)) * rs + br[gs * 8 + j]; emx = fmaxf(emx, e[j]); }
  float es = 0.f, b0 = -1.f, b1 = -1.f; int i0 = 0, i1 = 0;
#pragma unroll
  for (int j = 0; j < 8; ++j) { const float p = __expf(e[j] - emx); es += p;
    if (p > b0) { b1 = b0; i1 = i0; b0 = p; i0 = j; } else if (p > b1) { b1 = p; i1 = j; } }
  const float p0 = b0 / es, p1 = b1 / es, ps = p0 + p1;
  const int e0 = gs * 8 + i0, e1 = gs * 8 + i1;
  if (dry) { asm volatile("" :: "v"(p0 + ps), "v"(e0 + e1)); return; }
  rstd_out[t] = rs;
  toke[t * 2] = e0; toke[t * 2 + 1] = e1; tokw[t * 2] = pg * p0 / ps; tokw[t * 2 + 1] = pg * p1 / ps;
  const unsigned s0 = atomicAdd(cnt + e0, 1u), s1 = atomicAdd(cnt + e1, 1u);
  list[(size_t)e0 * T + s0] = t * 2; list[(size_t)e1 * T + s1] = t * 2 + 1;
}
__device__ __forceinline__ void router_mfma(const float* x, const float* wt, char* scr  , const float* bg, const float* br, int* toke, float* tokw, float* rstd_out,
                                            unsigned* cnt, int* list, const int t0  , const int wave, const int lane, const bool dry) {
  typedef float f4 __attribute__((ext_vector_type(4)));
  const int i = lane & 15, g = lane >> 4, wp = wave & 3, kh = wave >> 2;
  const float* xr = x + (size_t)(t0 + i) * DM + kh * 512 + 4 * g;
  const float* w0 = wt + (size_t)i * RT_P + kh * 512 + 4 * g; const float* w1 = w0 + 16 * RT_P; const float* w2 = wt + (size_t)(32 + (i < 4 ? i : 3)) * RT_P + kh * 512 + 4 * g;
  f4 c0 = {0.f, 0.f, 0.f, 0.f}, c1 = c0, c2 = c0; float ssl = 0.f;
#pragma unroll 4
  for (int s = 0; s < 32; ++s) {
    const f4 xa = *(const f4*)(xr + 16 * s), b0 = *(const f4*)(w0 + 16 * s), b1 = *(const f4*)(w1 + 16 * s), b2 = *(const f4*)(w2 + 16 * s);
    ssl += (xa[0] * xa[0] + xa[1] * xa[1]) + (xa[2] * xa[2] + xa[3] * xa[3]);
#pragma unroll
    for (int e = 0; e < 4; ++e) { c0 = __builtin_amdgcn_mfma_f32_16x16x4f32(xa[e], b0[e], c0, 0, 0, 0); c1 = __builtin_amdgcn_mfma_f32_16x16x4f32(xa[e], b1[e], c1, 0, 0, 0); c2 = __builtin_amdgcn_mfma_f32_16x16x4f32(xa[e], b2[e], c2, 0, 0, 0); }
  }
  float* part = (float*)scr + (size_t)(wp * 64 + lane) * 12; float* pss = (float*)(scr + 4 * 3072) + wp * 64 + lane;
  if (kh == 1) { *(f4*)part = c0; *(f4*)(part + 4) = c1; *(f4*)(part + 8) = c2; *pss = ssl; }
  __syncthreads();
  if (kh == 0) {
    c0 += *(const f4*)part; c1 += *(const f4*)(part + 4); c2 += *(const f4*)(part + 8); ssl += *pss;
    asm volatile("s_waitcnt lgkmcnt(0)" ::: "memory");
    ssl += shx(ssl, 16, lane); ssl += shx(ssl, 32, lane);
    float* lg = (float*)(scr + wp * 3072);
#pragma unroll
    for (int r = 0; r < 4; ++r) { lg[(4 * g + r) * 48 + i] = c0[r]; lg[(4 * g + r) * 48 + 16 + i] = c1[r]; lg[(4 * g + r) * 48 + 32 + i] = c2[r]; }
    asm volatile("s_waitcnt lgkmcnt(0)" ::: "memory");
    if (lane < 16) { float acc[36];
#pragma unroll
      for (int j = 0; j < 36; ++j) acc[j] = lg[lane * 48 + j];
      router_select(acc, rsqrtf(ssl * (1.f / DM) + EPS), bg, br, t0 + lane, toke, tokw, rstd_out, cnt, list, dry); }
  }
  __syncthreads();
}
template <bool LAST>
__device__ __forceinline__ void b_finalize(float* x, unsigned char* ws, const float* gf, int row, int lane) {
  float4* xr = (float4*)(x + (size_t)row * DM);
  const bf16_t* y0 = (const bf16_t*)(ws + OFF_Y) + (size_t)row * 2048; const bf16_t* y1 = y0 + 1024;
  float4 v[4]; float ss = 0.f;
#pragma unroll
  for (int i = 0; i < 4; ++i) { const int c4 = lane + 64 * i; float4 a = xr[c4];
    uint2 p0 = *(const uint2*)(y0 + c4 * 4), p1 = *(const uint2*)(y1 + c4 * 4);
    a.x += __uint_as_float(p0.x << 16) + __uint_as_float(p1.x << 16); a.y += __uint_as_float(p0.x & 0xffff0000u) + __uint_as_float(p1.x & 0xffff0000u);
    a.z += __uint_as_float(p0.y << 16) + __uint_as_float(p1.y << 16); a.w += __uint_as_float(p0.y & 0xffff0000u) + __uint_as_float(p1.y & 0xffff0000u);
    v[i] = a; ss += a.x * a.x + a.y * a.y + a.z * a.z + a.w * a.w; }
  ss = wave_sum(ss, lane);
  const float rs = rsqrtf(ss * (1.f / DM) + EPS);
#pragma unroll
  for (int i = 0; i < 4; ++i) { const int c4 = lane + 64 * i; float4 a = v[i];
    if (LAST) { float4 g = ((const float4*)gf)[c4]; a.x *= rs * g.x; a.y *= rs * g.y; a.z *= rs * g.z; a.w *= rs * g.w; xr[c4] = a; }
    else { xr[c4] = a; bf16_t* o = (bf16_t*)(ws + OFF_XB) + (size_t)row * DM + c4 * 4; o[0] = f2bf(a.x); o[1] = f2bf(a.y); o[2] = f2bf(a.z); o[3] = f2bf(a.w); } }
  if (!LAST && lane == 0) ((float*)(ws + OFF_CTL + CTL_RSTD))[row] = rs;
}


namespace pg8 {
#define PG8_LAS __attribute__((address_space(3)))
typedef short bf16x8 __attribute__((ext_vector_type(8)));
typedef float f32x4 __attribute__((ext_vector_type(4)));
typedef unsigned u32x4 __attribute__((ext_vector_type(4)));
constexpr int BM = 256, BK = 64, HALF = 128, HTB = HALF * BK * 2, STAGE_BYTES = 8 * HTB, NXCD = 8, WGM = 8;
__host__ __device__ __forceinline__ int lds_byte(int r, int c) { const int st = (r >> 4) * 2 + (c >> 5), rr = r & 15, cc = c & 31, ob = rr * 64 + cc * 2; return st * 1024 + (ob ^ (((ob >> 9) & 1) << 5)); }
__host__ __device__ __forceinline__ void stage_rc(int b, int& R, int& C) { const int st = b / 1024, sb = b % 1024, swz = sb ^ (((sb >> 9) & 1) << 5); R = (st >> 1) * 16 + swz / 64; C = (st & 1) * 32 + (swz % 64) / 2; }
__host__ __device__ __forceinline__ int perm32(int rho) { const int n = rho >> 4, i = rho & 15; return 8 * (i >> 2) + 4 * n + (i & 3); }
__device__ __forceinline__ unsigned cvt_pk_bf16(float lo, float hi) { unsigned r; asm volatile("v_cvt_pk_bf16_f32 %0, %1, %2" : "=v"(r) : "v"(lo), "v"(hi)); return r; }

struct Unit { int pm, pn; const char* A; const char* B; const int* rows; int aux; int nt; };

__device__ __forceinline__ bool static_tile(int i, int G, int c, int nM, int nN, int& pm, int& pn) {
  const int nwg = nM * nN; const long L = (long)i * G + c; if (L >= nwg) return false;
  int wgid = (int)L; { const int q = nwg / NXCD, r = nwg % NXCD, xcd = wgid % NXCD, off = wgid / NXCD; wgid = (xcd < r ? xcd * (q + 1) : r * (q + 1) + (xcd - r) * q) + off; }
  const int nig = WGM * nN, gid = wgid / nig, fm = gid * WGM, gsz = (nM - fm) < WGM ? (nM - fm) : WGM;
  pm = fm + ((wgid % nig) % gsz); pn = (wgid % nig) / gsz; return true;
}
struct PlainOrder {
  const char* A; const char* Bt; int lda, ldb, nM, nN, G, c, nt;
  __device__ __forceinline__ bool next(int i, Unit& u) const {
    if (!static_tile(i, G, c, nM, nN, u.pm, u.pn)) return false;
    u.A = A + (size_t)u.pm * BM * lda * 2; u.B = Bt + (size_t)u.pn * BM * ldb * 2; u.rows = nullptr; u.aux = 0; u.nt = nt; return true; }
};

__host__ __device__ constexpr int in_tile(int v) {
  constexpr int tab[28] = {13, 15, 17, 21,  14, 16, 18, 22,  2, 5, 19, 23,  6, 10, 20, 24,  7, 11, 0, 3,  8, 12, 1, 4,  9, 25, 0, 0};
  return tab[v]; }
struct InOrder {
  const char* A; const char* Bt; int G, c;
  __device__ __forceinline__ bool next(int i, Unit& u) const {
    int pv; if (!static_tile(i, G, c, T / BM, NZP / BM, u.pm, pv)) return false;
    unsigned long long w0 = 0, w1 = 0, w2 = 0;
#pragma unroll
    for (int k = 0; k < 12; ++k) { w0 |= (unsigned long long)in_tile(k) << (5 * k); w1 |= (unsigned long long)in_tile(12 + k) << (5 * k); if (k < 2) w2 |= (unsigned long long)in_tile(24 + k) << (5 * k); }
    const unsigned long long w = pv < 12 ? w0 : pv < 24 ? w1 : w2; const int sh = 5 * (pv < 12 ? pv : pv < 24 ? pv - 12 : pv - 24);
    u.pn = (int)((w >> sh) & 31ull);
    u.A = A + (size_t)u.pm * BM * 1024 * 2; u.B = Bt + (size_t)u.pn * BM * 1024 * 2; u.rows = nullptr; u.aux = 0; u.nt = 16; return true; }
};

template <class Epi> __device__ __forceinline__ auto epi_keep(const Epi&, const Unit& u) -> decltype(Epi::keep(u)) { return Epi::keep(u); }
template <class Epi, class... X> __device__ __forceinline__ bool epi_keep(const Epi&, const Unit&, X...) { return false; }
template <class Epi, class Sched, bool ALIGN_EPI, bool GATHER, int lda, int ldb, int K>
__device__ __forceinline__ void gemm_phase(const int tid, PG8_LAS unsigned char* lds, const Sched& S, const Epi& E, PG8_LAS unsigned char* xlds = nullptr) {
    const int wid = __builtin_amdgcn_readfirstlane(tid >> 6), lane = tid & 63, wr = wid >> 2, wc = wid & 3, fr = lane & 15, fq = lane >> 4;
    unsigned voffA[2][2], voffB[2];
#pragma unroll
    for (int i = 0; i < 2; ++i) { int R, C; stage_rc(tid * 16 + i * 8192, R, C); const int Rb = (R & ~31) + perm32(R & 31);
        voffB[i] = (unsigned)(Rb * ldb + C) * 2u;
#pragma unroll
        for (int h = 0; h < 2; ++h) { voffA[h][i] = (unsigned)((R + (GATHER ? h * HALF : 0)) * lda + C) * 2u; } }
    const size_t hstepA = GATHER ? (size_t)0 : (size_t)HALF * lda * 2;
    const size_t kstep = (size_t)(BK * 2);
    const size_t hstepB = (size_t)HALF * ldb * 2;
    const unsigned ldsw = (unsigned)wid * 1024u;
    const int aoff = lds_byte(wr * 64 + fr, fq * 8), boff = lds_byte(wc * 32 + fr, fq * 8);
#define PG8_SA(b, h) (((b) * 2 + (h)) * HTB)
#define PG8_SB(b, h) ((4 + (b) * 2 + (h)) * HTB)
#define PG8_STAGE(bufoff, gbase, voff) do { _Pragma("unroll") for (int _i = 0; _i < 2; ++_i) \
        __builtin_amdgcn_global_load_lds((const unsigned*)((const char*)(gbase) + (voff)[_i]), (PG8_LAS unsigned*)(lds + (bufoff) + ldsw + _i * 8192), 16, 0, 0); } while (0)
#define PG8_LDA(dst, b, h) do { _Pragma("unroll") for (int m = 0; m < 4; ++m) _Pragma("unroll") for (int k = 0; k < 2; ++k) dst[m][k] = *(const PG8_LAS bf16x8*)(lds + PG8_SA(b, h) + aoff + m * 2048 + k * 1024); } while (0)
#define PG8_LDB(dst, b, h) do { _Pragma("unroll") for (int n = 0; n < 2; ++n) _Pragma("unroll") for (int k = 0; k < 2; ++k) dst[n][k] = *(const PG8_LAS bf16x8*)(lds + PG8_SB(b, h) + boff + n * 2048 + k * 1024); } while (0)
#define PG8_MMA(ai, bj, At, Bt) do { __builtin_amdgcn_s_setprio(1); _Pragma("unroll") for (int m = 0; m < 4; ++m) _Pragma("unroll") for (int n = 0; n < 2; ++n) _Pragma("unroll") for (int k = 0; k < 2; ++k) \
        acc[ai][bj][m][n] = __builtin_amdgcn_mfma_f32_16x16x32_bf16(Bt[n][k], At[m][k], acc[ai][bj][m][n], 0, 0, 0); __builtin_amdgcn_s_setprio(0); } while (0)
#define PG8_WAIT_V(n) asm volatile("s_waitcnt vmcnt(" #n ")" ::: "memory")
#define PG8_WAIT_L(n) asm volatile("s_waitcnt lgkmcnt(" #n ")" ::: "memory")
#define PG8_BAR __builtin_amdgcn_s_barrier()
#define PG8_SCHED __builtin_amdgcn_sched_barrier(0)
#define PG8_GATHER_OFFS(dst, u) do { if (GATHER) { _Pragma("unroll") for (int _i = 0; _i < 2; ++_i) { int _R, _C; stage_rc(tid * 16 + _i * 8192, _R, _C); \
        _Pragma("unroll") for (int _h = 0; _h < 2; ++_h) { const int _r = _h * HALF + _R; const int _e = _r < (u).aux ? ((u).rows[_r] >> 1) : 0; dst[_h][_i] = (unsigned)(_e * lda + _C) * 2u; } } } } while (0)
    Unit cur, nxt; int ui = 0;
    if (!S.next(0, cur)) return;
    PG8_GATHER_OFFS(voffA, cur);
    f32x4 acc[2][2][4][2];
#pragma unroll
    for (int a = 0; a < 2; ++a)
#pragma unroll
        for (int b = 0; b < 2; ++b)
#pragma unroll
            for (int m = 0; m < 4; ++m)
#pragma unroll
                for (int n = 0; n < 2; ++n) acc[a][b][m][n] = (f32x4){0.f, 0.f, 0.f, 0.f};
    bf16x8 At[4][2], B0[2][2], B1[2][2];
    const char* cA = cur.A; const char* cB = cur.B;
    PG8_STAGE(PG8_SB(0, 0), cB, voffB); PG8_STAGE(PG8_SB(0, 1), cB + hstepB, voffB); PG8_STAGE(PG8_SA(0, 0), cA, voffA[0]); PG8_STAGE(PG8_SA(0, 1), cA + hstepA, voffA[1]);
    if (wr == 1) PG8_BAR;
    PG8_WAIT_V(2); PG8_BAR;
    PG8_STAGE(PG8_SB(1, 0), cB + kstep, voffB); PG8_STAGE(PG8_SA(1, 0), cA + kstep, voffA[0]); PG8_STAGE(PG8_SB(1, 1), cB + hstepB + kstep, voffB);
    PG8_WAIT_V(6); PG8_BAR;
    for (;;) {
        const bool has_next = S.next(ui + 1, nxt);
        const char* nA = has_next ? nxt.A : cA; const char* nB = has_next ? nxt.B : cB;

        const int nt = cur.nt;
#pragma unroll 1
        for (int t = 0; t < nt; t += 2) {
            const bool last = (t == nt - 2);
            const char* a1 = cA + (size_t)(t + 1) * kstep;
            const char* a2 = last ? nA : cA + (size_t)(t + 2) * kstep; const char* b2 = last ? nB : cB + (size_t)(t + 2) * kstep;
            const char* a3 = a2 + kstep; const char* b3 = b2 + kstep;

            PG8_LDB(B0, 0, 0); PG8_LDB(B1, 0, 1); PG8_SCHED; PG8_LDA(At, 0, 0); PG8_STAGE(PG8_SA(1, 1), a1 + hstepA, voffA[1]);
            if (GATHER && last && has_next) PG8_GATHER_OFFS(voffA, nxt);
            PG8_WAIT_V(8); PG8_WAIT_L(0); PG8_BAR; PG8_MMA(0, 0, At, B0); PG8_MMA(0, 1, At, B1); PG8_BAR; PG8_SCHED;
            PG8_LDA(At, 0, 1); PG8_STAGE(PG8_SB(0, 0), b2, voffB); PG8_STAGE(PG8_SB(0, 1), b2 + hstepB, voffB); PG8_STAGE(PG8_SA(0, 0), a2, voffA[0]);
            PG8_WAIT_V(8); PG8_WAIT_L(0); PG8_BAR; PG8_MMA(1, 0, At, B0); PG8_MMA(1, 1, At, B1); PG8_BAR; PG8_SCHED;
            PG8_LDB(B0, 1, 0); PG8_LDB(B1, 1, 1); PG8_SCHED; PG8_LDA(At, 1, 0); PG8_STAGE(PG8_SA(0, 1), a2 + hstepA, voffA[1]);
            PG8_WAIT_V(8); PG8_WAIT_L(0); PG8_BAR; PG8_MMA(0, 0, At, B0); PG8_MMA(0, 1, At, B1); PG8_BAR; PG8_SCHED;
            PG8_LDA(At, 1, 1); PG8_STAGE(PG8_SB(1, 0), b3, voffB); PG8_STAGE(PG8_SB(1, 1), b3 + hstepB, voffB); PG8_STAGE(PG8_SA(1, 0), a3, voffA[0]);
            PG8_WAIT_V(8); PG8_WAIT_L(0); PG8_BAR; PG8_MMA(1, 0, At, B0); PG8_MMA(1, 1, At, B1); PG8_BAR; PG8_SCHED;
        }
        if constexpr (ALIGN_EPI) { if (wr == 0) PG8_BAR; }
        { int fr_e = fr, fq_e = fq; asm volatile("" : "+v"(fr_e), "+v"(fq_e)); E(acc, cur, wr, wc, fr_e, fq_e); }
        if (!has_next) break;
        if (!epi_keep<Epi>(E, cur)) {
#pragma unroll
        for (int a = 0; a < 2; ++a)
#pragma unroll
            for (int b = 0; b < 2; ++b)
#pragma unroll
                for (int m = 0; m < 4; ++m)
#pragma unroll
                    for (int n = 0; n < 2; ++n) acc[a][b][m][n] = (f32x4){0.f, 0.f, 0.f, 0.f};
        }
        cur = nxt; cA = nA; cB = nB; ++ui;

        if constexpr (ALIGN_EPI) { if (wr == 1) PG8_BAR; }
    }
    PG8_WAIT_V(0);
    if constexpr (!ALIGN_EPI) { if (wr == 0) PG8_BAR; }
    PG8_BAR;
#undef PG8_SA
#undef PG8_SB
#undef PG8_STAGE
#undef PG8_LDA
#undef PG8_LDB
#undef PG8_MMA
#undef PG8_WAIT_V
#undef PG8_WAIT_L
#undef PG8_BAR
#undef PG8_SCHED
#undef PG8_GATHER_OFFS
}

__device__ __forceinline__ u32x4 pack8(const f32x4 v0, const f32x4 v1) { u32x4 w; w.x = cvt_pk_bf16(v0[0], v0[1]); w.y = cvt_pk_bf16(v0[2], v0[3]); w.z = cvt_pk_bf16(v1[0], v1[1]); w.w = cvt_pk_bf16(v1[2], v1[3]); return w; }
__device__ __forceinline__ void unpack8v(const u32x4 w, f32x4& v0, f32x4& v1) {
  v0[0] = __uint_as_float(w.x << 16); v0[1] = __uint_as_float(w.x & 0xffff0000u); v0[2] = __uint_as_float(w.y << 16); v0[3] = __uint_as_float(w.y & 0xffff0000u);
  v1[0] = __uint_as_float(w.z << 16); v1[1] = __uint_as_float(w.z & 0xffff0000u); v1[2] = __uint_as_float(w.w << 16); v1[3] = __uint_as_float(w.w & 0xffff0000u); }

__device__ __forceinline__ void rope8(f32x4& v0, f32x4& v1, const float* ct, const float* st, int xorm, bool first, bool active, int lane) {
  f32x4 p0, p1;
#pragma unroll
  for (int j = 0; j < 4; ++j) { p0[j] = __int_as_float(__builtin_amdgcn_ds_bpermute((lane ^ xorm) << 2, __float_as_int(v0[j]))); p1[j] = __int_as_float(__builtin_amdgcn_ds_bpermute((lane ^ xorm) << 2, __float_as_int(v1[j]))); }
  const f32x4 c0 = *(const f32x4*)ct, c1 = *(const f32x4*)(ct + 4), s0 = *(const f32x4*)st, s1 = *(const f32x4*)(st + 4);
  const float sg = first ? -1.f : 1.f;
  const f32x4 n0 = v0 * c0 + (p0 * s0) * sg, n1 = v1 * c1 + (p1 * s1) * sg;
  if (active) { v0 = n0; v1 = n1; }
}
enum { K_PLAIN = 0, K_SIG, K_ROPE_A, K_ROPE_I, K_ROPE_B, K_SSQ };
struct EpiIn {
  unsigned char* ws;
  __device__ __forceinline__ void operator()(const f32x4 (&acc)[2][2][4][2], const Unit& u, int wr, int wc, int fr, int fq) const {
    const float* rstd = (const float*)(ws + OFF_CTL + CTL_RSTD); const float* rt = (const float*)(ws + OFF_CTL + CTL_ROPE);
    const int pn = u.pn, lane = fr + 16 * fq;
    float rsv[8];
#pragma unroll
    for (int k = 0; k < 8; ++k) rsv[k] = rstd[u.pm * BM + (k >> 2) * HALF + wr * 64 + (k & 3) * 16 + fr];
#pragma unroll
    for (int bj = 0; bj < 2; ++bj) {
      bf16_t* base; int pitch, lc, kind = K_PLAIN, rg = 0; float* ssq = nullptr;
      const int gc = bj * 128 + wc * 32;
      if (pn < 2) { base = (bf16_t*)(ws + OFF_AQ); pitch = 512; lc = pn * 256 + gc; if (wc == 0) kind = K_ROPE_A; }
      else if (pn == 2) { base = (bf16_t*)(ws + (bj == 0 ? OFF_AK : OFF_AV)); pitch = 128; lc = wc * 32; if (bj == 0 && wc == 0) kind = K_ROPE_A; }
      else if (pn < 5) { base = (bf16_t*)(ws + OFF_AIQ); pitch = 512; lc = (pn - 3) * 256 + gc; if ((wc & 1) == 0) kind = K_ROPE_I; }
      else if (pn == 5) { if (bj == 0) { if (wc < 2) { base = (bf16_t*)(ws + OFF_AIK); pitch = 64; lc = wc * 32; if (wc == 0) kind = K_ROPE_I; }
                                         else { base = (bf16_t*)(ws + OFF_BKR); pitch = 64; lc = (wc - 2) * 32; kind = K_ROPE_B; rg = wc - 2; } }
                          else { base = (bf16_t*)(ws + OFF_BC); pitch = 384; lc = 256 + wc * 32; kind = K_SSQ; ssq = (float*)(ws + OFF_CTL + CTL_SSQKV); } }
      else if (pn == 6) { base = (bf16_t*)(ws + OFF_BC); pitch = 384; lc = gc; kind = K_SSQ; ssq = (float*)(ws + OFF_CTL + CTL_SSQQ) + bj * 4 * T; }
      else if (pn < 9) { base = (bf16_t*)(ws + OFF_CQ); pitch = 512; lc = (pn - 7) * 256 + gc; }
      else if (pn < 11) { base = (bf16_t*)(ws + OFF_CK); pitch = 512; lc = (pn - 9) * 256 + gc; }
      else if (pn < 13) { base = (bf16_t*)(ws + OFF_CV); pitch = 512; lc = (pn - 11) * 256 + gc; }
      else if (pn < 25) { base = (bf16_t*)(ws + OFF_G); pitch = 3072; lc = (pn - 13) * 256 + gc; kind = K_SIG; }
      else { base = (bf16_t*)(ws + OFF_AIWB); pitch = 256; lc = gc; }
#pragma unroll
      for (int ai = 0; ai < 2; ++ai)
#pragma unroll
        for (int m = 0; m < 4; ++m) {
          const int row = u.pm * BM + ai * HALF + wr * 64 + m * 16 + fr; const float rs = rsv[ai * 4 + m]; const int pos = row & (SEQ - 1);
          f32x4 v0 = acc[ai][bj][m][0] * rs, v1 = acc[ai][bj][m][1] * rs;
          if (kind == K_SIG) {
#pragma unroll
            for (int j = 0; j < 4; ++j) { v0[j] = __builtin_amdgcn_rcpf(1.f + __expf(-v0[j])); v1[j] = __builtin_amdgcn_rcpf(1.f + __expf(-v1[j])); } }
          else if (kind == K_ROPE_A) rope8(v0, v1, rt + RT_COSA + pos * 16 + 8 * (fq & 1), rt + RT_SINA + pos * 16 + 8 * (fq & 1), 32, fq < 2, true, lane);
          else if (kind == K_ROPE_I) rope8(v0, v1, rt + RT_COSI + pos * 8, rt + RT_SINI + pos * 8, 16, fq == 0, fq < 2, lane);
          else if (kind == K_ROPE_B) rope8(v0, v1, rt + RT_COSB + pos * 32 + 16 * rg + 8 * (fq & 1), rt + RT_SINB + pos * 32 + 16 * rg + 8 * (fq & 1), 32, fq < 2, true, lane);
          else if (kind == K_SSQ) { float q = 0.f;
#pragma unroll
            for (int j = 0; j < 4; ++j) q += v0[j] * v0[j] + v1[j] * v1[j];
            q += __int_as_float(__builtin_amdgcn_ds_bpermute((lane ^ 16) << 2, __float_as_int(q))); q += __int_as_float(__builtin_amdgcn_ds_bpermute((lane ^ 32) << 2, __float_as_int(q)));
            if (fq == 0) ssq[(size_t)row * 4 + wc] = q; }
          *(u32x4*)(base + (size_t)row * pitch + lc + 8 * fq) = pack8(v0, v1);
        }
    }
  }
};
template <int NP, int W, bool ROPE>
struct EpiUp {
  unsigned char* ws; bf16_t* O; int pitch; const float* ssq;
  __device__ __forceinline__ void operator()(const f32x4 (&acc)[2][2][4][2], const Unit& u, int wr, int wc, int fr, int fq) const {
    const float* rt = (const float*)(ws + OFF_CTL + CTL_ROPE); const int lane = fr + 16 * fq;
#pragma unroll
    for (int ai = 0; ai < 2; ++ai) {
      float rsv[4];
#pragma unroll
      for (int k = 0; k < 4; ++k) { const int row = u.pm * BM + ai * HALF + wr * 64 + k * 16 + fr; float q = 0.f;
#pragma unroll
        for (int p = 0; p < NP; ++p) { const f32x4 s4 = *(const f32x4*)(ssq + (size_t)p * 4 * T + (size_t)row * 4); q += (s4[0] + s4[1]) + (s4[2] + s4[3]); }
        rsv[k] = rsqrtf(q * (1.f / W) + EPS); }
#pragma unroll
      for (int m = 0; m < 4; ++m) { const int row = u.pm * BM + ai * HALF + wr * 64 + m * 16 + fr; const int pos = row & (SEQ - 1);
        const float rs = rsv[m];
#pragma unroll
        for (int bj = 0; bj < 2; ++bj) { f32x4 v0 = acc[ai][bj][m][0] * rs, v1 = acc[ai][bj][m][1] * rs;
          if (ROPE && u.pn == 2) { const int rg = wc & 1; rope8(v0, v1, rt + RT_COSB + pos * 32 + 16 * rg + 8 * (fq & 1), rt + RT_SINB + pos * 32 + 16 * rg + 8 * (fq & 1), 32, fq < 2, true, lane); }
          *(u32x4*)(O + (size_t)row * pitch + u.pn * BM + bj * HALF + wc * 32 + 8 * fq) = pack8(v0, v1); } } }
  }
};
struct EpiProj {
  unsigned char* ws;
  static __device__ __forceinline__ bool keep(const Unit& u) { return u.aux < 2; }
  __device__ __forceinline__ void operator()(f32x4 (&acc)[2][2][4][2], const Unit& u, int wr, int wc, int fr, int fq) const {
    const int b = u.aux;
#pragma unroll
    for (int ai = 0; ai < 2; ++ai) {
      u32x4 gn[4][2], gd[4][2];
#pragma unroll
      for (int m = 0; m < 4; ++m) { const int row = u.pm * BM + ai * HALF + wr * 64 + m * 16 + fr;
#pragma unroll
        for (int bj = 0; bj < 2; ++bj) { const int col = u.pn * BM + bj * HALF + wc * 32 + 8 * fq;
          gn[m][bj] = *(const u32x4*)((const bf16_t*)(ws + OFF_G) + (size_t)row * 3072 + b * 1024 + col);
          if (b < 2) gd[m][bj] = *(const u32x4*)((const bf16_t*)(ws + OFF_G) + (size_t)row * 3072 + (b + 1) * 1024 + col); } }
#pragma unroll
      for (int m = 0; m < 4; ++m) { const int row = u.pm * BM + ai * HALF + wr * 64 + m * 16 + fr;
#pragma unroll
        for (int bj = 0; bj < 2; ++bj) { const int col = u.pn * BM + bj * HALF + wc * 32 + 8 * fq;
          f32x4 g0, g1; unpack8v(gn[m][bj], g0, g1);
          if (b < 2) { f32x4 d0, d1; unpack8v(gd[m][bj], d0, d1);
#pragma unroll
            for (int j = 0; j < 4; ++j) { g0[j] *= __builtin_amdgcn_rcpf(fmaxf(d0[j], 1e-30f)); g1[j] *= __builtin_amdgcn_rcpf(fmaxf(d1[j], 1e-30f)); } }
          acc[ai][bj][m][0] *= g0; acc[ai][bj][m][1] *= g1;
          if (b == 2) *(u32x4*)((bf16_t*)(ws + OFF_MIX) + (size_t)row * 1024 + col) = pack8(acc[ai][bj][m][0], acc[ai][bj][m][1]); } }
    }
  }
};
struct EpiOut {
  float* x; bf16_t* xb;
  __device__ __forceinline__ void operator()(const f32x4 (&acc)[2][2][4][2], const Unit& u, int wr, int wc, int fr, int fq) const {
#pragma unroll
    for (int ai = 0; ai < 2; ++ai)
#pragma unroll
    for (int mh = 0; mh < 2; ++mh) {
      f32x4 xv[2][2][2];
#pragma unroll
      for (int m2 = 0; m2 < 2; ++m2) { const int m = mh * 2 + m2, row = u.pm * BM + ai * HALF + wr * 64 + m * 16 + fr;
#pragma unroll
        for (int bj = 0; bj < 2; ++bj) { const size_t off = (size_t)row * DM + u.pn * BM + bj * HALF + wc * 32 + 8 * fq; xv[m2][bj][0] = *(const f32x4*)(x + off); xv[m2][bj][1] = *(const f32x4*)(x + off + 4); } }
#pragma unroll
      for (int m2 = 0; m2 < 2; ++m2) { const int m = mh * 2 + m2, row = u.pm * BM + ai * HALF + wr * 64 + m * 16 + fr;
#pragma unroll
        for (int bj = 0; bj < 2; ++bj) { const size_t off = (size_t)row * DM + u.pn * BM + bj * HALF + wc * 32 + 8 * fq;
          const f32x4 a0 = xv[m2][bj][0] + acc[ai][bj][m][0], a1 = xv[m2][bj][1] + acc[ai][bj][m][1];
          *(f32x4*)(x + off) = a0; *(f32x4*)(x + off + 4) = a1; *(u32x4*)(xb + off) = pack8(a0, a1); } }
    }
  }
};
struct EpiUpBoth {
  unsigned char* ws;
  __device__ __forceinline__ void operator()(const f32x4 (&acc)[2][2][4][2], const Unit& u, int wr, int wc, int fr, int fq) const {
    if (u.aux == 0) { EpiUp<2, 256, true> e{ws, (bf16_t*)(ws + OFF_QB), 768, (const float*)(ws + OFF_CTL + CTL_SSQQ)}; e(acc, u, wr, wc, fr, fq); }
    else { EpiUp<1, 128, false> e{ws, (bf16_t*)(ws + OFF_KVB), 1024, (const float*)(ws + OFF_CTL + CTL_SSQKV)}; e(acc, u, wr, wc, fr, fq); }
  }
};
struct UpOrder {
  unsigned char* ws; int G, c;
  __device__ __forceinline__ bool next(int i, Unit& u) const {
    const int iw = c & 31, bq = c >> 5; const bool light = iw < 4 || iw >= 28;
    int L;
    if (light) { const int lw = bq * 8 + (iw < 4 ? iw : iw - 24); if (i >= 4) return false; L = i < 3 ? 3 * lw + i : 192 + 192 + lw; }
    else { const int hw = bq * 24 + (iw - 4); if (i >= 1) return false; L = 192 + hw; }
    u.rows = nullptr;
    if (L < 192) { u.pm = L / 3; u.pn = L % 3; u.aux = 0; u.nt = 4; u.A = (const char*)(ws + OFF_BC) + (size_t)u.pm * BM * 384 * 2; u.B = (const char*)(ws + OFF_WATT + WA_UQ) + (size_t)u.pn * BM * 256 * 2; }
    else { const int k = L - 192; u.pm = k >> 2; u.pn = k & 3; u.aux = 1; u.nt = 2; u.A = (const char*)(ws + OFF_BC) + (size_t)u.pm * BM * 384 * 2 + 512; u.B = (const char*)(ws + OFF_WATT + WA_UKV) + (size_t)u.pn * BM * 256 * 2; }
    return true; }
};
struct ProjOrder {
  unsigned char* ws; int G, c;
  __device__ __forceinline__ bool next(int i, Unit& u) const {
    const int b = i % 3; if (!static_tile(i / 3, G, c, T / BM, 4, u.pm, u.pn)) return false;
    const size_t oa = b == 0 ? OFF_AQ : b == 1 ? OFF_AIQ : OFF_CQ;
    u.A = (const char*)(ws + oa) + (size_t)u.pm * BM * 512 * 2; u.B = (const char*)(ws + OFF_WATT + WA_P) + ((size_t)b * 1024 + (size_t)u.pn * BM) * 512 * 2; u.rows = nullptr; u.aux = b; u.nt = 8; return true; }
};

__device__ __forceinline__ void moe_build_map(unsigned* cntp, PG8_LAS unsigned* tab, int tid) {
  if (tid < 64) { const int lane = tid;
    const unsigned c = lane < 32 ? __hip_atomic_load(cntp + lane, __ATOMIC_RELAXED, __HIP_MEMORY_SCOPE_AGENT) : 0u;
    const unsigned nt = (c + 255u) >> 8; unsigned incl = nt;
#pragma unroll
    for (int o = 1; o < 32; o <<= 1) { const unsigned v = (unsigned)__builtin_amdgcn_ds_bpermute(((lane - o) & 63) << 2, (int)incl); if ((lane & 31) >= o) incl += v; }
    const unsigned start = incl - nt;
    if (lane < 32) for (unsigned j = 0; j < nt; ++j) { unsigned valid = c - j * 256u; valid = valid > 256u ? 256u : valid; tab[start + j] = (unsigned)lane | (j << 8) | (valid << 16); }
    if (lane == 31) tab[255] = incl; }
  __syncthreads();
}
template <int NPN, bool DOWN>
struct MoeOrder {
  unsigned char* ws; int G, c; const PG8_LAS unsigned* tab; int lo, hi;
  __device__ __forceinline__ bool next(int i, Unit& u) const {
    const int L = lo + i * G + c, tile = L / NPN, pn = L % NPN; const int total = __builtin_amdgcn_readfirstlane((int)tab[255]); if (c < 0 || L >= hi || tile >= total) return false;
    const unsigned rec = (unsigned)__builtin_amdgcn_readfirstlane((int)tab[tile]);
    const int e = rec & 255u, j = (rec >> 8) & 255u, valid = rec >> 16;
    u.pm = tile; u.pn = pn; u.aux = valid; u.nt = DOWN ? 4 : 16; u.rows = (const int*)(ws + OFF_LIST) + (size_t)e * T + j * 256;
    if (!DOWN) { u.A = (const char*)(ws + OFF_XB); u.B = (const char*)(ws + OFF_WGU) + ((size_t)e * 512 + (size_t)pn * 256) * 1024 * 2; }
    else { u.A = (const char*)(ws + OFF_H) + (size_t)tile * 256 * 256 * 2; u.B = (const char*)(ws + OFF_WD) + ((size_t)e * 1024 + (size_t)pn * 256) * 256 * 2; }
    return true; }
};
struct EpiGU {
  unsigned char* ws;
  __device__ __forceinline__ void operator()(const f32x4 (&acc)[2][2][4][2], const Unit& u, int wr, int wc, int fr, int fq) const {
    const float* rstd = (const float*)(ws + OFF_CTL + CTL_RSTD); const float* tokw = (const float*)(ws + OFF_CTL + CTL_TOKW);
    int ent[8]; float rs[8], wv[8];
#pragma unroll
    for (int k = 0; k < 8; ++k) { const int r = (k >> 2) * HALF + wr * 64 + (k & 3) * 16 + fr; ent[k] = u.rows[r < u.aux ? r : u.aux - 1]; }
#pragma unroll
    for (int k = 0; k < 8; ++k) { rs[k] = rstd[ent[k] >> 1]; wv[k] = tokw[ent[k]]; }
#pragma unroll
    for (int ai = 0; ai < 2; ++ai)
#pragma unroll
      for (int m = 0; m < 4; ++m) { const int r = ai * HALF + wr * 64 + m * 16 + fr; const int k = ai * 4 + m;
        { const float rsk = rs[k], w = wv[k];
          f32x4 h0, h1;
#pragma unroll
          for (int j = 0; j < 4; ++j) { const float a0 = acc[ai][0][m][0][j] * rsk, a1 = acc[ai][0][m][1][j] * rsk;
            h0[j] = a0 * __builtin_amdgcn_rcpf(1.f + __expf(-a0)) * (acc[ai][1][m][0][j] * rsk) * w; h1[j] = a1 * __builtin_amdgcn_rcpf(1.f + __expf(-a1)) * (acc[ai][1][m][1][j] * rsk) * w; }
          *(u32x4*)((bf16_t*)(ws + OFF_H) + ((size_t)u.pm * 256 + r) * 256 + u.pn * 128 + wc * 32 + 8 * fq) = pack8(h0, h1); } }
  }
};
struct EpiDown {
  unsigned char* ws;
  __device__ __forceinline__ void operator()(const f32x4 (&acc)[2][2][4][2], const Unit& u, int wr, int wc, int fr, int fq) const {
    int ent[8];
#pragma unroll
    for (int k = 0; k < 8; ++k) { const int r = (k >> 2) * HALF + wr * 64 + (k & 3) * 16 + fr; ent[k] = u.rows[r < u.aux ? r : u.aux - 1]; }
#pragma unroll
    for (int ai = 0; ai < 2; ++ai)
#pragma unroll
      for (int m = 0; m < 4; ++m) { const int r = ai * HALF + wr * 64 + m * 16 + fr;
        { const int entry = r < u.aux ? ent[ai * 4 + m] : 2 * T;
#pragma unroll
          for (int bj = 0; bj < 2; ++bj) *(u32x4*)((bf16_t*)(ws + OFF_Y) + (size_t)entry * 1024 + u.pn * BM + bj * HALF + wc * 32 + 8 * fq) = pack8(acc[ai][bj][m][0], acc[ai][bj][m][1]); } }
  }
};
}

namespace att {
using bf16x8 = __attribute__((ext_vector_type(8))) short;
using s16x4  = __attribute__((ext_vector_type(4))) short;
using f32x16 = __attribute__((ext_vector_type(16))) float;
using u32x4  = __attribute__((ext_vector_type(4))) unsigned;
constexpr int KVBLK = 64;
constexpr float THR = 8.f, NEG = -1e30f, M_INIT = -1e6f;
#define ASBAR() __builtin_amdgcn_sched_barrier(0)
__device__ __forceinline__ constexpr int crow_c(int r) { return (r & 3) + 8 * (r >> 2); }
__device__ __forceinline__ unsigned cvtpk(float lo, float hi) { unsigned r; asm volatile("v_cvt_pk_bf16_f32 %0, %1, %2" : "=v"(r) : "v"(lo), "v"(hi)); return r; }
template <int MODE> struct Cfg {
  static constexpr int DQK = MODE == 1 ? 192 : 128, ND0 = DQK / 16, KP = DQK * 2, SHM_K = 64 * KP;
  static constexpr float SCALE = MODE == 1 ? 0.07216878364870322f : 0.088388347648318440f;
};
template <int MODE>
__device__ __forceinline__ void partialSM(f32x16& p0, f32x16& p1, float& m_reg, float& mn, float& alpha) {
  constexpr float SC = Cfg<MODE>::SCALE, C = SC * 1.4426950408889634f;
#pragma unroll
  for (int r = 0; r < 16; ++r) { p0[r] *= C; p1[r] *= C; }
  float pmax = p0[0];
#pragma unroll
  for (int r = 1; r < 16; ++r) pmax = fmaxf(pmax, p0[r]);
#pragma unroll
  for (int r = 0; r < 16; ++r) pmax = fmaxf(pmax, p1[r]);
  { auto rr = __builtin_amdgcn_permlane32_swap(__float_as_uint(pmax), __float_as_uint(pmax), false, false);
    pmax = fmaxf(__uint_as_float(rr[0]), __uint_as_float(rr[1])); }
  if (__builtin_expect(__all(pmax - m_reg <= THR * 1.4426950408889634f), 1)) { mn = m_reg; alpha = 1.f; }
  else { mn = fmaxf(m_reg, pmax); alpha = __builtin_amdgcn_exp2f(m_reg - mn); m_reg = mn; }
#pragma unroll
  for (int r = 0; r < 16; ++r) { p0[r] -= mn; p1[r] -= mn; }
#pragma unroll
  for (int r = 0; r < 16; ++r) p0[r] = __builtin_amdgcn_exp2f(p0[r]);
}
__device__ __forceinline__ void finishSM(f32x16& p0, f32x16& p1, float alpha, float& l_reg, bf16x8& pa0, bf16x8& pa1, bf16x8& pa2, bf16x8& pa3) {
#pragma unroll
  for (int r = 0; r < 16; ++r) p1[r] = __builtin_amdgcn_exp2f(p1[r]);
  float ps = 0;
#pragma unroll
  for (int r = 0; r < 16; ++r) ps += p0[r];
#pragma unroll
  for (int r = 0; r < 16; ++r) ps += p1[r];
  { auto rr = __builtin_amdgcn_permlane32_swap(__float_as_uint(ps), __float_as_uint(ps), false, false);
    ps = __uint_as_float(rr[0]) + __uint_as_float(rr[1]); }
  l_reg = l_reg * alpha + ps;
#define PK4(P, BASE, OUT) do { unsigned a0 = cvtpk(P[BASE + 0], P[BASE + 1]), a1 = cvtpk(P[BASE + 2], P[BASE + 3]);   \
    unsigned b0 = cvtpk(P[BASE + 4], P[BASE + 5]), b1 = cvtpk(P[BASE + 6], P[BASE + 7]);                              \
    auto r0 = __builtin_amdgcn_permlane32_swap(a0, b0, false, false); auto r1 = __builtin_amdgcn_permlane32_swap(a1, b1, false, false); \
    u32x4 w = {r0[0], r1[0], r0[1], r1[1]}; OUT = *reinterpret_cast<bf16x8*>(&w); } while (0)
  PK4(p0, 0, pa0); PK4(p0, 8, pa1); PK4(p1, 0, pa2); PK4(p1, 8, pa3);
#undef PK4
}
#define KSWZ(row, colB, KP) ((row) * (KP) + ((colB) ^ (((row) & 7) << 4)))
template <int MODE>
__device__ __forceinline__ void qkt(f32x16& p0, f32x16& p1, const char* Ks, const bf16x8* qr, const char* qx  , int r32, int hi) {
  constexpr int KP = Cfg<MODE>::KP;
  p0 = f32x16{}; p1 = f32x16{};
#pragma unroll
  for (int d0 = 0; d0 < Cfg<MODE>::ND0; ++d0) { const int cb = (d0 * 16 + hi * 8) * 2;
    bf16x8 b0 = *reinterpret_cast<const bf16x8*>(Ks + KSWZ(r32, cb, KP));
    bf16x8 b1 = *reinterpret_cast<const bf16x8*>(Ks + KSWZ(32 + r32, cb, KP));
    const bf16x8 q = d0 < 8 ? qr[d0 < 8 ? d0 : 0] : *reinterpret_cast<const bf16x8*>(qx + (d0 - 8) * 32);
    p0 = __builtin_amdgcn_mfma_f32_32x32x16_bf16(b0, q, p0, 0, 0, 0);
    p1 = __builtin_amdgcn_mfma_f32_32x32x16_bf16(b1, q, p1, 0, 0, 0); }
}
__device__ __forceinline__ int v_st(int k, int c) { const int kk = (k & ~0xC) | ((k & 4) << 1) | ((k & 8) >> 1); return ((kk >> 3) * 4 + (c >> 5)) * 512 + ((kk & 7) * 32 + (c & 31)) * 2; }
__device__ __forceinline__ int v_rd_base(int lane) { return ((lane & 3) << 3) | (((lane >> 2) & 3) << 6) | (((lane >> 4) & 1) << 5) | (((lane >> 5) & 1) << 8); }
constexpr int v_rd_off(int d0, int ks, int half) { return d0 * 512 + ks * 4096 + half * 2048; }
template <int OFF> __device__ __forceinline__ s16x4 tr_read(int vb) {
  s16x4 r; asm volatile("ds_read_b64_tr_b16 %0, %1 offset:%2" : "=&v"(r) : "v"(vb), "i"(OFF) : "memory"); return r;
}
template <int D0> __device__ __forceinline__ void pv_one(f32x16& od, int vb, bf16x8 pa0, bf16x8 pa1, bf16x8 pa2, bf16x8 pa3) {
  const s16x4 l0 = tr_read<v_rd_off(D0, 0, 0)>(vb), h0 = tr_read<v_rd_off(D0, 0, 1)>(vb), l1 = tr_read<v_rd_off(D0, 1, 0)>(vb), h1 = tr_read<v_rd_off(D0, 1, 1)>(vb);
  const s16x4 l2 = tr_read<v_rd_off(D0, 2, 0)>(vb), h2 = tr_read<v_rd_off(D0, 2, 1)>(vb), l3 = tr_read<v_rd_off(D0, 3, 0)>(vb), h3 = tr_read<v_rd_off(D0, 3, 1)>(vb);
  asm volatile("s_waitcnt lgkmcnt(0)" ::: "memory"); ASBAR();
#define PK(L, H) (bf16x8){L[0], L[1], L[2], L[3], H[0], H[1], H[2], H[3]}
  od = __builtin_amdgcn_mfma_f32_32x32x16_bf16(pa0, PK(l0, h0), od, 0, 0, 0);
  od = __builtin_amdgcn_mfma_f32_32x32x16_bf16(pa1, PK(l1, h1), od, 0, 0, 0);
  od = __builtin_amdgcn_mfma_f32_32x32x16_bf16(pa2, PK(l2, h2), od, 0, 0, 0);
  od = __builtin_amdgcn_mfma_f32_32x32x16_bf16(pa3, PK(l3, h3), od, 0, 0, 0);
#undef PK
}
__device__ __forceinline__ void pv_d0(f32x16* o, int vb, bf16x8 pa0, bf16x8 pa1, bf16x8 pa2, bf16x8 pa3) {
  pv_one<0>(o[0], vb, pa0, pa1, pa2, pa3); pv_one<1>(o[1], vb, pa0, pa1, pa2, pa3); pv_one<2>(o[2], vb, pa0, pa1, pa2, pa3); pv_one<3>(o[3], vb, pa0, pa1, pa2, pa3);
}
template <int MODE>
__device__ __forceinline__ void post_scores(f32x16& p0, f32x16& p1, int jt, int jlo_w, int jhi_w, int cw, const char* xl, int qloc, int hi) {
  if (MODE == 0) {
    const uint2 w = *reinterpret_cast<const uint2*>(xl + qloc * 264 + jt * 8);
    const unsigned wl = w.x >> (4 * hi), wh = w.y >> (4 * hi);
#pragma unroll
    for (int r = 0; r < 16; ++r) { const unsigned m0 = (unsigned)__builtin_amdgcn_sbfe((int)wl, crow_c(r), 1), m1 = (unsigned)__builtin_amdgcn_sbfe((int)wh, crow_c(r), 1);
      p0[r] = __uint_as_float((__float_as_uint(p0[r]) & m0) | (__float_as_uint(NEG) & ~m0)); p1[r] = __uint_as_float((__float_as_uint(p1[r]) & m1) | (__float_as_uint(NEG) & ~m1)); }
  } else {
    if (jt > jhi_w || jt < jlo_w) {
#pragma unroll
      for (int r = 0; r < 16; ++r) { p0[r] = NEG; p1[r] = NEG; }
    } else if (MODE == 2) {
      const float* tab = reinterpret_cast<const float*>(xl);
      const int dj = cw - jt;
      if (dj >= 3) { const float bf = tab[256];
#pragma unroll
        for (int r = 0; r < 16; ++r) { p0[r] += bf; p1[r] += bf; } }
      else { const int dbase = dj * 64 + qloc - 4 * hi;
#pragma unroll
        for (int r = 0; r < 16; ++r) { int d0 = dbase - crow_c(r), d1 = d0 - 32; d0 = d0 > 128 ? 128 : d0; d1 = d1 > 128 ? 128 : d1; p0[r] += tab[d0 + 128]; p1[r] += tab[d1 + 128]; } }
    }
  }
}
template <int MODE>
__device__ __forceinline__ void attn_unit(unsigned char* ws, const float* relb, const int tid, char* lds, const int b, const int hx, const int cg, const bool dry = false) {
  using C = Cfg<MODE>;
  constexpr int KP = C::KP, SHM_K = C::SHM_K, SHM_V = 16384, ND0 = C::ND0;
  const int wid = __builtin_amdgcn_readfirstlane(tid >> 6), lane = tid & 63, r32 = lane & 31, hi = lane >> 5;
  char* V_lds = lds; char* K_lds = lds + 2 * SHM_V;
  float* wsc = reinterpret_cast<float*>(lds + 2 * SHM_V + 2 * SHM_K) + wid * 64; float* li_l = wsc; float* al_l = wsc + 32;
  char* xl = lds + 2 * SHM_V + 2 * SHM_K + 2048;
  const size_t tb = (size_t)b * SEQ;
  const int cw = MODE == 0 ? cg : 4 * cg + (wid >> 1);
  const int qloc = (wid & 1) * 32 + r32;
  const size_t tok = tb + (size_t)cw * 64 + qloc;
  const int j0 = MODE == 2 ? (4 * cg - 8 > 0 ? 4 * cg - 8 : 0) : 0;
  const int NT = MODE == 0 ? ((cg + 2) & ~1) : (4 * cg + 4 - j0);
  const int jlo_w = MODE == 2 ? (cw - 8 > 0 ? cw - 8 : 0) : 0, jhi_w = cw;
  const bf16_t* Kh; const bf16_t* Vh; const bf16_t* Kr = nullptr; int LDK;
  if (MODE == 0) { Kh = (const bf16_t*)(ws + OFF_AK) + tb * 128; Vh = (const bf16_t*)(ws + OFF_AV) + tb * 128; LDK = 128; }
  else if (MODE == 1) { Kh = (const bf16_t*)(ws + OFF_KVB) + tb * 1024 + hx * 256; Vh = Kh + 128; Kr = (const bf16_t*)(ws + OFF_BKR) + tb * 64; LDK = 1024; }
  else { Kh = (const bf16_t*)(ws + OFF_CK) + tb * 512 + hx * 128; Vh = (const bf16_t*)(ws + OFF_CV) + tb * 512 + hx * 128; LDK = 512; }
  __syncthreads();
  if (MODE == 0) { const uint2* mb = (const uint2*)(ws + OFF_MASK) + (tb + (size_t)cg * 64) * 32;
    for (int i = tid; i < 64 * 32; i += 512) { const int q = i >> 5, j = i & 31; *reinterpret_cast<uint2*>(xl + q * 264 + j * 8) = mb[i]; } }
  if (MODE == 2) { for (int i = tid; i < 257; i += 512) reinterpret_cast<float*>(xl)[i] = relb[hx * 257 + i] * (1.f / C::SCALE); }
  float m_reg = M_INIT, l_reg = 0; f32x16 o[4] = {}; bf16x8 qr[8];
  const char* qx = xl + wid * 4608 + r32 * 144 + hi * 16;
  { const bf16_t* Qw;
    if (MODE == 0) Qw = (const bf16_t*)(ws + OFF_AQ) + tok * 512 + (wid >> 1) * 128 + hi * 8;
    else if (MODE == 1) Qw = (const bf16_t*)(ws + OFF_QB) + tok * 768 + hx * 128 + hi * 8;
    else Qw = (const bf16_t*)(ws + OFF_CQ) + tok * 512 + hx * 128 + hi * 8;
#pragma unroll
    for (int d0 = 0; d0 < 8; ++d0) qr[d0] = *reinterpret_cast<const bf16x8*>(Qw + d0 * 16);
    if (MODE == 1) { const bf16_t* Qr = (const bf16_t*)(ws + OFF_QB) + tok * 768 + 512 + hx * 64 + hi * 8;
#pragma unroll
      for (int d0 = 8; d0 < ND0; ++d0) *reinterpret_cast<bf16x8*>(const_cast<char*>(qx) + (d0 - 8) * 32) = *reinterpret_cast<const bf16x8*>(Qr + (d0 - 8) * 16); } }
  const int sr = tid >> 4, sc = (tid & 15) * 8, vst0 = v_st(sr, sc), vst1 = v_st(32 + sr, sc);
  const int vb0 = (int)(uintptr_t)V_lds + v_rd_base(lane);
  constexpr int NPI = SHM_K / 8192;
  unsigned koff[NPI], kstr[NPI];
#pragma unroll
  for (int i = 0; i < NPI; ++i) { const int L = (i * 8 + wid) * 1024 + lane * 16, row = L / KP, cs = L % KP, colB = cs ^ ((row & 7) << 4);
    if (MODE == 1 && colB >= 256) { koff[i] = (unsigned)(OFF_BKR + (tb + (size_t)j0 * 64 + row) * 128 + (colB - 256)); kstr[i] = 64 * 128; }
    else { koff[i] = (unsigned)((MODE == 0 ? OFF_AK : MODE == 1 ? OFF_KVB : OFF_CK) + (tb + (size_t)j0 * 64 + row) * (size_t)LDK * 2 + (MODE == 0 ? 0 : MODE == 1 ? hx * 512 : hx * 256) + colB); kstr[i] = 64 * LDK * 2; } }
  bf16x8 vs0, vs1;
#define SLOAD(jrel, bf) do { const int k0_ = kbase + (jrel) * KVBLK; \
    vs0 = *reinterpret_cast<const bf16x8*>(&Vh[(size_t)(k0_ + sr) * LDK + sc]); vs1 = *reinterpret_cast<const bf16x8*>(&Vh[(size_t)(k0_ + 32 + sr) * LDK + sc]); \
    _Pragma("unroll") for (int i_ = 0; i_ < NPI; ++i_) { __builtin_amdgcn_global_load_lds((const unsigned*)(ws + koff[i_]), \
        (__attribute__((address_space(3))) unsigned*)(K_lds + (bf) * SHM_K + (i_ * 8 + wid) * 1024), 16, 0, 0); koff[i_] += (MODE == 1 ? kstr[i_] : (unsigned)(64 * LDK * 2)); } } while (0)
#define SWRITE(bf) do { *reinterpret_cast<bf16x8*>(V_lds + (bf) * SHM_V + vst0) = vs0; *reinterpret_cast<bf16x8*>(V_lds + (bf) * SHM_V + vst1) = vs1; } while (0)
#define RESC(a) do { if (__any((a) < 1.f)) { if (hi == 0) al_l[r32] = (a); asm volatile("s_waitcnt lgkmcnt(0)" ::: "memory"); \
    _Pragma("unroll") for (int d = 0; d < 4; ++d) _Pragma("unroll") for (int r = 0; r < 16; ++r) o[d][r] *= al_l[crow_c(r) + 4 * hi]; } } while (0)
#define POST(P0, P1, jrel) post_scores<MODE>(P0, P1, j0 + (jrel), jlo_w, jhi_w, cw, xl, qloc, hi)
  const int kbase = j0 * KVBLK; (void)kbase;
  bf16x8 pa0, pa1, pa2, pa3;
  if (MODE != 2) {
    f32x16 p0, p1; float mn, al;
    SLOAD(0, 0); asm volatile("s_waitcnt vmcnt(0)" ::: "memory"); SWRITE(0); __syncthreads();
    for (int j = 0; j < NT; j += 2) {
      SLOAD(j + 1, 1); ASBAR();
      qkt<MODE>(p0, p1, K_lds, qr, qx, r32, hi); POST(p0, p1, j); partialSM<MODE>(p0, p1, m_reg, mn, al); RESC(al);
      finishSM(p0, p1, al, l_reg, pa0, pa1, pa2, pa3); ASBAR();
      pv_d0(o, vb0, pa0, pa1, pa2, pa3);
      asm volatile("s_waitcnt vmcnt(0)" ::: "memory"); SWRITE(1); __syncthreads();
      const bool more = j + 2 < NT;
      if (more) SLOAD(j + 2, 0);
      ASBAR();
      qkt<MODE>(p0, p1, K_lds + SHM_K, qr, qx, r32, hi); POST(p0, p1, j + 1); partialSM<MODE>(p0, p1, m_reg, mn, al); RESC(al);
      finishSM(p0, p1, al, l_reg, pa0, pa1, pa2, pa3); ASBAR();
      pv_d0(o, vb0 + SHM_V, pa0, pa1, pa2, pa3);
      asm volatile("s_waitcnt vmcnt(0)" ::: "memory"); if (more) SWRITE(0); __syncthreads();
    }
  } else {
    f32x16 pA0, pA1, pB0, pB1; float mnA, mnB, alA, alB;
    SLOAD(0, 0); asm volatile("s_waitcnt vmcnt(0)" ::: "memory"); SWRITE(0); __syncthreads();
    qkt<MODE>(pA0, pA1, K_lds, qr, qx, r32, hi); POST(pA0, pA1, 0); partialSM<MODE>(pA0, pA1, m_reg, mnA, alA);
    SLOAD(1, 1);
    asm volatile("s_waitcnt vmcnt(0)" ::: "memory"); SWRITE(1); __syncthreads();
    for (int j = 1; j + 1 < NT; j += 2) {
      ASBAR(); qkt<MODE>(pB0, pB1, K_lds + SHM_K, qr, qx, r32, hi); POST(pB0, pB1, j);
      finishSM(pA0, pA1, alA, l_reg, pa0, pa1, pa2, pa3); ASBAR();
      SLOAD(j + 1, 0); ASBAR();
      pv_d0(o, vb0, pa0, pa1, pa2, pa3); partialSM<MODE>(pB0, pB1, m_reg, mnB, alB);
      __syncthreads(); asm volatile("s_waitcnt vmcnt(0)" ::: "memory"); SWRITE(0);
      RESC(alB); __syncthreads();
      ASBAR(); qkt<MODE>(pA0, pA1, K_lds, qr, qx, r32, hi); POST(pA0, pA1, j + 1);
      finishSM(pB0, pB1, alB, l_reg, pa0, pa1, pa2, pa3); ASBAR();
      SLOAD(j + 2, 1); ASBAR();
      pv_d0(o, vb0 + SHM_V, pa0, pa1, pa2, pa3); partialSM<MODE>(pA0, pA1, m_reg, mnA, alA);
      __syncthreads(); asm volatile("s_waitcnt vmcnt(0)" ::: "memory"); SWRITE(1);
      RESC(alA); __syncthreads();
    }
    ASBAR(); qkt<MODE>(pB0, pB1, K_lds + SHM_K, qr, qx, r32, hi); POST(pB0, pB1, NT - 1);
    finishSM(pA0, pA1, alA, l_reg, pa0, pa1, pa2, pa3); ASBAR();
    pv_d0(o, vb0, pa0, pa1, pa2, pa3); partialSM<MODE>(pB0, pB1, m_reg, mnB, alB);
    __syncthreads(); RESC(alB);
    finishSM(pB0, pB1, alB, l_reg, pa0, pa1, pa2, pa3); ASBAR();
    pv_d0(o, vb0 + SHM_V, pa0, pa1, pa2, pa3);
  }
  int lane_e = lane; asm volatile("" : "+v"(lane_e));
  const int r32e = lane_e & 31, hie = lane_e >> 5;
  if (hi == 0) li_l[r32] = l_reg; asm volatile("s_waitcnt lgkmcnt(0)" ::: "memory");
  float rli[16];
#pragma unroll
  for (int r = 0; r < 16; ++r) rli[r] = __builtin_amdgcn_rcpf(li_l[crow_c(r) + 4 * hi]);
  __syncthreads();
  char* Ost = lds + wid * 8192;
#pragma unroll
  for (int r = 0; r < 16; ++r) { const int orow = crow_c(r) + 4 * hie;
#pragma unroll
    for (int d0 = 0; d0 < 4; ++d0) *reinterpret_cast<bf16_t*>(Ost + orow * 256 + (d0 * 32 + r32e) * 2) = f2bf(o[d0][r] * rli[r]); }
  asm volatile("s_waitcnt lgkmcnt(0)" ::: "memory");
  { bf16_t* Ob; int ldo;
    const size_t tok0 = tb + (size_t)cw * 64 + (wid & 1) * 32;
    if (MODE == 0) { Ob = (bf16_t*)(ws + OFF_AQ) + tok0 * 512 + (wid >> 1) * 128; ldo = 512; }
    else if (MODE == 1) { Ob = (bf16_t*)(ws + OFF_AIQ) + tok0 * 512 + hx * 128; ldo = 512; }
    else { Ob = (bf16_t*)(ws + OFF_CQ) + tok0 * 512 + hx * 128; ldo = 512; }
#pragma unroll
    for (int i = 0; i < 8; ++i) { const int ch = i * 64 + lane_e, row = ch >> 4, c16 = ch & 15;
      const u32x4 ov = *reinterpret_cast<const u32x4*>(Ost + row * 256 + c16 * 16); if (!dry) *reinterpret_cast<u32x4*>(Ob + (size_t)row * ldo + c16 * 8) = ov; } }
#undef SLOAD
#undef SWRITE
#undef RESC
#undef POST
}
}

namespace idx {
using bf16x8 = __attribute__((ext_vector_type(8))) short;
using f32x4 = __attribute__((ext_vector_type(4))) float;
__device__ __forceinline__ unsigned ordkey(float f) { const unsigned u = __float_as_uint(f); return (u & 0x80000000u) ? ~u : (u | 0x80000000u); }
__device__ __forceinline__ void select2(const unsigned (&key)[2][32], const int nw, unsigned* h0p, unsigned* h1p, const int lane_in, unsigned (&thr)[2], bool (&allsel)[2]) {
  unsigned prefix[2] = {0u, 0u}; int rneed[2] = {256, 256}; bool done[2] = {false, false};
  thr[0] = thr[1] = 0u; allsel[0] = allsel[1] = false;
#pragma unroll
  for (int pass = 0; pass < 3; ++pass) {
    if (!(done[0] && done[1])) {
      int lane = lane_in; asm volatile("" : "+v"(lane));
      const int sh = pass == 0 ? 21 : pass == 1 ? 10 : 0, bits = pass == 2 ? 10 : 11; const unsigned nbm = (1u << bits) - 1u;
#pragma unroll
      for (int i = 0; i < 8; ++i) { *reinterpret_cast<uint4*>(reinterpret_cast<char*>(h0p) + (i * 64 + lane) * 16) = make_uint4(0u, 0u, 0u, 0u); *reinterpret_cast<uint4*>(reinterpret_cast<char*>(h1p) + (i * 64 + lane) * 16) = make_uint4(0u, 0u, 0u, 0u); }
#pragma unroll
      for (int i = 0; i < 32; ++i) if (i < nw) {
#pragma unroll
        for (int q = 0; q < 2; ++q) { const bool match = pass == 0 ? true : (key[q][i] >> (sh + bits)) == prefix[q];
          if (match) { const unsigned d = (key[q][i] >> sh) & nbm; atomicAdd(&(q ? h1p : h0p)[(d & ~31u) | ((d & 31u) ^ ((d >> 5) & 31u))], 1u); } } }
      unsigned tl[2] = {0u, 0u};
#pragma unroll
      for (int i = 0; i < 32; ++i) { tl[0] += h0p[32 * lane + (i ^ (lane & 31))]; tl[1] += h1p[32 * lane + (i ^ (lane & 31))]; }
      unsigned S[2] = {tl[0], tl[1]};
#pragma unroll
      for (int o = 1; o < 64; o <<= 1) {
        const unsigned v0 = (unsigned)__builtin_amdgcn_ds_bpermute(((lane + o) & 63) << 2, (int)S[0]), v1 = (unsigned)__builtin_amdgcn_ds_bpermute(((lane + o) & 63) << 2, (int)S[1]);
        if (lane + o < 64) { S[0] += v0; S[1] += v1; } }
      int Ls[2], rls[2];
#pragma unroll
      for (int q = 0; q < 2; ++q) { const u64 mk = __ballot((int)S[q] >= rneed[q]); Ls[q] = __builtin_amdgcn_readfirstlane(63 - __clzll(mk));
        rls[q] = __builtin_amdgcn_readlane(rneed[q] - (int)(S[q] - tl[q]), Ls[q]); }
      const int li = lane & 31;
      unsigned hbv[2] = {h0p[32 * Ls[0] + (li ^ (Ls[0] & 31))], h1p[32 * Ls[1] + (li ^ (Ls[1] & 31))]};
      unsigned P[2] = {hbv[0], hbv[1]};
#pragma unroll
      for (int o = 1; o < 32; o <<= 1) {
        const unsigned v0 = (unsigned)__builtin_amdgcn_ds_bpermute(((lane + o) & 63) << 2, (int)P[0]), v1 = (unsigned)__builtin_amdgcn_ds_bpermute(((lane + o) & 63) << 2, (int)P[1]);
        if (li + o < 32) { P[0] += v0; P[1] += v1; } }
#pragma unroll
      for (int q = 0; q < 2; ++q) {
        const unsigned mk2 = (unsigned)__ballot((int)P[q] >= rls[q]);
        const int bi = __builtin_amdgcn_readfirstlane(31 - __clz(mk2));
        const int hbs = __builtin_amdgcn_readlane((int)hbv[q], bi), Pbi = __builtin_amdgcn_readlane((int)P[q], bi);
        const int rn = rls[q] - (Pbi - hbs);
        if (!done[q]) { rneed[q] = rn; prefix[q] = (prefix[q] << bits) | (unsigned)(32 * Ls[q] + bi); thr[q] = prefix[q] << sh;
          if (hbs == rn) { done[q] = true; allsel[q] = true; } }
      }
    }
  }
}
__device__ __forceinline__ u64 mask_words(const unsigned (&key)[32], const unsigned thr, const bool allsel, const int lane) {
  u64 myword = 0ull;
  if (allsel) {
#pragma unroll
    for (int i = 0; i < 32; ++i) { const u64 word = __ballot(key[i] >= thr); if (lane == i) myword = word; }
  } else {
    int cgt = 0;
#pragma unroll
    for (int i = 0; i < 32; ++i) cgt += __popcll(__ballot(key[i] > thr));
    const int need = 256 - cgt; int taken = 0;
#pragma unroll
    for (int i = 0; i < 32; ++i) {
      const bool gt = key[i] > thr, eq = key[i] == thr; const u64 em = __ballot(eq);
      const int before = taken + (int)__builtin_amdgcn_mbcnt_hi((unsigned)(em >> 32), __builtin_amdgcn_mbcnt_lo((unsigned)em, 0u));
      const u64 word = __ballot(gt || (eq && before < need)); taken += __popcll(em);
      if (lane == i) myword = word;
    }
  }
  return myword;
}
__device__ __forceinline__ void indexer_unit(unsigned char* ws, const int tid, char* lds, const int b, const int c, const int half) {
  const int wid = __builtin_amdgcn_readfirstlane(tid >> 6), lane = tid & 63, l15 = lane & 15, G = lane >> 4;
  const size_t tb = (size_t)b * SEQ;
  const int nk = (c + 1) * 64, nw = c + 1, nt16 = nk / 16;
  u64* mrow = (u64*)(ws + OFF_MASK) + (tb + (size_t)c * 64 + half * 32) * 32;
  if (c < 4) {
    for (int i = tid; i < 32 * 32; i += 512) mrow[i] = (i & 31) <= c ? ~0ull : 0ull;
    return;
  }
  float* sc = reinterpret_cast<float*>(lds);
  const bf16_t* aiq = (const bf16_t*)(ws + OFF_AIQ); const bf16_t* aik = (const bf16_t*)(ws + OFF_AIK) + tb * 64; const bf16_t* aiwb = (const bf16_t*)(ws + OFF_AIWB);
  for (int r = 0; r < 2; ++r) {
    {
      const int qbase = c * 64 + half * 32 + r * 16;
      bf16x8 a[2][2][2][2]; f32x4 w[2][2][2];
#pragma unroll
      for (int hh = 0; hh < 2; ++hh)
#pragma unroll
      for (int p = 0; p < 2; ++p) { const size_t tq = tb + qbase + hh * 8 + 4 * p + (l15 >> 2); const int h = l15 & 3;
#pragma unroll
        for (int hg = 0; hg < 2; ++hg)
#pragma unroll
          for (int ks = 0; ks < 2; ++ks) a[hh][p][hg][ks] = *reinterpret_cast<const bf16x8*>(aiq + tq * 512 + (h + 4 * hg) * 64 + 8 * G + 32 * ks);
        { const uint4 wq = *reinterpret_cast<const uint4*>(aiwb + (tb + qbase + hh * 8 + 4 * p + G) * 256);
          w[hh][p][0] = (f32x4){__uint_as_float(wq.x << 16), __uint_as_float(wq.x & 0xffff0000u), __uint_as_float(wq.y << 16), __uint_as_float(wq.y & 0xffff0000u)};
          w[hh][p][1] = (f32x4){__uint_as_float(wq.z << 16), __uint_as_float(wq.z & 0xffff0000u), __uint_as_float(wq.w << 16), __uint_as_float(wq.w & 0xffff0000u)}; } }
      bf16x8 cb[4][2], nb[4][2];
#define IDX_LOADB(dst, t0) do { _Pragma("unroll") for (int k_ = 0; k_ < 4; ++k_) { int tk_ = (t0) + 8 * k_; tk_ = tk_ < nt16 ? tk_ : nt16 - 1; \
        const bf16_t* kp_ = aik + (size_t)(tk_ * 16 + l15) * 64 + 8 * G; dst[k_][0] = *reinterpret_cast<const bf16x8*>(kp_); dst[k_][1] = *reinterpret_cast<const bf16x8*>(kp_ + 32); } } while (0)
      IDX_LOADB(cb, wid);
      for (int t0 = wid; t0 < nt16; t0 += 32) {
        IDX_LOADB(nb, t0 + 32);
#pragma unroll
        for (int k = 0; k < 4; ++k) { const int tk = t0 + 8 * k;
          if (tk < nt16) {
#pragma unroll
            for (int hh = 0; hh < 2; ++hh)
#pragma unroll
            for (int p = 0; p < 2; ++p) {
              f32x4 c0 = {0.f, 0.f, 0.f, 0.f}, c1 = {0.f, 0.f, 0.f, 0.f};
              c0 = __builtin_amdgcn_mfma_f32_16x16x32_bf16(a[hh][p][0][0], cb[k][0], c0, 0, 0, 0); c0 = __builtin_amdgcn_mfma_f32_16x16x32_bf16(a[hh][p][0][1], cb[k][1], c0, 0, 0, 0);
              c1 = __builtin_amdgcn_mfma_f32_16x16x32_bf16(a[hh][p][1][0], cb[k][0], c1, 0, 0, 0); c1 = __builtin_amdgcn_mfma_f32_16x16x32_bf16(a[hh][p][1][1], cb[k][1], c1, 0, 0, 0);
              float sv = 0.f;
#pragma unroll
              for (int j = 0; j < 4; ++j) { const float r0 = __builtin_amdgcn_fmed3f(c0[j], 0.f, __builtin_inff()), r1 = __builtin_amdgcn_fmed3f(c1[j], 0.f, __builtin_inff());
                sv = __builtin_fmaf(r0, w[hh][p][0][j], sv); sv = __builtin_fmaf(r1, w[hh][p][1][j], sv); }
              sc[(8 * hh + 4 * p + G) * 2048 + tk * 16 + l15] = sv; } } }
#pragma unroll
        for (int k = 0; k < 4; ++k) { cb[k][0] = nb[k][0]; cb[k][1] = nb[k][1]; }
      }
#undef IDX_LOADB
    }
    __syncthreads();
    unsigned key[2][32];
#pragma unroll
    for (int i = 0; i < 32; ++i) { const unsigned k0 = ordkey(sc[wid * 2048 + i * 64 + lane]), k1 = ordkey(sc[(wid + 8) * 2048 + i * 64 + lane]);
      key[0][i] = i < nw ? k0 : 0u; key[1][i] = i < nw ? k1 : 0u; }
    asm volatile("s_waitcnt lgkmcnt(0)" ::: "memory");
    unsigned thr[2]; bool allsel[2];
    select2(key, nw, reinterpret_cast<unsigned*>(sc + wid * 2048), reinterpret_cast<unsigned*>(sc + (wid + 8) * 2048), lane, thr, allsel);
    const u64 w0 = mask_words(key[0], thr[0], allsel[0], lane), w1 = mask_words(key[1], thr[1], allsel[1], lane);
    if (lane < 32) { mrow[(size_t)(r * 16 + wid) * 32 + lane] = w0; mrow[(size_t)(r * 16 + wid + 8) * 32 + lane] = w1; }
    __syncthreads();
  }
}
}

#define XB_TMO      128
#define XB_XCNT(j)  (256  + 64 * (j))
#define XB_XSUB(j)  (1280 + 64 * (j))
#define XB_XGEN(j)  (2304 + 64 * (j))
#define XB_TOP      3328
#define XB_TOPGEN   3392
#define XCD_BAR_WORDS 3456
#define XB_SPIN_CAP (1u << 18)
#define LAS __attribute__((address_space(3)))

__device__ __forceinline__ unsigned xb_ld(unsigned* p)              { return __hip_atomic_load(p, __ATOMIC_RELAXED, __HIP_MEMORY_SCOPE_AGENT); }
__device__ __forceinline__ unsigned xb_add(unsigned* p, unsigned v) { return __hip_atomic_fetch_add(p, v, __ATOMIC_RELAXED, __HIP_MEMORY_SCOPE_AGENT); }
__device__ __forceinline__ unsigned xb_xcc_id() { return (unsigned)__builtin_amdgcn_s_getreg((3 << 11) | 20) & 0xFu; }
#define XB_SPIN(cond, bar) do { unsigned _sp = 0; while (cond) { __builtin_amdgcn_s_sleep(1); \
    if ((++_sp & 255u) == 0u) { if (xb_ld(&(bar)[XB_TMO])) break; if (_sp > XB_SPIN_CAP) { atomicAdd(&(bar)[XB_TMO], 1u); break; } } } } while (0)

struct XcdBarrier { unsigned* bar; unsigned x; volatile LAS unsigned* st; };

__device__ __forceinline__ XcdBarrier xcd_barrier_post(unsigned* bar, volatile LAS unsigned* st, int tid) {
    XcdBarrier b; b.bar = bar; b.x = xb_xcc_id(); b.st = st;
    if (tid == 0) (void)xb_add(&bar[XB_XCNT(b.x)], 1u);
    return b;
}
__device__ __forceinline__ void xcd_barrier_complete(unsigned* bar, unsigned x, unsigned& nloc, unsigned& nx) {
    const unsigned G = gridDim.x * gridDim.y * gridDim.z;
    unsigned sum, cnt, mine, sp = 0u;
    for (;;) {
        sum = 0u; cnt = 0u; mine = 0u;
#pragma unroll
        for (unsigned j = 0; j < 16; ++j) { const unsigned c = xb_ld(&bar[XB_XCNT(j)]); sum += c; cnt += (c > 0u) ? 1u : 0u; mine = (j == x) ? c : mine; }
        if (sum == G) break;
        __builtin_amdgcn_s_sleep(1);
        if ((++sp & 255u) == 0u) { if (xb_ld(&bar[XB_TMO])) break; if (sp > XB_SPIN_CAP) { atomicAdd(&bar[XB_TMO], 1u); break; } }
    }
    nloc = mine > 0u ? mine : 1u; nx = cnt > 0u ? cnt : 1u;
}
__device__ __forceinline__ void xcd_barrier(const XcdBarrier& b, int tid) {
    asm volatile("s_waitcnt vmcnt(0)" ::: "memory");
    __syncthreads();
    if (tid == 0) {
        unsigned* bar = b.bar;
        __builtin_amdgcn_s_waitcnt(0);
        unsigned nloc = b.st[0], nx = b.st[1];
        if (nloc == 0u) { xcd_barrier_complete(bar, b.x, nloc, nx); b.st[0] = nloc; b.st[1] = nx; }
        const unsigned old = xb_add(&bar[XB_XSUB(b.x)], 1u);
        const unsigned gen = old / nloc;
        if (old + 1u == (gen + 1u) * nloc) {
            __builtin_amdgcn_fence(__ATOMIC_RELEASE, "agent");
            asm volatile("s_waitcnt vmcnt(0)" ::: "memory");
            const unsigned og = xb_add(&bar[XB_TOP], 1u);
            const unsigned tg = og / nx;
            if (og + 1u == (tg + 1u) * nx) xb_add(&bar[XB_TOPGEN], 1u);
            else XB_SPIN(xb_ld(&bar[XB_TOPGEN]) == tg, bar);
            __builtin_amdgcn_fence(__ATOMIC_ACQUIRE, "agent");
            xb_add(&bar[XB_XGEN(b.x)], 1u);
            asm volatile("s_waitcnt vmcnt(0)" ::: "memory");
        } else {
            XB_SPIN(xb_ld(&bar[XB_XGEN(b.x)]) == gen, bar);
            __builtin_amdgcn_fence(__ATOMIC_ACQUIRE, "agent");
            asm volatile("s_waitcnt vmcnt(0)" ::: "memory");
        }
    }
    __syncthreads();
}

#ifndef RP_PREP
#define RP_PREP 1
#endif
#ifndef RP_P1
#define RP_P1 1
#endif
#ifndef RP_ATT
#define RP_ATT 1
#endif
#ifndef RP_MOE
#define RP_MOE 1
#endif
#ifndef RP_IDX
#define RP_IDX 1
#endif
#ifndef RP_RT
#define RP_RT 1
#endif
#ifndef RP_P4
#define RP_P4 1
#endif
#ifndef RP_UP
#define RP_UP 1
#endif
#ifndef RP_AIW
#define RP_AIW 1
#endif
#ifndef RP_BAR
#define RP_BAR 1
#endif
constexpr int NTHR = 512;
constexpr int LDS_BYTES = 163840;
constexpr int GEMM_LDS_OFF = 1024;
constexpr int XLDS_OFF = 1024 + 131072;
struct Args { const float* in[21]; float* x; unsigned char* ws; };

#define VB_LOOP2(NVB, BODY) do { for (int _i = blockIdx.x; _i < (NVB) / 4; _i += gridDim.x) { const int vb = 4 * _i + 2 * half; BODY; } } while (0)
#define VB_LOOP(NVB, BODY) do { for (int _i = blockIdx.x; _i < (NVB) / 2; _i += gridDim.x) { const int vb = 2 * _i + half; BODY; } } while (0)
#define ROW_LOOP(NROW, BODY) do { for (int row = blockIdx.x * 8 + wave; row < (NROW); row += gridDim.x * 8) { BODY; } } while (0)
#define ELEM_LOOP(N, BODY) do { for (int idx = blockIdx.x * NTHR + tid512; idx < (N); idx += gridDim.x * NTHR) { BODY; } } while (0)

#define AIN(k) as_global(a.in[k])
typedef const __attribute__((address_space(4))) Args* KArgs;
#define PH_BEGIN() KArgs ap_ = (KArgs)__builtin_amdgcn_kernarg_segment_ptr(); asm volatile("" : "+s"(ap_)); const __attribute__((address_space(4))) Args& a = *ap_; \
  int wv_ = wave_u; asm volatile("" : "+s"(wv_)); unsigned z_ = 0u; asm volatile("" : "+v"(z_)); int tid512 = wv_ * 64 + (int)__builtin_amdgcn_mbcnt_hi(~0u, __builtin_amdgcn_mbcnt_lo(~0u, z_)); asm volatile("" : "+v"(tid512)); \
  const int half = tid512 >> 8, tid = tid512 & 255, wave = tid512 >> 6, lane = tid512 & 63; (void)half; (void)tid; (void)wave; (void)lane; \
  size_t zo_ = 0; asm volatile("" : "+s"(zo_)); unsigned char* ws = as_global(a.ws) + zo_; float* x = as_global(a.x) + zo_; \
  char* sm = lds + 1024 + half * 36864; (void)sm; float* rstd = (float*)(ws + OFF_CTL + CTL_RSTD); (void)rstd;

__device__ __forceinline__ void prep_attn_weights(const __attribute__((address_space(4))) Args& a, unsigned char* ws, int l, int half, int tid, char* sm) {
  const float* g_attn = AIN(1) + l * 1024; const float* w_in = AIN(2) + (size_t)l * 1024 * NIN;
  { TrDesc d{w_in, nullptr, g_attn, (bf16_t*)(ws + OFF_WATT + WA_IN), NIN, 1024, NZP, 1}; VB_LOOP2(1664, b_transpose2(d, 0, 0, vb, tid, sm)); }
  { TrDesc d{AIN(4) + (size_t)l * 256 * 768, nullptr, AIN(3) + l * 256, (bf16_t*)(ws + OFF_WATT + WA_UQ), 768, 256, 768, 2}; VB_LOOP2(48, b_transpose2(d, 0, 0, vb, tid, sm)); }
  { TrDesc d{AIN(6) + (size_t)l * 128 * 1024, nullptr, AIN(5) + l * 128, (bf16_t*)(ws + OFF_WATT + WA_UKV), 1024, 128, 1024, 0, 256}; VB_LOOP2(32, b_transpose2(d, 0, 0, vb, tid, sm)); }
  { TrDesc d{AIN(8) + (size_t)l * 512 * 1024, nullptr, nullptr, (bf16_t*)(ws + OFF_WATT + WA_P), 1024, 512, 1024, 0}; VB_LOOP2(128, b_transpose2(d, 0, 0, vb, tid, sm)); }
  { TrDesc d{AIN(9) + (size_t)l * 512 * 1024, nullptr, nullptr, (bf16_t*)(ws + OFF_WATT + WA_P) + (size_t)1024 * 512, 1024, 512, 1024, 0}; VB_LOOP2(128, b_transpose2(d, 0, 0, vb, tid, sm)); }
  { TrDesc d{AIN(10) + (size_t)l * 512 * 1024, nullptr, nullptr, (bf16_t*)(ws + OFF_WATT + WA_P) + (size_t)2 * 1024 * 512, 1024, 512, 1024, 0}; VB_LOOP2(128, b_transpose2(d, 0, 0, vb, tid, sm)); }
  { TrDesc d{AIN(11) + (size_t)l * 1024 * 1024, nullptr, nullptr, (bf16_t*)(ws + OFF_WATT + WA_O), 1024, 1024, 1024, 0}; VB_LOOP2(256, b_transpose2(d, 0, 0, vb, tid, sm)); }
}

#define GRID_BAR() do { PH_BEGIN(); XcdBarrier bar_; bar_.bar = (unsigned*)(ws + OFF_CTL + CTL_BAR); bar_.x = xb_xcc_id(); bar_.st = (volatile LAS unsigned*)lds; xcd_barrier(bar_, tid512); } while (0)
template <int l>
__device__ __forceinline__ void layer_phases(const int wave_u, char* lds) {
#define PH_P1() { PH_BEGIN(); __syncthreads(); \
      { pg8::InOrder S{(const char*)(ws + OFF_XB), (const char*)(ws + OFF_WATT + WA_IN), (int)gridDim.x, (int)blockIdx.x}; pg8::EpiIn E{ws}; \
        pg8::gemm_phase<pg8::EpiIn, pg8::InOrder, true, false, 1024, 1024, 1024>(tid512, (PG8_LAS unsigned char*)lds + GEMM_LDS_OFF, S, E); } }
    PH_P1();
#if RP_P1 > 1
    PH_P1();
#endif
#if RP_BAR > 1
    GRID_BAR(); GRID_BAR(); GRID_BAR(); GRID_BAR(); GRID_BAR(); GRID_BAR(); GRID_BAR(); GRID_BAR(); GRID_BAR(); GRID_BAR();
#endif
    GRID_BAR();
#define PH_UP() { PH_BEGIN(); __syncthreads(); pg8::UpOrder S{ws, (int)gridDim.x, (int)blockIdx.x}; pg8::EpiUpBoth E{ws}; \
      pg8::gemm_phase<pg8::EpiUpBoth, pg8::UpOrder, true, false, 384, 256, 256>(tid512, (PG8_LAS unsigned char*)lds + GEMM_LDS_OFF, S, E); }
    PH_UP();
#if RP_UP > 1
    PH_UP();
#endif
#define PH_IDX() { PH_BEGIN(); __syncthreads(); const int w = blockIdx.x, bb = w >> 5, i = w & 31;        \
      idx::indexer_unit(ws, tid512, lds + GEMM_LDS_OFF, bb, i, 0); idx::indexer_unit(ws, tid512, lds + GEMM_LDS_OFF, bb, 31 - i, 1); }
    PH_IDX();
#if RP_IDX > 1
    PH_IDX();
#endif
    GRID_BAR();
#define PH_ATT(dry) \
    { PH_BEGIN(); const int w = blockIdx.x, bb = w >> 5, i = w & 31; att::attn_unit<0>(ws, nullptr, tid512, lds + GEMM_LDS_OFF, bb, 0, i, dry); } \
    { PH_BEGIN(); const int w = blockIdx.x, bb = w >> 5, i = w & 31; att::attn_unit<1>(ws, nullptr, tid512, lds + GEMM_LDS_OFF, bb, i & 3, 7 - (i >> 2), dry); } \
    { PH_BEGIN(); const float* relb_ = AIN(7) + l * 4 * 257; const int w = blockIdx.x, bb = w >> 5, i = w & 31; att::attn_unit<2>(ws, relb_, tid512, lds + GEMM_LDS_OFF, bb, i & 3, i >> 2, dry); }
#if RP_ATT > 1
    PH_ATT(true);
#endif
    PH_ATT(false);
    GRID_BAR();
    { PH_BEGIN(); if (blockIdx.x == 0 && tid512 < 128) ((unsigned*)(ws + OFF_CTL + CTL_CNT))[tid512] = 0u; }
#define PH_P4()     { PH_BEGIN(); __syncthreads(); \
      pg8::ProjOrder S{ws, (int)gridDim.x, (int)blockIdx.x}; pg8::EpiProj E{ws}; \
      pg8::gemm_phase<pg8::EpiProj, pg8::ProjOrder, false, false, 512, 512, 512>(tid512, (PG8_LAS unsigned char*)lds + GEMM_LDS_OFF, S, E); }
    PH_P4();
#if RP_P4 > 1
    PH_P4();
#endif
    GRID_BAR();
    { PH_BEGIN(); __syncthreads();
      pg8::PlainOrder S{(const char*)(ws + OFF_MIX), (const char*)(ws + OFF_WATT + WA_O), 1024, 1024, T / 256, 4, (int)gridDim.x, (int)blockIdx.x, 16}; pg8::EpiOut E{x, (bf16_t*)(ws + OFF_XB)};
      pg8::gemm_phase<pg8::EpiOut, pg8::PlainOrder, false, false, 1024, 1024, 1024>(tid512, (PG8_LAS unsigned char*)lds + GEMM_LDS_OFF, S, E); }
    GRID_BAR();
#define PH_RT(DRY)     { PH_BEGIN(); const float* g_ = AIN(12) + l * 1024; const float* wg_ = AIN(13) + (size_t)l * 1024 * 4; const float* bg_ = AIN(14) + l * 4; const float* wr_ = AIN(15) + (size_t)l * 1024 * 32; const float* br_ = AIN(16) + l * 32; \
      __syncthreads(); float* wt_ = (float*)(lds + GEMM_LDS_OFF); router_stage(g_, wg_, wr_, wt_, tid512); __syncthreads(); \
      for (int t0 = blockIdx.x * 64; t0 < T; t0 += gridDim.x * 64) \
        router_mfma((const float*)x, wt_, lds + GEMM_LDS_OFF + ROUTER_LDS, bg_, br_, (int*)(ws + OFF_CTL + CTL_TOKE), (float*)(ws + OFF_CTL + CTL_TOKW), rstd, (unsigned*)(ws + OFF_CTL + CTL_CNT), (int*)(ws + OFF_LIST), t0 + (wave & 3) * 16, wave, lane, DRY); \
      __syncthreads(); }
#if RP_RT > 1
    PH_RT(true);
#endif
    PH_RT(false);
#if RP_PREP > 1
    { PH_BEGIN();
      { TrDesc d{AIN(17) + (size_t)l * 32 * 1024 * 256, AIN(18) + (size_t)l * 32 * 1024 * 256, AIN(12) + l * 1024, (bf16_t*)(ws + OFF_WGU), 256, 1024, 512, 3};
        VB_LOOP2(128 * 32, b_transpose2(d, (size_t)1024 * 256, (size_t)512 * 1024, vb, tid, sm)); }
      { TrDesc d{AIN(19) + (size_t)l * 32 * 256 * 1024, nullptr, nullptr, (bf16_t*)(ws + OFF_WD), 1024, 256, 1024, 0};
        VB_LOOP2(64 * 32, b_transpose2(d, (size_t)256 * 1024, (size_t)1024 * 256, vb, tid, sm)); } }
#endif
    { PH_BEGIN();
      { TrDesc d{AIN(17) + (size_t)l * 32 * 1024 * 256, AIN(18) + (size_t)l * 32 * 1024 * 256, AIN(12) + l * 1024, (bf16_t*)(ws + OFF_WGU), 256, 1024, 512, 3};
        VB_LOOP2(128 * 32, b_transpose2(d, (size_t)1024 * 256, (size_t)512 * 1024, vb, tid, sm)); }
      { TrDesc d{AIN(19) + (size_t)l * 32 * 256 * 1024, nullptr, nullptr, (bf16_t*)(ws + OFF_WD), 1024, 256, 1024, 0};
        VB_LOOP2(64 * 32, b_transpose2(d, (size_t)256 * 1024, (size_t)1024 * 256, vb, tid, sm)); } }
    GRID_BAR();
#define MOE_TAB ((PG8_LAS unsigned*)((PG8_LAS unsigned char*)lds + XLDS_OFF))
#define PH_MOE_A() { PH_BEGIN(); __syncthreads(); pg8::moe_build_map((unsigned*)(ws + OFF_CTL + CTL_CNT), MOE_TAB, tid512); \
      pg8::MoeOrder<2, false> S{ws, (int)gridDim.x, (int)blockIdx.x, MOE_TAB, 0, 256}; pg8::EpiGU E{ws}; \
      pg8::gemm_phase<pg8::EpiGU, pg8::MoeOrder<2, false>, true, true, 1024, 1024, 1024>(tid512, (PG8_LAS unsigned char*)lds + GEMM_LDS_OFF, S, E, (PG8_LAS unsigned char*)lds + XLDS_OFF + 1024); }
#define PH_MOE_B() \
    { PH_BEGIN(); __syncthreads(); pg8::moe_build_map((unsigned*)(ws + OFF_CTL + CTL_CNT), MOE_TAB, tid512); \
      pg8::MoeOrder<2, false> S{ws, (int)gridDim.x, (int)blockIdx.x, MOE_TAB, 256, 1 << 30}; pg8::EpiGU E{ws}; \
      pg8::gemm_phase<pg8::EpiGU, pg8::MoeOrder<2, false>, true, true, 1024, 1024, 1024>(tid512, (PG8_LAS unsigned char*)lds + GEMM_LDS_OFF, S, E, (PG8_LAS unsigned char*)lds + XLDS_OFF + 1024); \
      const int nt_ = __builtin_amdgcn_readfirstlane((int)MOE_TAB[255]); const int L_ = 256 + (int)blockIdx.x;       \
      asm volatile("s_waitcnt vmcnt(0)" ::: "memory"); __syncthreads(); \
      if (L_ < 2 * nt_ && tid512 == 0) { __builtin_amdgcn_fence(__ATOMIC_RELEASE, "agent"); asm volatile("s_waitcnt vmcnt(0)" ::: "memory"); \
        __hip_atomic_fetch_add((unsigned*)(ws + OFF_CTL + CTL_CNT) + 64 + (L_ / 2 - 128), 1u, __ATOMIC_RELAXED, __HIP_MEMORY_SCOPE_AGENT); } } \
    { PH_BEGIN(); __syncthreads(); const int nt_ = __builtin_amdgcn_readfirstlane((int)MOE_TAB[255]); const int nx_ = 2 * nt_ > 256 ? 2 * nt_ - 256 : 0; \
      pg8::MoeOrder<4, true> S{ws, (int)gridDim.x - nx_, (int)blockIdx.x - nx_, MOE_TAB, 0, 512}; pg8::EpiDown E{ws}; \
      pg8::gemm_phase<pg8::EpiDown, pg8::MoeOrder<4, true>, true, false, 256, 256, 256>(tid512, (PG8_LAS unsigned char*)lds + GEMM_LDS_OFF, S, E); } \
    { PH_BEGIN(); __syncthreads(); const int nt_ = __builtin_amdgcn_readfirstlane((int)MOE_TAB[255]); const int L_ = 512 + (int)blockIdx.x; \
      if (L_ < 4 * nt_) { if (tid512 == 0) { unsigned* fl_ = (unsigned*)(ws + OFF_CTL + CTL_CNT) + 64 + (L_ / 4 - 128); unsigned sp_ = 0; \
          while (__hip_atomic_load(fl_, __ATOMIC_RELAXED, __HIP_MEMORY_SCOPE_AGENT) < 2u && ++sp_ < (1u << 22)) __builtin_amdgcn_s_sleep(1); \
          __builtin_amdgcn_fence(__ATOMIC_ACQUIRE, "agent"); asm volatile("s_waitcnt vmcnt(0)" ::: "memory"); } } \
      __syncthreads(); \
      pg8::MoeOrder<4, true> S{ws, (int)gridDim.x, (int)blockIdx.x, MOE_TAB, 512, 1 << 30}; pg8::EpiDown E{ws}; \
      pg8::gemm_phase<pg8::EpiDown, pg8::MoeOrder<4, true>, true, false, 256, 256, 256>(tid512, (PG8_LAS unsigned char*)lds + GEMM_LDS_OFF, S, E); }
#if RP_MOE > 1
    PH_MOE_A(); GRID_BAR();
#endif
    PH_MOE_A();
    GRID_BAR();
    PH_MOE_B();
    GRID_BAR();
    if (l == 0) { { PH_BEGIN(); ROW_LOOP(T, b_finalize<false>(x, ws, nullptr, row, lane)); } { PH_BEGIN(); prep_attn_weights(a, ws, 1, half, tid, sm); } if (RP_PREP > 1) { PH_BEGIN(); prep_attn_weights(a, ws, 1, half, tid, sm); } GRID_BAR(); }
    else { PH_BEGIN(); const float* gf_ = AIN(20); ROW_LOOP(T, b_finalize<true>(x, ws, gf_, row, lane)); }
}

__global__ void __launch_bounds__(NTHR, 2) mk_fwd(Args a_in) {
  extern __shared__ __attribute__((aligned(16))) char lds[];
  const int wave_u = __builtin_amdgcn_readfirstlane((int)threadIdx.x >> 6);
  { PH_BEGIN();
    if (tid512 == 0) { ((volatile LAS unsigned*)lds)[0] = 0u; ((volatile LAS unsigned*)lds)[1] = 0u; ((volatile LAS unsigned*)lds)[2] = 0u; ((volatile LAS unsigned*)lds)[3] = 0u; }
    __syncthreads();
    (void)xcd_barrier_post((unsigned*)(ws + OFF_CTL + CTL_BAR), (volatile LAS unsigned*)lds, tid512); }
  { PH_BEGIN(); ELEM_LOOP(2048 * 56, b_rope_tables((float*)(ws + OFF_CTL + CTL_ROPE), idx)); }
  { PH_BEGIN(); const float* xin = AIN(0); ROW_LOOP(T, b_x_init(xin, x, (bf16_t*)(ws + OFF_XB), rstd, row, lane)); }
  { PH_BEGIN(); prep_attn_weights(a, ws, 0, half, tid, sm); }
  if (RP_PREP > 1) { PH_BEGIN(); prep_attn_weights(a, ws, 0, half, tid, sm); }
  GRID_BAR();
  layer_phases<0>(wave_u, lds);
  layer_phases<1>(wave_u, lds);
}

extern "C" void kernel_launch(void* const* d_in, const int* in_sizes, int n_in, void* d_out, int out_size, void* d_ws, size_t ws_size, hipStream_t stream) {
  if (ws_size < WS_END) { fprintf(stderr, "kernel_launch: workspace too small: %zu < %zu\n", ws_size, WS_END); return; }
  static int grid = 0;
  if (!grid) {
    int dev = 0, cus = 0, per_cu = 0;
    hipGetDevice(&dev);
    hipDeviceGetAttribute(&cus, hipDeviceAttributeMultiprocessorCount, dev);
    hipFuncSetAttribute((const void*)mk_fwd, hipFuncAttributeMaxDynamicSharedMemorySize, LDS_BYTES);
    hipOccupancyMaxActiveBlocksPerMultiprocessor(&per_cu, (const void*)mk_fwd, NTHR, LDS_BYTES);
    if (per_cu < 1) { fprintf(stderr, "kernel_launch: occupancy query says %d blocks per CU\n", per_cu); return; }
    if (cus < 256) { fprintf(stderr, "kernel_launch: this kernel is laid out for 256 workgroups, one per CU; the device reports %d CUs\n", cus); return; }
    grid = 256;
  }
  Args a{};
  for (int i = 0; i < 21; ++i) a.in[i] = (const float*)d_in[i];
  a.x = (float*)d_out; a.ws = (unsigned char*)d_ws;
  hipMemsetAsync((unsigned char*)d_ws + OFF_CTL + CTL_BAR, 0, XCD_BAR_WORDS * sizeof(unsigned), stream);
  hipLaunchKernelGGL(mk_fwd, dim3(grid), dim3(NTHR), LDS_BYTES, stream, a);
}
```

```cpp
#include <hip/hip_runtime.h>
#include <hip/hip_bf16.h>
#include <cstdint>
#include <cstdio>

typedef unsigned short bf16_t;
typedef unsigned long long u64;

constexpr int T = 16384, DM = 1024, SEQ = 2048, NB = 8;
constexpr int NIN = 6408, NZ = 6400, NZP = 6656;
constexpr float EPS = 1e-6f;

constexpr size_t MiB = (size_t)1 << 20;
constexpr size_t OFF_CTL = 0;
constexpr size_t OFF_WATT = 4 * MiB;
constexpr size_t OFF_XB = 23 * MiB;
constexpr size_t OFF_AQ = 55 * MiB;
constexpr size_t OFF_CQ = 71 * MiB;
constexpr size_t OFF_QB = 87 * MiB;
constexpr size_t OFF_ZA = 111 * MiB;
constexpr size_t OFF_AK = OFF_ZA;
constexpr size_t OFF_AV = OFF_AK + 4 * MiB;
constexpr size_t OFF_AIQ = OFF_AV + 4 * MiB;
constexpr size_t OFF_AIK = OFF_AIQ + 16 * MiB;
constexpr size_t OFF_BKR = OFF_AIK + 2 * MiB;
constexpr size_t OFF_BCKV = OFF_BKR + 2 * MiB;
constexpr size_t OFF_BCQ = OFF_BCKV + 4 * MiB;
constexpr size_t OFF_BC = OFF_BCKV;
constexpr size_t OFF_CK = OFF_BCQ + 8 * MiB;
constexpr size_t OFF_CV = OFF_CK + 16 * MiB;
constexpr size_t OFF_KVB = 183 * MiB;
constexpr size_t OFF_MASK = 215 * MiB;
constexpr size_t OFF_G = 219 * MiB;
constexpr size_t OFF_AIWB = 315 * MiB;
constexpr size_t WS_END = 323 * MiB;
constexpr size_t OFF_MIX = OFF_KVB;
constexpr size_t OFF_WMOE = OFF_ZA;
constexpr size_t OFF_WGU = OFF_WMOE;
constexpr size_t OFF_WD = OFF_WMOE + 32 * MiB;
constexpr size_t OFF_Y = OFF_G;
constexpr size_t OFF_LIST = OFF_MASK;
constexpr size_t OFF_H = OFF_AQ;
constexpr size_t CTL_BAR = 0;
constexpr size_t CTL_CNT = 16 * 1024;
constexpr size_t CTL_ROPE = 64 * 1024;
constexpr size_t CTL_RSTD = 1 * MiB;
constexpr size_t CTL_RSTDQ = CTL_RSTD + 64 * 1024;
constexpr size_t CTL_RSTDKV = CTL_RSTDQ + 64 * 1024;
constexpr size_t CTL_AIW = CTL_RSTDKV + 64 * 1024;
constexpr size_t CTL_SSQ = 2 * MiB;
constexpr size_t CTL_SSQQ = CTL_SSQ;
constexpr size_t CTL_SSQKV = CTL_SSQ + 512 * 1024;
constexpr size_t CTL_TOKE = 3 * MiB;
constexpr size_t CTL_TOKW = CTL_TOKE + 128 * 1024;
constexpr size_t CTL_WT = 3 * MiB + 512 * 1024;
constexpr size_t WA_IN = 0;
constexpr size_t WA_UQ = 13 * MiB;
constexpr size_t WA_UKV = WA_UQ + 512 * 1024;
constexpr size_t WA_P = 14 * MiB;
constexpr size_t WA_O = 17 * MiB;
constexpr int RT_COSA = 0, RT_SINA = 2048 * 16, RT_COSI = 2048 * 32, RT_SINI = 2048 * 40, RT_COSB = 2048 * 48, RT_SINB = 2048 * 80;

template <class Tp> __device__ __forceinline__ Tp* as_global(Tp* p) { return (Tp*)(__attribute__((address_space(1))) Tp*)p; }
__device__ __forceinline__ float bf2f(bf16_t v) { return __uint_as_float(((unsigned)v) << 16); }
__device__ __forceinline__ bf16_t f2bf(float f) { unsigned u = __float_as_uint(f); return (bf16_t)((u + 0x7fffu + ((u >> 16) & 1u)) >> 16); }
__device__ __forceinline__ float shx(float v, int m, int lane) { return __int_as_float(__builtin_amdgcn_ds_bpermute((lane ^ m) << 2, __float_as_int(v))); }
__device__ __forceinline__ float wave_sum(float v, int lane) {
  v += shx(v, 32, lane); v += shx(v, 16, lane); v += shx(v, 8, lane); v += shx(v, 4, lane); v += shx(v, 2, lane); v += shx(v, 1, lane); return v;
}
__host__ __device__ __forceinline__ int zmap(int c) {
  if (c < 1344) return c;
  if (c < 1408) { int n = c - 1344, g = n >> 5, r = n & 31; return 1736 + (r < 16 ? 16 * g + r : 32 + 16 * g + (r - 16)); }
  if (c < 1536) return 1608 + (c - 1408);
  if (c < 1792) return 1352 + (c - 1536);
  return c + 8;
}
__host__ __device__ __forceinline__ int uqmap(int c) {
  if (c < 512) { int h = c >> 7, d = c & 127; return h * 192 + d; }
  int n = c - 512, h = n >> 6, m = n & 63, g = m >> 5, r = m & 31;
  return h * 192 + 128 + (r < 16 ? 16 * g + r : 32 + 16 * g + (r - 16));
}
__host__ __device__ __forceinline__ int gumap(int n, int& isup) { int pn = n >> 8, j = n & 255; isup = j >= 128; return 128 * pn + (j & 127); }

struct TrDesc { const float* src; const float* src2; const float* scale; bf16_t* dst; int ld; int K; int N; int kind; int dp = 0; };
struct TrRegs { float4 v[4]; float sc[4]; };
__device__ __forceinline__ void tt_load(const TrDesc& d, int tn, int tk, int tid, TrRegs& R) {
  const int n0 = tn * 64, k0 = tk * 64;
  const int n4 = (tid & 15) * 4, kq = tid >> 4;
  const int n = n0 + n4;
  const float* s = d.src; int col; float cs = 1.f;
  if (d.kind == 0) col = n; else if (d.kind == 1) { if (n >= NZ) { col = n < NZ + 8 ? 1344 + (n - NZ) : 0; cs = n < NZ + 8 ? 0.35355339059327373f * 0.125f : 0.f; } else col = zmap(n); } else if (d.kind == 2) col = uqmap(n);
  else { int isup; col = gumap(n, isup); if (isup) s = d.src2; }
  const bool vec = ((((size_t)d.ld * 4) & 15) == 0) && ((col & 3) == 0);
#pragma unroll
  for (int i = 0; i < 4; ++i) { const int kk = kq + 16 * i; const float* p = s + (size_t)(k0 + kk) * d.ld + col;
    if (vec) R.v[i] = *(const float4*)p; else { R.v[i].x = p[0]; R.v[i].y = p[1]; R.v[i].z = p[2]; R.v[i].w = p[3]; }
    R.sc[i] = (d.scale ? d.scale[k0 + kk] : 1.f) * cs; }
}
__device__ __forceinline__ void tt_lds(const TrRegs& R, float (*tile)[65], int tid) {
  const int n4 = (tid & 15) * 4, kq = tid >> 4;
#pragma unroll
  for (int i = 0; i < 4; ++i) { const int kk = kq + 16 * i; const float sc = R.sc[i];
    tile[kk][n4] = R.v[i].x * sc; tile[kk][n4 + 1] = R.v[i].y * sc; tile[kk][n4 + 2] = R.v[i].z * sc; tile[kk][n4 + 3] = R.v[i].w * sc; }
}
__device__ __forceinline__ void tt_store(const TrDesc& d, int tn, int tk, float (*tile)[65], int tid) {
  const int n0 = tn * 64, k0 = tk * 64;
  const int dp = d.dp ? d.dp : d.K;
#pragma unroll
  for (int i = 0; i < 2; ++i) { const int e = tid + 256 * i, nn = e >> 3, k8 = (e & 7) * 8;
    uint4 w;
    w.x = (unsigned)f2bf(tile[k8 + 0][nn]) | ((unsigned)f2bf(tile[k8 + 1][nn]) << 16); w.y = (unsigned)f2bf(tile[k8 + 2][nn]) | ((unsigned)f2bf(tile[k8 + 3][nn]) << 16);
    w.z = (unsigned)f2bf(tile[k8 + 4][nn]) | ((unsigned)f2bf(tile[k8 + 5][nn]) << 16); w.w = (unsigned)f2bf(tile[k8 + 6][nn]) | ((unsigned)f2bf(tile[k8 + 7][nn]) << 16);
    *(uint4*)(d.dst + (size_t)(n0 + nn) * dp + k0 + k8) = w; }
}
__device__ __forceinline__ void b_transpose2(TrDesc d, size_t src_stride, size_t dst_stride, int vb, int tid, char* sm) {
  float (*tileA)[65] = (float (*)[65])sm; float (*tileB)[65] = (float (*)[65])(sm + 64 * 65 * 4);
  const int ntk = d.K / 64, per = (d.N / 64) * ntk;
  TrDesc da = d, db = d;
  { const int e = vb / per; da.src += (size_t)e * src_stride; if (da.src2) da.src2 += (size_t)e * src_stride; da.dst += (size_t)e * dst_stride; }
  { const int e = (vb + 1) / per; db.src += (size_t)e * src_stride; if (db.src2) db.src2 += (size_t)e * src_stride; db.dst += (size_t)e * dst_stride; }
  const int ta = vb % per, tb = (vb + 1) % per;
  TrRegs ra, rb; tt_load(da, ta / ntk, ta % ntk, tid, ra); tt_load(db, tb / ntk, tb % ntk, tid, rb);
  tt_lds(ra, tileA, tid); tt_lds(rb, tileB, tid);
  __syncthreads();
  tt_store(da, ta / ntk, ta % ntk, tileA, tid); tt_store(db, tb / ntk, tb % ntk, tileB, tid);
  __syncthreads();
}
__device__ __forceinline__ void tr_setup(const TrDesc& d, size_t src_stride, size_t dst_stride, int per, int vb, TrDesc& o, int& t) {
  o = d; const int e = vb / per; o.src += (size_t)e * src_stride; if (o.src2) o.src2 += (size_t)e * src_stride; o.dst += (size_t)e * dst_stride; t = vb % per; }
__device__ __forceinline__ void b_transpose_stream(const TrDesc d, size_t src_stride, size_t dst_stride, int nvb, int c, int G, int half, int tid, char* sm) {
  float (*tileA)[65] = (float (*)[65])sm; float (*tileB)[65] = (float (*)[65])(sm + 64 * 65 * 4);
  const int ntk = d.K / 64, per = (d.N / 64) * ntk, n = nvb / 4;
  int i = c; if (i >= n) return;
  TrDesc da, db; int ta, tb; TrRegs ra, rb;
  tr_setup(d, src_stride, dst_stride, per, 4 * i + 2 * half, da, ta); tr_setup(d, src_stride, dst_stride, per, 4 * i + 2 * half + 1, db, tb);
  tt_load(da, ta / ntk, ta % ntk, tid, ra); tt_load(db, tb / ntk, tb % ntk, tid, rb);
  for (;;) {
    tt_lds(ra, tileA, tid); tt_lds(rb, tileB, tid);
    const int inext = i + G; const bool more = inext < n;
    TrDesc na = da, nb = db; int nta = ta, ntb = tb; TrRegs nra = ra, nrb = rb;
    if (more) { tr_setup(d, src_stride, dst_stride, per, 4 * inext + 2 * half, na, nta); tr_setup(d, src_stride, dst_stride, per, 4 * inext + 2 * half + 1, nb, ntb);
      tt_load(na, nta / ntk, nta % ntk, tid, nra); tt_load(nb, ntb / ntk, ntb % ntk, tid, nrb); }
    asm volatile("s_waitcnt lgkmcnt(0)" ::: "memory"); __builtin_amdgcn_s_barrier(); asm volatile("" ::: "memory");
    tt_store(da, ta / ntk, ta % ntk, tileA, tid); tt_store(db, tb / ntk, tb % ntk, tileB, tid);
    asm volatile("s_waitcnt lgkmcnt(0)" ::: "memory"); __builtin_amdgcn_s_barrier(); asm volatile("" ::: "memory");
    if (!more) break;
    da = na; db = nb; ta = nta; tb = ntb; ra = nra; rb = nrb; i = inext;
  }
}
__device__ __forceinline__ void b_rope_tables(float* rt, int i) {
  int pos = i / 56, j = i % 56; int rot, idx, oc, os;
  if (j < 16) { rot = 32; idx = j; oc = RT_COSA + pos * 16 + idx; os = RT_SINA + pos * 16 + idx; }
  else if (j < 24) { rot = 16; idx = j - 16; oc = RT_COSI + pos * 8 + idx; os = RT_SINI + pos * 8 + idx; }
  else { rot = 64; idx = j - 24; oc = RT_COSB + pos * 32 + idx; os = RT_SINB + pos * 32 + idx; }
  float inv = (float)pow(500000.0, -(double)(2 * idx) / (double)rot);
  float ang = (float)pos * inv;
  rt[oc] = (float)cos((double)ang); rt[os] = (float)sin((double)ang);
}
__device__ __forceinline__ void b_x_init(const float* xin, float* x, bf16_t* xb, float* rstd, int row, int lane) {
  const float4* s = (const float4*)(xin + (size_t)row * DM); float4* d = (float4*)(x + (size_t)row * DM);
  float ss = 0.f;
#pragma unroll
  for (int i = 0; i < 4; ++i) { float4 v = s[lane + 64 * i]; d[lane + 64 * i] = v; ss += v.x * v.x + v.y * v.y + v.z * v.z + v.w * v.w;
    bf16_t* o = xb + (size_t)row * DM + (lane + 64 * i) * 4; o[0] = f2bf(v.x); o[1] = f2bf(v.y); o[2] = f2bf(v.z); o[3] = f2bf(v.w); }
  ss = wave_sum(ss, lane);
  if (lane == 0) rstd[row] = rsqrtf(ss * (1.f / DM) + EPS);
}

constexpr int RT_P = 1028;
constexpr int ROUTER_LDS = 36 * RT_P * 4;
__device__ __forceinline__ void b_router_table(const float* g, const float* wg, const float* wr, float* wt, int i) {
  if (i < 1024 * 32) { const int k = i >> 5, j = i & 31; wt[(4 + j) * RT_P + k] = g[k] * wr[i]; }
  else { const int i2 = i - 1024 * 32, k = i2 >> 2, j = i2 & 3; wt[j * RT_P + k] = g[k] * wg[i2]; }
}
__device__ __forceinline__ void router_stage(const float* src, float* wt, int tid) {
  typedef float f4 __attribute__((ext_vector_type(4)));
  constexpr int N4 = 36 * RT_P / 4;
  f4 v[19];
#pragma unroll
  for (int u = 0; u < 19; ++u) { const int i = tid + 512 * u; v[u] = *(const f4*)(src + 4 * (i < N4 ? i : N4 - 1)); }
#pragma unroll
  for (int u = 0; u < 19; ++u) { const int i = tid + 512 * u; if (i < N4) *(f4*)(wt + 4 * i) = v[u]; }
}
__device__ __forceinline__ void router_select(const float (&acc)[36], const float rs, const float* bg, const float* br, int t, int* toke, float* tokw, float* rstd_out, int& e0_out, int& e1_out, bool dry) {
  float lg[4]; float mx = -INFINITY;
#pragma unroll
  for (int j = 0; j < 4; ++j) { lg[j] = acc[j] * rs + bg[j]; mx = fmaxf(mx, lg[j]); }
  float sm = 0.f, best = -1.f; int gs = 0;
#pragma unroll
  for (int j = 0; j < 4; ++j) { const float p = __expf(lg[j] - mx); sm += p; if (p > best) { best = p; gs = j; } }
  const float pg = best / sm;
  const float m0 = gs == 0 ? 1.f : 0.f, m1 = gs == 1 ? 1.f : 0.f, m2 = gs == 2 ? 1.f : 0.f, m3 = gs == 3 ? 1.f : 0.f;
  float e[8]; float emx = -INFINITY;
#pragma unroll
  for (int j = 0; j < 8; ++j) { e[j] = ((acc[4 + j] * m0 + acc[12 + j] * m1) + (acc[20 + j] * m2 + acc[28 + j] * m3)) * rs + br[gs * 8 + j]; emx = fmaxf(emx, e[j]); }
  float es = 0.f, b0 = -1.f, b1 = -1.f; int i0 = 0, i1 = 0;
#pragma unroll
  for (int j = 0; j < 8; ++j) { const float p = __expf(e[j] - emx); es += p;
    if (p > b0) { b1 = b0; i1 = i0; b0 = p; i0 = j; } else if (p > b1) { b1 = p; i1 = j; } }
  const float p0 = b0 / es, p1 = b1 / es, ps = p0 + p1;
  const int e0 = gs * 8 + i0, e1 = gs * 8 + i1;
  if (dry) { asm volatile("" :: "v"(p0 + ps), "v"(e0 + e1)); return; }
  rstd_out[t] = rs;
  toke[t * 2] = e0; toke[t * 2 + 1] = e1; tokw[t * 2] = pg * p0 / ps; tokw[t * 2 + 1] = pg * p1 / ps;
  e0_out = e0; e1_out = e1;
}
__device__ __forceinline__ void router_mfma(const float* x, const float* wt, char* scr  , const float* bg, const float* br, int* toke, float* tokw, float* rstd_out,
                                            unsigned* cnt, int* list, const int t0  , const int wave, const int lane, const bool dry) {
  typedef float f4 __attribute__((ext_vector_type(4)));
  const int i = lane & 15, g = lane >> 4, wp = wave & 3, kh = wave >> 2;
  const float* xr = x + (size_t)(t0 + i) * DM + kh * 512 + 4 * g;
  const float* w0 = wt + (size_t)i * RT_P + kh * 512 + 4 * g; const float* w1 = w0 + 16 * RT_P; const float* w2 = wt + (size_t)(32 + (i < 4 ? i : 3)) * RT_P + kh * 512 + 4 * g;
  f4 c0 = {0.f, 0.f, 0.f, 0.f}, c1 = c0, c2 = c0; float ssl = 0.f;
#pragma unroll 4
  for (int s = 0; s < 32; ++s) {
    const f4 xa = *(const f4*)(xr + 16 * s), b0 = *(const f4*)(w0 + 16 * s), b1 = *(const f4*)(w1 + 16 * s), b2 = *(const f4*)(w2 + 16 * s);
    ssl += (xa[0] * xa[0] + xa[1] * xa[1]) + (xa[2] * xa[2] + xa[3] * xa[3]);
#pragma unroll
    for (int e = 0; e < 4; ++e) { c0 = __builtin_amdgcn_mfma_f32_16x16x4f32(xa[e], b0[e], c0, 0, 0, 0); c1 = __builtin_amdgcn_mfma_f32_16x16x4f32(xa[e], b1[e], c1, 0, 0, 0); c2 = __builtin_amdgcn_mfma_f32_16x16x4f32(xa[e], b2[e], c2, 0, 0, 0); }
  }
  float* part = (float*)scr + (size_t)(wp * 64 + lane) * 12; float* pss = (float*)(scr + 4 * 3072) + wp * 64 + lane;
  unsigned* lcnt = (unsigned*)(scr + 4 * 3072 + 1024); unsigned* lbase = lcnt + 32;
  if (wave == 0 && lane < 32) lcnt[lane] = 0u;
  if (kh == 1) { *(f4*)part = c0; *(f4*)(part + 4) = c1; *(f4*)(part + 8) = c2; *pss = ssl; }
  __syncthreads();
  int e0 = 0, e1 = 0; unsigned r0 = 0u, r1 = 0u; const bool sel = kh == 0 && lane < 16 && !dry;
  if (kh == 0) {
    c0 += *(const f4*)part; c1 += *(const f4*)(part + 4); c2 += *(const f4*)(part + 8); ssl += *pss;
    asm volatile("s_waitcnt lgkmcnt(0)" ::: "memory");
    ssl += shx(ssl, 16, lane); ssl += shx(ssl, 32, lane);
    float* lg = (float*)(scr + wp * 3072);
#pragma unroll
    for (int r = 0; r < 4; ++r) { lg[(4 * g + r) * 48 + i] = c0[r]; lg[(4 * g + r) * 48 + 16 + i] = c1[r]; lg[(4 * g + r) * 48 + 32 + i] = c2[r]; }
    asm volatile("s_waitcnt lgkmcnt(0)" ::: "memory");
    if (lane < 16) { float acc[36];
#pragma unroll
      for (int j = 0; j < 36; ++j) acc[j] = lg[lane * 48 + j];
      router_select(acc, rsqrtf(ssl * (1.f / DM) + EPS), bg, br, t0 + lane, toke, tokw, rstd_out, e0, e1, dry);
      if (!dry) { r0 = atomicAdd(lcnt + e0, 1u); r1 = atomicAdd(lcnt + e1, 1u); } }
  }
  __syncthreads();
  if (!dry && wave == 0 && lane < 32) { const unsigned n = lcnt[lane]; lbase[lane] = n ? atomicAdd(cnt + lane, n) : 0u; }
  __syncthreads();
  if (sel) { list[(size_t)e0 * T + lbase[e0] + r0] = (t0 + lane) * 2; list[(size_t)e1 * T + lbase[e1] + r1] = (t0 + lane) * 2 + 1; }
  __syncthreads();
}
template <bool LAST>
__device__ __forceinline__ void b_finalize(float* x, unsigned char* ws, const float* gf, int row, int lane) {
  float4* xr = (float4*)(x + (size_t)row * DM);
  const bf16_t* y0 = (const bf16_t*)(ws + OFF_Y) + (size_t)row * 2048; const bf16_t* y1 = y0 + 1024;
  float4 v[4]; float ss = 0.f;
#pragma unroll
  for (int i = 0; i < 4; ++i) { const int c4 = lane + 64 * i; float4 a = xr[c4];
    uint2 p0 = *(const uint2*)(y0 + c4 * 4), p1 = *(const uint2*)(y1 + c4 * 4);
    a.x += __uint_as_float(p0.x << 16) + __uint_as_float(p1.x << 16); a.y += __uint_as_float(p0.x & 0xffff0000u) + __uint_as_float(p1.x & 0xffff0000u);
    a.z += __uint_as_float(p0.y << 16) + __uint_as_float(p1.y << 16); a.w += __uint_as_float(p0.y & 0xffff0000u) + __uint_as_float(p1.y & 0xffff0000u);
    v[i] = a; ss += a.x * a.x + a.y * a.y + a.z * a.z + a.w * a.w; }
  ss = wave_sum(ss, lane);
  const float rs = rsqrtf(ss * (1.f / DM) + EPS);
#pragma unroll
  for (int i = 0; i < 4; ++i) { const int c4 = lane + 64 * i; float4 a = v[i];
    if (LAST) { float4 g = ((const float4*)gf)[c4]; a.x *= rs * g.x; a.y *= rs * g.y; a.z *= rs * g.z; a.w *= rs * g.w; xr[c4] = a; }
    else { xr[c4] = a; bf16_t* o = (bf16_t*)(ws + OFF_XB) + (size_t)row * DM + c4 * 4; o[0] = f2bf(a.x); o[1] = f2bf(a.y); o[2] = f2bf(a.z); o[3] = f2bf(a.w); } }
  if (!LAST && lane == 0) ((float*)(ws + OFF_CTL + CTL_RSTD))[row] = rs;
}


namespace pg8 {
#define PG8_LAS __attribute__((address_space(3)))
typedef short bf16x8 __attribute__((ext_vector_type(8)));
typedef float f32x4 __attribute__((ext_vector_type(4)));
typedef unsigned u32x4 __attribute__((ext_vector_type(4)));
constexpr int BM = 256, BK = 64, HALF = 128, HTB = HALF * BK * 2, STAGE_BYTES = 8 * HTB, NXCD = 8, WGM = 8;
__host__ __device__ __forceinline__ int lds_byte(int r, int c) { const int st = (r >> 4) * 2 + (c >> 5), rr = r & 15, cc = c & 31, ob = rr * 64 + cc * 2; return st * 1024 + (ob ^ (((ob >> 9) & 1) << 5)); }
__host__ __device__ __forceinline__ void stage_rc(int b, int& R, int& C) { const int st = b / 1024, sb = b % 1024, swz = sb ^ (((sb >> 9) & 1) << 5); R = (st >> 1) * 16 + swz / 64; C = (st & 1) * 32 + (swz % 64) / 2; }
__host__ __device__ __forceinline__ int perm32(int rho) { const int n = rho >> 4, i = rho & 15; return 8 * (i >> 2) + 4 * n + (i & 3); }
__device__ __forceinline__ unsigned cvt_pk_bf16(float lo, float hi) { unsigned r; asm volatile("v_cvt_pk_bf16_f32 %0, %1, %2" : "=v"(r) : "v"(lo), "v"(hi)); return r; }

struct Unit { int pm, pn; const char* A; const char* B; const int* rows; int aux; int nt; };

__device__ __forceinline__ bool static_tile(int i, int G, int c, int nM, int nN, int& pm, int& pn) {
  const int nwg = nM * nN; const long L = (long)i * G + c; if (L >= nwg) return false;
  int wgid = (int)L; { const int q = nwg / NXCD, r = nwg % NXCD, xcd = wgid % NXCD, off = wgid / NXCD; wgid = (xcd < r ? xcd * (q + 1) : r * (q + 1) + (xcd - r) * q) + off; }
  const int nig = WGM * nN, gid = wgid / nig, fm = gid * WGM, gsz = (nM - fm) < WGM ? (nM - fm) : WGM;
  pm = fm + ((wgid % nig) % gsz); pn = (wgid % nig) / gsz; return true;
}
struct PlainOrder {
  const char* A; const char* Bt; int lda, ldb, nM, nN, G, c, nt;
  __device__ __forceinline__ bool next(int i, Unit& u) const {
    if (!static_tile(i, G, c, nM, nN, u.pm, u.pn)) return false;
    u.A = A + (size_t)u.pm * BM * lda * 2; u.B = Bt + (size_t)u.pn * BM * ldb * 2; u.rows = nullptr; u.aux = 0; u.nt = nt; return true; }
};

__host__ __device__ constexpr int in_tile(int v) {
  constexpr int tab[28] = {13, 15, 17, 21,  14, 16, 18, 22,  2, 5, 19, 23,  6, 10, 20, 24,  7, 11, 0, 3,  8, 12, 1, 4,  9, 25, 0, 0};
  return tab[v]; }
struct InOrder {
  const char* A; const char* Bt; int G, c;
  __device__ __forceinline__ bool next(int i, Unit& u) const {
    int pv; if (!static_tile(i, G, c, T / BM, NZP / BM, u.pm, pv)) return false;
    unsigned long long w0 = 0, w1 = 0, w2 = 0;
#pragma unroll
    for (int k = 0; k < 12; ++k) { w0 |= (unsigned long long)in_tile(k) << (5 * k); w1 |= (unsigned long long)in_tile(12 + k) << (5 * k); if (k < 2) w2 |= (unsigned long long)in_tile(24 + k) << (5 * k); }
    const unsigned long long w = pv < 12 ? w0 : pv < 24 ? w1 : w2; const int sh = 5 * (pv < 12 ? pv : pv < 24 ? pv - 12 : pv - 24);
    u.pn = (int)((w >> sh) & 31ull);
    u.A = A + (size_t)u.pm * BM * 1024 * 2; u.B = Bt + (size_t)u.pn * BM * 1024 * 2; u.rows = nullptr; u.aux = 0; u.nt = 16; return true; }
};

template <class Epi> __device__ __forceinline__ auto epi_keep(const Epi&, const Unit& u) -> decltype(Epi::keep(u)) { return Epi::keep(u); }
template <class Epi, class... X> __device__ __forceinline__ bool epi_keep(const Epi&, const Unit&, X...) { return false; }
template <class Epi, class Sched, bool ALIGN_EPI, bool GATHER, int lda, int ldb, int K>
__device__ __forceinline__ void gemm_phase(const int tid, PG8_LAS unsigned char* lds, const Sched& S, const Epi& E, PG8_LAS unsigned char* xlds = nullptr) {
    const int wid = __builtin_amdgcn_readfirstlane(tid >> 6), lane = tid & 63, wr = wid >> 2, wc = wid & 3, fr = lane & 15, fq = lane >> 4;
    unsigned voffA[2][2], voffB[2];
#pragma unroll
    for (int i = 0; i < 2; ++i) { int R, C; stage_rc(tid * 16 + i * 8192, R, C); const int Rb = (R & ~31) + perm32(R & 31);
        voffB[i] = (unsigned)(Rb * ldb + C) * 2u;
#pragma unroll
        for (int h = 0; h < 2; ++h) { voffA[h][i] = (unsigned)((R + (GATHER ? h * HALF : 0)) * lda + C) * 2u; } }
    const size_t hstepA = GATHER ? (size_t)0 : (size_t)HALF * lda * 2;
    const size_t kstep = (size_t)(BK * 2);
    const size_t hstepB = (size_t)HALF * ldb * 2;
    const unsigned ldsw = (unsigned)wid * 1024u;
    const int aoff = lds_byte(wr * 64 + fr, fq * 8), boff = lds_byte(wc * 32 + fr, fq * 8);
#define PG8_SA(b, h) (((b) * 2 + (h)) * HTB)
#define PG8_SB(b, h) ((4 + (b) * 2 + (h)) * HTB)
#define PG8_STAGE(bufoff, gbase, voff) do { _Pragma("unroll") for (int _i = 0; _i < 2; ++_i) \
        __builtin_amdgcn_global_load_lds((const unsigned*)((const char*)(gbase) + (voff)[_i]), (PG8_LAS unsigned*)(lds + (bufoff) + ldsw + _i * 8192), 16, 0, 0); } while (0)
#define PG8_LDA(dst, b, h) do { _Pragma("unroll") for (int m = 0; m < 4; ++m) _Pragma("unroll") for (int k = 0; k < 2; ++k) dst[m][k] = *(const PG8_LAS bf16x8*)(lds + PG8_SA(b, h) + aoff + m * 2048 + k * 1024); } while (0)
#define PG8_LDB(dst, b, h) do { _Pragma("unroll") for (int n = 0; n < 2; ++n) _Pragma("unroll") for (int k = 0; k < 2; ++k) dst[n][k] = *(const PG8_LAS bf16x8*)(lds + PG8_SB(b, h) + boff + n * 2048 + k * 1024); } while (0)
#define PG8_MMA(ai, bj, At, Bt) do { __builtin_amdgcn_s_setprio(1); _Pragma("unroll") for (int m = 0; m < 4; ++m) _Pragma("unroll") for (int n = 0; n < 2; ++n) _Pragma("unroll") for (int k = 0; k < 2; ++k) \
        acc[ai][bj][m][n] = __builtin_amdgcn_mfma_f32_16x16x32_bf16(Bt[n][k], At[m][k], acc[ai][bj][m][n], 0, 0, 0); __builtin_amdgcn_s_setprio(0); } while (0)
#define PG8_WAIT_V(n) asm volatile("s_waitcnt vmcnt(" #n ")" ::: "memory")
#define PG8_WAIT_L(n) asm volatile("s_waitcnt lgkmcnt(" #n ")" ::: "memory")
#define PG8_BAR __builtin_amdgcn_s_barrier()
#define PG8_SCHED __builtin_amdgcn_sched_barrier(0)
#define PG8_GATHER_OFFS(dst, u) do { if (GATHER) { _Pragma("unroll") for (int _i = 0; _i < 2; ++_i) { int _R, _C; stage_rc(tid * 16 + _i * 8192, _R, _C); \
        _Pragma("unroll") for (int _h = 0; _h < 2; ++_h) { const int _r = _h * HALF + _R; const int _e = _r < (u).aux ? ((u).rows[_r] >> 1) : 0; dst[_h][_i] = (unsigned)(_e * lda + _C) * 2u; } } } } while (0)
    Unit cur, nxt; int ui = 0;
    if (!S.next(0, cur)) return;
    PG8_GATHER_OFFS(voffA, cur);
    f32x4 acc[2][2][4][2];
#pragma unroll
    for (int a = 0; a < 2; ++a)
#pragma unroll
        for (int b = 0; b < 2; ++b)
#pragma unroll
            for (int m = 0; m < 4; ++m)
#pragma unroll
                for (int n = 0; n < 2; ++n) acc[a][b][m][n] = (f32x4){0.f, 0.f, 0.f, 0.f};
    bf16x8 At[4][2], B0[2][2], B1[2][2];
    const char* cA = cur.A; const char* cB = cur.B;
    PG8_STAGE(PG8_SB(0, 0), cB, voffB); PG8_STAGE(PG8_SB(0, 1), cB + hstepB, voffB); PG8_STAGE(PG8_SA(0, 0), cA, voffA[0]); PG8_STAGE(PG8_SA(0, 1), cA + hstepA, voffA[1]);
    if (wr == 1) PG8_BAR;
    PG8_WAIT_V(2); PG8_BAR;
    PG8_STAGE(PG8_SB(1, 0), cB + kstep, voffB); PG8_STAGE(PG8_SA(1, 0), cA + kstep, voffA[0]); PG8_STAGE(PG8_SB(1, 1), cB + hstepB + kstep, voffB);
    PG8_WAIT_V(6); PG8_BAR;
    for (;;) {
        const bool has_next = S.next(ui + 1, nxt);
        const char* nA = has_next ? nxt.A : cA; const char* nB = has_next ? nxt.B : cB;

        const int nt = cur.nt;
#pragma unroll 1
        for (int t = 0; t < nt; t += 2) {
            const bool last = (t == nt - 2);
            const char* a1 = cA + (size_t)(t + 1) * kstep;
            const char* a2 = last ? nA : cA + (size_t)(t + 2) * kstep; const char* b2 = last ? nB : cB + (size_t)(t + 2) * kstep;
            const char* a3 = a2 + kstep; const char* b3 = b2 + kstep;

            PG8_LDB(B0, 0, 0); PG8_LDB(B1, 0, 1); PG8_SCHED; PG8_LDA(At, 0, 0); PG8_STAGE(PG8_SA(1, 1), a1 + hstepA, voffA[1]);
            if (GATHER && last && has_next) PG8_GATHER_OFFS(voffA, nxt);
            PG8_WAIT_V(8); PG8_WAIT_L(0); PG8_BAR; PG8_MMA(0, 0, At, B0); PG8_MMA(0, 1, At, B1); PG8_BAR; PG8_SCHED;
            PG8_LDA(At, 0, 1); PG8_STAGE(PG8_SB(0, 0), b2, voffB); PG8_STAGE(PG8_SB(0, 1), b2 + hstepB, voffB); PG8_STAGE(PG8_SA(0, 0), a2, voffA[0]);
            PG8_WAIT_V(8); PG8_WAIT_L(0); PG8_BAR; PG8_MMA(1, 0, At, B0); PG8_MMA(1, 1, At, B1); PG8_BAR; PG8_SCHED;
            PG8_LDB(B0, 1, 0); PG8_LDB(B1, 1, 1); PG8_SCHED; PG8_LDA(At, 1, 0); PG8_STAGE(PG8_SA(0, 1), a2 + hstepA, voffA[1]);
            PG8_WAIT_V(8); PG8_WAIT_L(0); PG8_BAR; PG8_MMA(0, 0, At, B0); PG8_MMA(0, 1, At, B1); PG8_BAR; PG8_SCHED;
            PG8_LDA(At, 1, 1); PG8_STAGE(PG8_SB(1, 0), b3, voffB); PG8_STAGE(PG8_SB(1, 1), b3 + hstepB, voffB); PG8_STAGE(PG8_SA(1, 0), a3, voffA[0]);
            PG8_WAIT_V(8); PG8_WAIT_L(0); PG8_BAR; PG8_MMA(1, 0, At, B0); PG8_MMA(1, 1, At, B1); PG8_BAR; PG8_SCHED;
        }
        if constexpr (ALIGN_EPI) { if (wr == 0) PG8_BAR; }
        { int fr_e = fr, fq_e = fq; asm volatile("" : "+v"(fr_e), "+v"(fq_e)); E(acc, cur, wr, wc, fr_e, fq_e); }
        if (!has_next) break;
        if (!epi_keep<Epi>(E, cur)) {
#pragma unroll
        for (int a = 0; a < 2; ++a)
#pragma unroll
            for (int b = 0; b < 2; ++b)
#pragma unroll
                for (int m = 0; m < 4; ++m)
#pragma unroll
                    for (int n = 0; n < 2; ++n) acc[a][b][m][n] = (f32x4){0.f, 0.f, 0.f, 0.f};
        }
        cur = nxt; cA = nA; cB = nB; ++ui;

        if constexpr (ALIGN_EPI) { if (wr == 1) PG8_BAR; }
    }
    PG8_WAIT_V(0);
    if constexpr (!ALIGN_EPI) { if (wr == 0) PG8_BAR; }
    PG8_BAR;
#undef PG8_SA
#undef PG8_SB
#undef PG8_STAGE
#undef PG8_LDA
#undef PG8_LDB
#undef PG8_MMA
#undef PG8_WAIT_V
#undef PG8_WAIT_L
#undef PG8_BAR
#undef PG8_SCHED
#undef PG8_GATHER_OFFS
}

__device__ __forceinline__ u32x4 pack8(const f32x4 v0, const f32x4 v1) { u32x4 w; w.x = cvt_pk_bf16(v0[0], v0[1]); w.y = cvt_pk_bf16(v0[2], v0[3]); w.z = cvt_pk_bf16(v1[0], v1[1]); w.w = cvt_pk_bf16(v1[2], v1[3]); return w; }
__device__ __forceinline__ void unpack8v(const u32x4 w, f32x4& v0, f32x4& v1) {
  v0[0] = __uint_as_float(w.x << 16); v0[1] = __uint_as_float(w.x & 0xffff0000u); v0[2] = __uint_as_float(w.y << 16); v0[3] = __uint_as_float(w.y & 0xffff0000u);
  v1[0] = __uint_as_float(w.z << 16); v1[1] = __uint_as_float(w.z & 0xffff0000u); v1[2] = __uint_as_float(w.w << 16); v1[3] = __uint_as_float(w.w & 0xffff0000u); }

__device__ __forceinline__ void rope8(f32x4& v0, f32x4& v1, const float* ct, const float* st, int xorm, bool first, bool active, int lane) {
  f32x4 p0, p1;
#pragma unroll
  for (int j = 0; j < 4; ++j) { p0[j] = __int_as_float(__builtin_amdgcn_ds_bpermute((lane ^ xorm) << 2, __float_as_int(v0[j]))); p1[j] = __int_as_float(__builtin_amdgcn_ds_bpermute((lane ^ xorm) << 2, __float_as_int(v1[j]))); }
  const f32x4 c0 = *(const f32x4*)ct, c1 = *(const f32x4*)(ct + 4), s0 = *(const f32x4*)st, s1 = *(const f32x4*)(st + 4);
  const float sg = first ? -1.f : 1.f;
  const f32x4 n0 = v0 * c0 + (p0 * s0) * sg, n1 = v1 * c1 + (p1 * s1) * sg;
  if (active) { v0 = n0; v1 = n1; }
}
enum { K_PLAIN = 0, K_SIG, K_ROPE_A, K_ROPE_I, K_ROPE_B, K_SSQ };
struct EpiIn {
  unsigned char* ws;
  __device__ __forceinline__ void operator()(const f32x4 (&acc)[2][2][4][2], const Unit& u, int wr, int wc, int fr, int fq) const {
    const float* rstd = (const float*)(ws + OFF_CTL + CTL_RSTD); const float* rt = (const float*)(ws + OFF_CTL + CTL_ROPE);
    const int pn = u.pn, lane = fr + 16 * fq;
    float rsv[8];
#pragma unroll
    for (int k = 0; k < 8; ++k) rsv[k] = rstd[u.pm * BM + (k >> 2) * HALF + wr * 64 + (k & 3) * 16 + fr];
#pragma unroll
    for (int bj = 0; bj < 2; ++bj) {
      bf16_t* base; int pitch, lc, kind = K_PLAIN, rg = 0; float* ssq = nullptr;
      const int gc = bj * 128 + wc * 32;
      if (pn < 2) { base = (bf16_t*)(ws + OFF_AQ); pitch = 512; lc = pn * 256 + gc; if (wc == 0) kind = K_ROPE_A; }
      else if (pn == 2) { base = (bf16_t*)(ws + (bj == 0 ? OFF_AK : OFF_AV)); pitch = 128; lc = wc * 32; if (bj == 0 && wc == 0) kind = K_ROPE_A; }
      else if (pn < 5) { base = (bf16_t*)(ws + OFF_AIQ); pitch = 512; lc = (pn - 3) * 256 + gc; if ((wc & 1) == 0) kind = K_ROPE_I; }
      else if (pn == 5) { if (bj == 0) { if (wc < 2) { base = (bf16_t*)(ws + OFF_AIK); pitch = 64; lc = wc * 32; if (wc == 0) kind = K_ROPE_I; }
                                         else { base = (bf16_t*)(ws + OFF_BKR); pitch = 64; lc = (wc - 2) * 32; kind = K_ROPE_B; rg = wc - 2; } }
                          else { base = (bf16_t*)(ws + OFF_BC); pitch = 384; lc = 256 + wc * 32; kind = K_SSQ; ssq = (float*)(ws + OFF_CTL + CTL_SSQKV); } }
      else if (pn == 6) { base = (bf16_t*)(ws + OFF_BC); pitch = 384; lc = gc; kind = K_SSQ; ssq = (float*)(ws + OFF_CTL + CTL_SSQQ) + bj * 4 * T; }
      else if (pn < 9) { base = (bf16_t*)(ws + OFF_CQ); pitch = 512; lc = (pn - 7) * 256 + gc; }
      else if (pn < 11) { base = (bf16_t*)(ws + OFF_CK); pitch = 512; lc = (pn - 9) * 256 + gc; }
      else if (pn < 13) { base = (bf16_t*)(ws + OFF_CV); pitch = 512; lc = (pn - 11) * 256 + gc; }
      else if (pn < 25) { base = (bf16_t*)(ws + OFF_G); pitch = 3072; lc = (pn - 13) * 256 + gc; kind = K_SIG; }
      else { base = (bf16_t*)(ws + OFF_AIWB); pitch = 256; lc = gc; }
#pragma unroll
      for (int ai = 0; ai < 2; ++ai)
#pragma unroll
        for (int m = 0; m < 4; ++m) {
          const int row = u.pm * BM + ai * HALF + wr * 64 + m * 16 + fr; const float rs = rsv[ai * 4 + m]; const int pos = row & (SEQ - 1);
          f32x4 v0 = acc[ai][bj][m][0] * rs, v1 = acc[ai][bj][m][1] * rs;
          if (kind == K_SIG) {
#pragma unroll
            for (int j = 0; j < 4; ++j) { v0[j] = __builtin_amdgcn_rcpf(1.f + __expf(-v0[j])); v1[j] = __builtin_amdgcn_rcpf(1.f + __expf(-v1[j])); } }
          else if (kind == K_ROPE_A) rope8(v0, v1, rt + RT_COSA + pos * 16 + 8 * (fq & 1), rt + RT_SINA + pos * 16 + 8 * (fq & 1), 32, fq < 2, true, lane);
          else if (kind == K_ROPE_I) rope8(v0, v1, rt + RT_COSI + pos * 8, rt + RT_SINI + pos * 8, 16, fq == 0, fq < 2, lane);
          else if (kind == K_ROPE_B) rope8(v0, v1, rt + RT_COSB + pos * 32 + 16 * rg + 8 * (fq & 1), rt + RT_SINB + pos * 32 + 16 * rg + 8 * (fq & 1), 32, fq < 2, true, lane);
          else if (kind == K_SSQ) { float q = 0.f;
#pragma unroll
            for (int j = 0; j < 4; ++j) q += v0[j] * v0[j] + v1[j] * v1[j];
            q += __int_as_float(__builtin_amdgcn_ds_bpermute((lane ^ 16) << 2, __float_as_int(q))); q += __int_as_float(__builtin_amdgcn_ds_bpermute((lane ^ 32) << 2, __float_as_int(q)));
            if (fq == 0) ssq[(size_t)row * 4 + wc] = q; }
          *(u32x4*)(base + (size_t)row * pitch + lc + 8 * fq) = pack8(v0, v1);
        }
    }
  }
};
template <int NP, int W, bool ROPE>
struct EpiUp {
  unsigned char* ws; bf16_t* O; int pitch; const float* ssq;
  __device__ __forceinline__ void operator()(const f32x4 (&acc)[2][2][4][2], const Unit& u, int wr, int wc, int fr, int fq) const {
    const float* rt = (const float*)(ws + OFF_CTL + CTL_ROPE); const int lane = fr + 16 * fq;
#pragma unroll
    for (int ai = 0; ai < 2; ++ai) {
      float rsv[4];
#pragma unroll
      for (int k = 0; k < 4; ++k) { const int row = u.pm * BM + ai * HALF + wr * 64 + k * 16 + fr; float q = 0.f;
#pragma unroll
        for (int p = 0; p < NP; ++p) { const f32x4 s4 = *(const f32x4*)(ssq + (size_t)p * 4 * T + (size_t)row * 4); q += (s4[0] + s4[1]) + (s4[2] + s4[3]); }
        rsv[k] = rsqrtf(q * (1.f / W) + EPS); }
#pragma unroll
      for (int m = 0; m < 4; ++m) { const int row = u.pm * BM + ai * HALF + wr * 64 + m * 16 + fr; const int pos = row & (SEQ - 1);
        const float rs = rsv[m];
#pragma unroll
        for (int bj = 0; bj < 2; ++bj) { f32x4 v0 = acc[ai][bj][m][0] * rs, v1 = acc[ai][bj][m][1] * rs;
          if (ROPE && u.pn == 2) { const int rg = wc & 1; rope8(v0, v1, rt + RT_COSB + pos * 32 + 16 * rg + 8 * (fq & 1), rt + RT_SINB + pos * 32 + 16 * rg + 8 * (fq & 1), 32, fq < 2, true, lane); }
          *(u32x4*)(O + (size_t)row * pitch + u.pn * BM + bj * HALF + wc * 32 + 8 * fq) = pack8(v0, v1); } } }
  }
};
struct EpiProj {
  unsigned char* ws;
  static __device__ __forceinline__ bool keep(const Unit& u) { return u.aux < 2; }
  __device__ __forceinline__ void operator()(f32x4 (&acc)[2][2][4][2], const Unit& u, int wr, int wc, int fr, int fq) const {
    const int b = u.aux;
#pragma unroll
    for (int ai = 0; ai < 2; ++ai) {
      u32x4 gn[4][2], gd[4][2];
#pragma unroll
      for (int m = 0; m < 4; ++m) { const int row = u.pm * BM + ai * HALF + wr * 64 + m * 16 + fr;
#pragma unroll
        for (int bj = 0; bj < 2; ++bj) { const int col = u.pn * BM + bj * HALF + wc * 32 + 8 * fq;
          gn[m][bj] = *(const u32x4*)((const bf16_t*)(ws + OFF_G) + (size_t)row * 3072 + b * 1024 + col);
          if (b < 2) gd[m][bj] = *(const u32x4*)((const bf16_t*)(ws + OFF_G) + (size_t)row * 3072 + (b + 1) * 1024 + col); } }
#pragma unroll
      for (int m = 0; m < 4; ++m) { const int row = u.pm * BM + ai * HALF + wr * 64 + m * 16 + fr;
#pragma unroll
        for (int bj = 0; bj < 2; ++bj) { const int col = u.pn * BM + bj * HALF + wc * 32 + 8 * fq;
          f32x4 g0, g1; unpack8v(gn[m][bj], g0, g1);
          if (b < 2) { f32x4 d0, d1; unpack8v(gd[m][bj], d0, d1);
#pragma unroll
            for (int j = 0; j < 4; ++j) { g0[j] *= __builtin_amdgcn_rcpf(fmaxf(d0[j], 1e-30f)); g1[j] *= __builtin_amdgcn_rcpf(fmaxf(d1[j], 1e-30f)); } }
          acc[ai][bj][m][0] *= g0; acc[ai][bj][m][1] *= g1;
          if (b == 2) *(u32x4*)((bf16_t*)(ws + OFF_MIX) + (size_t)row * 1024 + col) = pack8(acc[ai][bj][m][0], acc[ai][bj][m][1]); } }
    }
  }
};
struct EpiOut {
  float* x; bf16_t* xb;
  __device__ __forceinline__ void operator()(const f32x4 (&acc)[2][2][4][2], const Unit& u, int wr, int wc, int fr, int fq) const {
#pragma unroll
    for (int ai = 0; ai < 2; ++ai) {
      f32x4 xv[4][2][2];
#pragma unroll
      for (int m = 0; m < 4; ++m) { const int row = u.pm * BM + ai * HALF + wr * 64 + m * 16 + fr;
#pragma unroll
        for (int bj = 0; bj < 2; ++bj) { const size_t off = (size_t)row * DM + u.pn * BM + bj * HALF + wc * 32 + 8 * fq; xv[m][bj][0] = *(const f32x4*)(x + off); xv[m][bj][1] = *(const f32x4*)(x + off + 4); } }
#pragma unroll
      for (int m = 0; m < 4; ++m) { const int row = u.pm * BM + ai * HALF + wr * 64 + m * 16 + fr;
#pragma unroll
        for (int bj = 0; bj < 2; ++bj) { const size_t off = (size_t)row * DM + u.pn * BM + bj * HALF + wc * 32 + 8 * fq;
          const f32x4 a0 = xv[m][bj][0] + acc[ai][bj][m][0], a1 = xv[m][bj][1] + acc[ai][bj][m][1];
          *(f32x4*)(x + off) = a0; *(f32x4*)(x + off + 4) = a1; *(u32x4*)(xb + off) = pack8(a0, a1); } }
    }
  }
};
struct EpiUpBoth {
  unsigned char* ws;
  __device__ __forceinline__ void operator()(const f32x4 (&acc)[2][2][4][2], const Unit& u, int wr, int wc, int fr, int fq) const {
    if (u.aux == 0) { EpiUp<2, 256, true> e{ws, (bf16_t*)(ws + OFF_QB), 768, (const float*)(ws + OFF_CTL + CTL_SSQQ)}; e(acc, u, wr, wc, fr, fq); }
    else { EpiUp<1, 128, false> e{ws, (bf16_t*)(ws + OFF_KVB), 1024, (const float*)(ws + OFF_CTL + CTL_SSQKV)}; e(acc, u, wr, wc, fr, fq); }
  }
};
struct UpOrder {
  unsigned char* ws; int G, c;
  __device__ __forceinline__ bool next(int i, Unit& u) const {
    const int iw = c & 31, bq = c >> 5; const bool light = iw < 4 || iw >= 28;
    int L;
    if (light) { const int lw = bq * 8 + (iw < 4 ? iw : iw - 24); if (i >= 4) return false; L = i < 3 ? 3 * lw + i : 192 + 192 + lw; }
    else { const int hw = bq * 24 + (iw - 4); if (i >= 1) return false; L = 192 + hw; }
    u.rows = nullptr;
    if (L < 192) { u.pm = L / 3; u.pn = L % 3; u.aux = 0; u.nt = 4; u.A = (const char*)(ws + OFF_BC) + (size_t)u.pm * BM * 384 * 2; u.B = (const char*)(ws + OFF_WATT + WA_UQ) + (size_t)u.pn * BM * 256 * 2; }
    else { const int k = L - 192; u.pm = k >> 2; u.pn = k & 3; u.aux = 1; u.nt = 2; u.A = (const char*)(ws + OFF_BC) + (size_t)u.pm * BM * 384 * 2 + 512; u.B = (const char*)(ws + OFF_WATT + WA_UKV) + (size_t)u.pn * BM * 256 * 2; }
    return true; }
};
struct ProjOrder {
  unsigned char* ws; int G, c;
  __device__ __forceinline__ bool next(int i, Unit& u) const {
    const int b = i % 3; if (!static_tile(i / 3, G, c, T / BM, 4, u.pm, u.pn)) return false;
    const size_t oa = b == 0 ? OFF_AQ : b == 1 ? OFF_AIQ : OFF_CQ;
    u.A = (const char*)(ws + oa) + (size_t)u.pm * BM * 512 * 2; u.B = (const char*)(ws + OFF_WATT + WA_P) + ((size_t)b * 1024 + (size_t)u.pn * BM) * 512 * 2; u.rows = nullptr; u.aux = b; u.nt = 8; return true; }
};

__device__ __forceinline__ void moe_build_map(unsigned* cntp, PG8_LAS unsigned* tab, int tid) {
  if (tid < 64) { const int lane = tid;
    const unsigned c = lane < 32 ? __hip_atomic_load(cntp + lane, __ATOMIC_RELAXED, __HIP_MEMORY_SCOPE_AGENT) : 0u;
    const unsigned nt = (c + 255u) >> 8; unsigned incl = nt;
#pragma unroll
    for (int o = 1; o < 32; o <<= 1) { const unsigned v = (unsigned)__builtin_amdgcn_ds_bpermute(((lane - o) & 63) << 2, (int)incl); if ((lane & 31) >= o) incl += v; }
    const unsigned start = incl - nt;
    if (lane < 32) for (unsigned j = 0; j < nt; ++j) { unsigned valid = c - j * 256u; valid = valid > 256u ? 256u : valid; tab[start + j] = (unsigned)lane | (j << 8) | (valid << 16); }
    if (lane == 31) tab[255] = incl; }
  __syncthreads();
}
template <int NPN, bool DOWN>
struct MoeOrder {
  unsigned char* ws; int G, c; const PG8_LAS unsigned* tab; int lo, hi;
  __device__ __forceinline__ bool next(int i, Unit& u) const {
    const int L = lo + i * G + c, tile = L / NPN, pn = L % NPN; const int total = __builtin_amdgcn_readfirstlane((int)tab[255]); if (c < 0 || L >= hi || tile >= total) return false;
    const unsigned rec = (unsigned)__builtin_amdgcn_readfirstlane((int)tab[tile]);
    const int e = rec & 255u, j = (rec >> 8) & 255u, valid = rec >> 16;
    u.pm = tile; u.pn = pn; u.aux = valid; u.nt = DOWN ? 4 : 16; u.rows = (const int*)(ws + OFF_LIST) + (size_t)e * T + j * 256;
    if (!DOWN) { u.A = (const char*)(ws + OFF_XB); u.B = (const char*)(ws + OFF_WGU) + ((size_t)e * 512 + (size_t)pn * 256) * 1024 * 2; }
    else { u.A = (const char*)(ws + OFF_H) + (size_t)tile * 256 * 256 * 2; u.B = (const char*)(ws + OFF_WD) + ((size_t)e * 1024 + (size_t)pn * 256) * 256 * 2; }
    return true; }
};
struct EpiGU {
  unsigned char* ws;
  __device__ __forceinline__ void operator()(const f32x4 (&acc)[2][2][4][2], const Unit& u, int wr, int wc, int fr, int fq) const {
    const float* rstd = (const float*)(ws + OFF_CTL + CTL_RSTD); const float* tokw = (const float*)(ws + OFF_CTL + CTL_TOKW);
    int ent[8]; float rs[8], wv[8];
#pragma unroll
    for (int k = 0; k < 8; ++k) { const int r = (k >> 2) * HALF + wr * 64 + (k & 3) * 16 + fr; ent[k] = u.rows[r < u.aux ? r : u.aux - 1]; }
#pragma unroll
    for (int k = 0; k < 8; ++k) { rs[k] = rstd[ent[k] >> 1]; wv[k] = tokw[ent[k]]; }
#pragma unroll
    for (int ai = 0; ai < 2; ++ai)
#pragma unroll
      for (int m = 0; m < 4; ++m) { const int r = ai * HALF + wr * 64 + m * 16 + fr; const int k = ai * 4 + m;
        { const float rsk = rs[k], w = wv[k];
          f32x4 h0, h1;
#pragma unroll
          for (int j = 0; j < 4; ++j) { const float a0 = acc[ai][0][m][0][j] * rsk, a1 = acc[ai][0][m][1][j] * rsk;
            h0[j] = a0 * __builtin_amdgcn_rcpf(1.f + __expf(-a0)) * (acc[ai][1][m][0][j] * rsk) * w; h1[j] = a1 * __builtin_amdgcn_rcpf(1.f + __expf(-a1)) * (acc[ai][1][m][1][j] * rsk) * w; }
          *(u32x4*)((bf16_t*)(ws + OFF_H) + ((size_t)u.pm * 256 + r) * 256 + u.pn * 128 + wc * 32 + 8 * fq) = pack8(h0, h1); } }
  }
};
struct EpiDown {
  unsigned char* ws;
  __device__ __forceinline__ void operator()(const f32x4 (&acc)[2][2][4][2], const Unit& u, int wr, int wc, int fr, int fq) const {
    int ent[8];
#pragma unroll
    for (int k = 0; k < 8; ++k) { const int r = (k >> 2) * HALF + wr * 64 + (k & 3) * 16 + fr; ent[k] = u.rows[r < u.aux ? r : u.aux - 1]; }
#pragma unroll
    for (int ai = 0; ai < 2; ++ai)
#pragma unroll
      for (int m = 0; m < 4; ++m) { const int r = ai * HALF + wr * 64 + m * 16 + fr;
        { const int entry = r < u.aux ? ent[ai * 4 + m] : 2 * T;
#pragma unroll
          for (int bj = 0; bj < 2; ++bj) *(u32x4*)((bf16_t*)(ws + OFF_Y) + (size_t)entry * 1024 + u.pn * BM + bj * HALF + wc * 32 + 8 * fq) = pack8(acc[ai][bj][m][0], acc[ai][bj][m][1]); } }
  }
};
}

namespace att {
using bf16x8 = __attribute__((ext_vector_type(8))) short;
using s16x4  = __attribute__((ext_vector_type(4))) short;
using f32x16 = __attribute__((ext_vector_type(16))) float;
using u32x4  = __attribute__((ext_vector_type(4))) unsigned;
constexpr int KVBLK = 64;
constexpr float THR = 8.f, NEG = -1e30f, M_INIT = -1e6f;
#define ASBAR() __builtin_amdgcn_sched_barrier(0)
__device__ __forceinline__ constexpr int crow_c(int r) { return (r & 3) + 8 * (r >> 2); }
__device__ __forceinline__ unsigned cvtpk(float lo, float hi) { unsigned r; asm volatile("v_cvt_pk_bf16_f32 %0, %1, %2" : "=v"(r) : "v"(lo), "v"(hi)); return r; }
template <int MODE> struct Cfg {
  static constexpr int DQK = MODE == 1 ? 192 : 128, ND0 = DQK / 16, KP = DQK * 2, SHM_K = 64 * KP;
  static constexpr float SCALE = MODE == 1 ? 0.07216878364870322f : 0.088388347648318440f;
};
template <int MODE>
__device__ __forceinline__ void partialSM(f32x16& p0, f32x16& p1, float& m_reg, float& mn, float& alpha) {
  constexpr float SC = Cfg<MODE>::SCALE, C = SC * 1.4426950408889634f;
#pragma unroll
  for (int r = 0; r < 16; ++r) { p0[r] *= C; p1[r] *= C; }
  float pmax = p0[0];
#pragma unroll
  for (int r = 1; r < 16; ++r) pmax = fmaxf(pmax, p0[r]);
#pragma unroll
  for (int r = 0; r < 16; ++r) pmax = fmaxf(pmax, p1[r]);
  { auto rr = __builtin_amdgcn_permlane32_swap(__float_as_uint(pmax), __float_as_uint(pmax), false, false);
    pmax = fmaxf(__uint_as_float(rr[0]), __uint_as_float(rr[1])); }
  if (__builtin_expect(__all(pmax - m_reg <= THR * 1.4426950408889634f), 1)) { mn = m_reg; alpha = 1.f; }
  else { mn = fmaxf(m_reg, pmax); alpha = __builtin_amdgcn_exp2f(m_reg - mn); m_reg = mn; }
#pragma unroll
  for (int r = 0; r < 16; ++r) { p0[r] -= mn; p1[r] -= mn; }
#pragma unroll
  for (int r = 0; r < 16; ++r) p0[r] = __builtin_amdgcn_exp2f(p0[r]);
}
__device__ __forceinline__ void finishSM(f32x16& p0, f32x16& p1, float alpha, float& l_reg, bf16x8& pa0, bf16x8& pa1, bf16x8& pa2, bf16x8& pa3) {
#pragma unroll
  for (int r = 0; r < 16; ++r) p1[r] = __builtin_amdgcn_exp2f(p1[r]);
  float ps = 0;
#pragma unroll
  for (int r = 0; r < 16; ++r) ps += p0[r];
#pragma unroll
  for (int r = 0; r < 16; ++r) ps += p1[r];
  { auto rr = __builtin_amdgcn_permlane32_swap(__float_as_uint(ps), __float_as_uint(ps), false, false);
    ps = __uint_as_float(rr[0]) + __uint_as_float(rr[1]); }
  l_reg = l_reg * alpha + ps;
#define PK4(P, BASE, OUT) do { unsigned a0 = cvtpk(P[BASE + 0], P[BASE + 1]), a1 = cvtpk(P[BASE + 2], P[BASE + 3]);   \
    unsigned b0 = cvtpk(P[BASE + 4], P[BASE + 5]), b1 = cvtpk(P[BASE + 6], P[BASE + 7]);                              \
    auto r0 = __builtin_amdgcn_permlane32_swap(a0, b0, false, false); auto r1 = __builtin_amdgcn_permlane32_swap(a1, b1, false, false); \
    u32x4 w = {r0[0], r1[0], r0[1], r1[1]}; OUT = *reinterpret_cast<bf16x8*>(&w); } while (0)
  PK4(p0, 0, pa0); PK4(p0, 8, pa1); PK4(p1, 0, pa2); PK4(p1, 8, pa3);
#undef PK4
}
#define KSWZ(row, colB, KP) ((row) * (KP) + ((colB) ^ (((row) & 7) << 4)))
template <int MODE>
__device__ __forceinline__ void qkt(f32x16& p0, f32x16& p1, const char* Ks, const bf16x8* qr, const char* qx  , int r32, int hi) {
  constexpr int KP = Cfg<MODE>::KP;
  p0 = f32x16{}; p1 = f32x16{};
#pragma unroll
  for (int d0 = 0; d0 < Cfg<MODE>::ND0; ++d0) { const int cb = (d0 * 16 + hi * 8) * 2;
    bf16x8 b0 = *reinterpret_cast<const bf16x8*>(Ks + KSWZ(r32, cb, KP));
    bf16x8 b1 = *reinterpret_cast<const bf16x8*>(Ks + KSWZ(32 + r32, cb, KP));
    const bf16x8 q = d0 < 8 ? qr[d0 < 8 ? d0 : 0] : *reinterpret_cast<const bf16x8*>(qx + (d0 - 8) * 32);
    p0 = __builtin_amdgcn_mfma_f32_32x32x16_bf16(b0, q, p0, 0, 0, 0);
    p1 = __builtin_amdgcn_mfma_f32_32x32x16_bf16(b1, q, p1, 0, 0, 0); }
}
__device__ __forceinline__ int v_st(int k, int c) { const int kk = (k & ~0xC) | ((k & 4) << 1) | ((k & 8) >> 1); return ((kk >> 3) * 4 + (c >> 5)) * 512 + ((kk & 7) * 32 + (c & 31)) * 2; }
__device__ __forceinline__ int v_rd_base(int lane) { return ((lane & 3) << 3) | (((lane >> 2) & 3) << 6) | (((lane >> 4) & 1) << 5) | (((lane >> 5) & 1) << 8); }
constexpr int v_rd_off(int d0, int ks, int half) { return d0 * 512 + ks * 4096 + half * 2048; }
template <int OFF> __device__ __forceinline__ s16x4 tr_read(int vb) {
  s16x4 r; asm volatile("ds_read_b64_tr_b16 %0, %1 offset:%2" : "=&v"(r) : "v"(vb), "i"(OFF) : "memory"); return r;
}
template <int D0> __device__ __forceinline__ void pv_one(f32x16& od, int vb, bf16x8 pa0, bf16x8 pa1, bf16x8 pa2, bf16x8 pa3) {
  const s16x4 l0 = tr_read<v_rd_off(D0, 0, 0)>(vb), h0 = tr_read<v_rd_off(D0, 0, 1)>(vb), l1 = tr_read<v_rd_off(D0, 1, 0)>(vb), h1 = tr_read<v_rd_off(D0, 1, 1)>(vb);
  const s16x4 l2 = tr_read<v_rd_off(D0, 2, 0)>(vb), h2 = tr_read<v_rd_off(D0, 2, 1)>(vb), l3 = tr_read<v_rd_off(D0, 3, 0)>(vb), h3 = tr_read<v_rd_off(D0, 3, 1)>(vb);
  asm volatile("s_waitcnt lgkmcnt(0)" ::: "memory"); ASBAR();
#define PK(L, H) (bf16x8){L[0], L[1], L[2], L[3], H[0], H[1], H[2], H[3]}
  od = __builtin_amdgcn_mfma_f32_32x32x16_bf16(pa0, PK(l0, h0), od, 0, 0, 0);
  od = __builtin_amdgcn_mfma_f32_32x32x16_bf16(pa1, PK(l1, h1), od, 0, 0, 0);
  od = __builtin_amdgcn_mfma_f32_32x32x16_bf16(pa2, PK(l2, h2), od, 0, 0, 0);
  od = __builtin_amdgcn_mfma_f32_32x32x16_bf16(pa3, PK(l3, h3), od, 0, 0, 0);
#undef PK
}
__device__ __forceinline__ void pv_d0(f32x16* o, int vb, bf16x8 pa0, bf16x8 pa1, bf16x8 pa2, bf16x8 pa3) {
  pv_one<0>(o[0], vb, pa0, pa1, pa2, pa3); pv_one<1>(o[1], vb, pa0, pa1, pa2, pa3); pv_one<2>(o[2], vb, pa0, pa1, pa2, pa3); pv_one<3>(o[3], vb, pa0, pa1, pa2, pa3);
}
template <int MODE>
__device__ __forceinline__ void post_scores(f32x16& p0, f32x16& p1, int jt, int jlo_w, int jhi_w, int cw, const char* xl, int qloc, int hi) {
  if (MODE == 0) {
    const uint2 w = *reinterpret_cast<const uint2*>(xl + qloc * 264 + jt * 8);
    const unsigned wl = w.x >> (4 * hi), wh = w.y >> (4 * hi);
#pragma unroll
    for (int r = 0; r < 16; ++r) { const unsigned m0 = (unsigned)__builtin_amdgcn_sbfe((int)wl, crow_c(r), 1), m1 = (unsigned)__builtin_amdgcn_sbfe((int)wh, crow_c(r), 1);
      p0[r] = __uint_as_float((__float_as_uint(p0[r]) & m0) | (__float_as_uint(NEG) & ~m0)); p1[r] = __uint_as_float((__float_as_uint(p1[r]) & m1) | (__float_as_uint(NEG) & ~m1)); }
  } else {
    if (jt > jhi_w || jt < jlo_w) {
#pragma unroll
      for (int r = 0; r < 16; ++r) { p0[r] = NEG; p1[r] = NEG; }
    } else if (MODE == 2) {
      const float* tab = reinterpret_cast<const float*>(xl);
      const int dj = cw - jt;
      if (dj >= 3) { const float bf = tab[256];
#pragma unroll
        for (int r = 0; r < 16; ++r) { p0[r] += bf; p1[r] += bf; } }
      else { const int dbase = dj * 64 + qloc - 4 * hi;
#pragma unroll
        for (int r = 0; r < 16; ++r) { int d0 = dbase - crow_c(r), d1 = d0 - 32; d0 = d0 > 128 ? 128 : d0; d1 = d1 > 128 ? 128 : d1; p0[r] += tab[d0 + 128]; p1[r] += tab[d1 + 128]; } }
    }
  }
}
template <int MODE>
__device__ __forceinline__ void attn_unit(unsigned char* ws, const float* relb, const int tid, char* lds, const int b, const int hx, const int cg, const bool dry = false) {
  using C = Cfg<MODE>;
  constexpr int KP = C::KP, SHM_K = C::SHM_K, SHM_V = 16384, ND0 = C::ND0;
  const int wid = __builtin_amdgcn_readfirstlane(tid >> 6), lane = tid & 63, r32 = lane & 31, hi = lane >> 5;
  char* V_lds = lds; char* K_lds = lds + 2 * SHM_V;
  float* wsc = reinterpret_cast<float*>(lds + 2 * SHM_V + 2 * SHM_K) + wid * 64; float* li_l = wsc; float* al_l = wsc + 32;
  char* xl = lds + 2 * SHM_V + 2 * SHM_K + 2048;
  const size_t tb = (size_t)b * SEQ;
  const int cw = MODE == 0 ? cg : 4 * cg + (wid >> 1);
  const int qloc = (wid & 1) * 32 + r32;
  const size_t tok = tb + (size_t)cw * 64 + qloc;
  const int j0 = MODE == 2 ? (4 * cg - 8 > 0 ? 4 * cg - 8 : 0) : 0;
  const int NT = MODE == 0 ? ((cg + 2) & ~1) : (4 * cg + 4 - j0);
  const int jlo_w = MODE == 2 ? (cw - 8 > 0 ? cw - 8 : 0) : 0, jhi_w = cw;
  const bf16_t* Kh; const bf16_t* Vh; const bf16_t* Kr = nullptr; int LDK;
  if (MODE == 0) { Kh = (const bf16_t*)(ws + OFF_AK) + tb * 128; Vh = (const bf16_t*)(ws + OFF_AV) + tb * 128; LDK = 128; }
  else if (MODE == 1) { Kh = (const bf16_t*)(ws + OFF_KVB) + tb * 1024 + hx * 256; Vh = Kh + 128; Kr = (const bf16_t*)(ws + OFF_BKR) + tb * 64; LDK = 1024; }
  else { Kh = (const bf16_t*)(ws + OFF_CK) + tb * 512 + hx * 128; Vh = (const bf16_t*)(ws + OFF_CV) + tb * 512 + hx * 128; LDK = 512; }
  __syncthreads();
  if (MODE == 0) { const uint2* mb = (const uint2*)(ws + OFF_MASK) + (tb + (size_t)cg * 64) * 32;
    for (int i = tid; i < 64 * 32; i += 512) { const int q = i >> 5, j = i & 31; *reinterpret_cast<uint2*>(xl + q * 264 + j * 8) = mb[i]; } }
  if (MODE == 2) { for (int i = tid; i < 257; i += 512) reinterpret_cast<float*>(xl)[i] = relb[hx * 257 + i] * (1.f / C::SCALE); }
  float m_reg = M_INIT, l_reg = 0; f32x16 o[4] = {}; bf16x8 qr[8];
  const char* qx = xl + wid * 4608 + r32 * 144 + hi * 16;
  { const bf16_t* Qw;
    if (MODE == 0) Qw = (const bf16_t*)(ws + OFF_AQ) + tok * 512 + (wid >> 1) * 128 + hi * 8;
    else if (MODE == 1) Qw = (const bf16_t*)(ws + OFF_QB) + tok * 768 + hx * 128 + hi * 8;
    else Qw = (const bf16_t*)(ws + OFF_CQ) + tok * 512 + hx * 128 + hi * 8;
#pragma unroll
    for (int d0 = 0; d0 < 8; ++d0) qr[d0] = *reinterpret_cast<const bf16x8*>(Qw + d0 * 16);
    if (MODE == 1) { const bf16_t* Qr = (const bf16_t*)(ws + OFF_QB) + tok * 768 + 512 + hx * 64 + hi * 8;
#pragma unroll
      for (int d0 = 8; d0 < ND0; ++d0) *reinterpret_cast<bf16x8*>(const_cast<char*>(qx) + (d0 - 8) * 32) = *reinterpret_cast<const bf16x8*>(Qr + (d0 - 8) * 16); } }
  const int sr = tid >> 4, sc = (tid & 15) * 8, vst0 = v_st(sr, sc), vst1 = v_st(32 + sr, sc);
  const int vb0 = (int)(uintptr_t)V_lds + v_rd_base(lane);
  constexpr int NPI = SHM_K / 8192;
  unsigned koff[NPI], kstr[NPI];
#pragma unroll
  for (int i = 0; i < NPI; ++i) { const int L = (i * 8 + wid) * 1024 + lane * 16, row = L / KP, cs = L % KP, colB = cs ^ ((row & 7) << 4);
    if (MODE == 1 && colB >= 256) { koff[i] = (unsigned)(OFF_BKR + (tb + (size_t)j0 * 64 + row) * 128 + (colB - 256)); kstr[i] = 64 * 128; }
    else { koff[i] = (unsigned)((MODE == 0 ? OFF_AK : MODE == 1 ? OFF_KVB : OFF_CK) + (tb + (size_t)j0 * 64 + row) * (size_t)LDK * 2 + (MODE == 0 ? 0 : MODE == 1 ? hx * 512 : hx * 256) + colB); kstr[i] = 64 * LDK * 2; } }
  bf16x8 vs0, vs1;
#define SLOAD(jrel, bf) do { const int k0_ = kbase + (jrel) * KVBLK; \
    vs0 = *reinterpret_cast<const bf16x8*>(&Vh[(size_t)(k0_ + sr) * LDK + sc]); vs1 = *reinterpret_cast<const bf16x8*>(&Vh[(size_t)(k0_ + 32 + sr) * LDK + sc]); \
    _Pragma("unroll") for (int i_ = 0; i_ < NPI; ++i_) { __builtin_amdgcn_global_load_lds((const unsigned*)(ws + koff[i_]), \
        (__attribute__((address_space(3))) unsigned*)(K_lds + (bf) * SHM_K + (i_ * 8 + wid) * 1024), 16, 0, 0); koff[i_] += (MODE == 1 ? kstr[i_] : (unsigned)(64 * LDK * 2)); } } while (0)
#define SWRITE(bf) do { *reinterpret_cast<bf16x8*>(V_lds + (bf) * SHM_V + vst0) = vs0; *reinterpret_cast<bf16x8*>(V_lds + (bf) * SHM_V + vst1) = vs1; } while (0)
#define RESC(a) do { if (__any((a) < 1.f)) { if (hi == 0) al_l[r32] = (a); asm volatile("s_waitcnt lgkmcnt(0)" ::: "memory"); \
    _Pragma("unroll") for (int d = 0; d < 4; ++d) _Pragma("unroll") for (int r = 0; r < 16; ++r) o[d][r] *= al_l[crow_c(r) + 4 * hi]; } } while (0)
#define POST(P0, P1, jrel) post_scores<MODE>(P0, P1, j0 + (jrel), jlo_w, jhi_w, cw, xl, qloc, hi)
  const int kbase = j0 * KVBLK; (void)kbase;
  bf16x8 pa0, pa1, pa2, pa3;
  if (MODE != 2) {
    f32x16 p0, p1; float mn, al;
    SLOAD(0, 0); asm volatile("s_waitcnt vmcnt(0)" ::: "memory"); SWRITE(0); __syncthreads();
    for (int j = 0; j < NT; j += 2) {
      SLOAD(j + 1, 1); ASBAR();
      qkt<MODE>(p0, p1, K_lds, qr, qx, r32, hi); POST(p0, p1, j); partialSM<MODE>(p0, p1, m_reg, mn, al); RESC(al);
      finishSM(p0, p1, al, l_reg, pa0, pa1, pa2, pa3); ASBAR();
      pv_d0(o, vb0, pa0, pa1, pa2, pa3);
      asm volatile("s_waitcnt vmcnt(0)" ::: "memory"); SWRITE(1); __syncthreads();
      const bool more = j + 2 < NT;
      if (more) SLOAD(j + 2, 0);
      ASBAR();
      qkt<MODE>(p0, p1, K_lds + SHM_K, qr, qx, r32, hi); POST(p0, p1, j + 1); partialSM<MODE>(p0, p1, m_reg, mn, al); RESC(al);
      finishSM(p0, p1, al, l_reg, pa0, pa1, pa2, pa3); ASBAR();
      pv_d0(o, vb0 + SHM_V, pa0, pa1, pa2, pa3);
      asm volatile("s_waitcnt vmcnt(0)" ::: "memory"); if (more) SWRITE(0); __syncthreads();
    }
  } else {
    f32x16 pA0, pA1, pB0, pB1; float mnA, mnB, alA, alB;
    SLOAD(0, 0); asm volatile("s_waitcnt vmcnt(0)" ::: "memory"); SWRITE(0); __syncthreads();
    qkt<MODE>(pA0, pA1, K_lds, qr, qx, r32, hi); POST(pA0, pA1, 0); partialSM<MODE>(pA0, pA1, m_reg, mnA, alA);
    SLOAD(1, 1);
    asm volatile("s_waitcnt vmcnt(0)" ::: "memory"); SWRITE(1); __syncthreads();
    for (int j = 1; j + 1 < NT; j += 2) {
      ASBAR(); qkt<MODE>(pB0, pB1, K_lds + SHM_K, qr, qx, r32, hi); POST(pB0, pB1, j);
      finishSM(pA0, pA1, alA, l_reg, pa0, pa1, pa2, pa3); ASBAR();
      SLOAD(j + 1, 0); ASBAR();
      pv_d0(o, vb0, pa0, pa1, pa2, pa3); partialSM<MODE>(pB0, pB1, m_reg, mnB, alB);
      __syncthreads(); asm volatile("s_waitcnt vmcnt(0)" ::: "memory"); SWRITE(0);
      RESC(alB); __syncthreads();
      ASBAR(); qkt<MODE>(pA0, pA1, K_lds, qr, qx, r32, hi); POST(pA0, pA1, j + 1);
      finishSM(pB0, pB1, alB, l_reg, pa0, pa1, pa2, pa3); ASBAR();
      SLOAD(j + 2, 1); ASBAR();
      pv_d0(o, vb0 + SHM_V, pa0, pa1, pa2, pa3); partialSM<MODE>(pA0, pA1, m_reg, mnA, alA);
      __syncthreads(); asm volatile("s_waitcnt vmcnt(0)" ::: "memory"); SWRITE(1);
      RESC(alA); __syncthreads();
    }
    ASBAR(); qkt<MODE>(pB0, pB1, K_lds + SHM_K, qr, qx, r32, hi); POST(pB0, pB1, NT - 1);
    finishSM(pA0, pA1, alA, l_reg, pa0, pa1, pa2, pa3); ASBAR();
    pv_d0(o, vb0, pa0, pa1, pa2, pa3); partialSM<MODE>(pB0, pB1, m_reg, mnB, alB);
    __syncthreads(); RESC(alB);
    finishSM(pB0, pB1, alB, l_reg, pa0, pa1, pa2, pa3); ASBAR();
    pv_d0(o, vb0 + SHM_V, pa0, pa1, pa2, pa3);
  }
  int lane_e = lane; asm volatile("" : "+v"(lane_e));
  const int r32e = lane_e & 31, hie = lane_e >> 5;
  if (hi == 0) li_l[r32] = l_reg; asm volatile("s_waitcnt lgkmcnt(0)" ::: "memory");
  float rli[16];
#pragma unroll
  for (int r = 0; r < 16; ++r) rli[r] = __builtin_amdgcn_rcpf(li_l[crow_c(r) + 4 * hi]);
  __syncthreads();
  char* Ost = lds + wid * 8192;
#pragma unroll
  for (int r = 0; r < 16; ++r) { const int orow = crow_c(r) + 4 * hie;
#pragma unroll
    for (int d0 = 0; d0 < 4; ++d0) *reinterpret_cast<bf16_t*>(Ost + orow * 256 + (d0 * 32 + r32e) * 2) = f2bf(o[d0][r] * rli[r]); }
  asm volatile("s_waitcnt lgkmcnt(0)" ::: "memory");
  { bf16_t* Ob; int ldo;
    const size_t tok0 = tb + (size_t)cw * 64 + (wid & 1) * 32;
    if (MODE == 0) { Ob = (bf16_t*)(ws + OFF_AQ) + tok0 * 512 + (wid >> 1) * 128; ldo = 512; }
    else if (MODE == 1) { Ob = (bf16_t*)(ws + OFF_AIQ) + tok0 * 512 + hx * 128; ldo = 512; }
    else { Ob = (bf16_t*)(ws + OFF_CQ) + tok0 * 512 + hx * 128; ldo = 512; }
#pragma unroll
    for (int i = 0; i < 8; ++i) { const int ch = i * 64 + lane_e, row = ch >> 4, c16 = ch & 15;
      const u32x4 ov = *reinterpret_cast<const u32x4*>(Ost + row * 256 + c16 * 16); if (!dry) *reinterpret_cast<u32x4*>(Ob + (size_t)row * ldo + c16 * 8) = ov; } }
#undef SLOAD
#undef SWRITE
#undef RESC
#undef POST
}
}

namespace idx {
using bf16x8 = __attribute__((ext_vector_type(8))) short;
using f32x4 = __attribute__((ext_vector_type(4))) float;
__device__ __forceinline__ unsigned ordkey(float f) { const unsigned u = __float_as_uint(f); return (u & 0x80000000u) ? ~u : (u | 0x80000000u); }
__device__ __forceinline__ void select2(const unsigned (&key)[2][32], const int nw, unsigned* h0p, unsigned* h1p, const int lane_in, unsigned (&thr)[2], bool (&allsel)[2]) {
  unsigned prefix[2] = {0u, 0u}; int rneed[2] = {256, 256}; bool done[2] = {false, false};
  thr[0] = thr[1] = 0u; allsel[0] = allsel[1] = false;
#pragma unroll
  for (int pass = 0; pass < 3; ++pass) {
    if (!(done[0] && done[1])) {
      int lane = lane_in; asm volatile("" : "+v"(lane));
      const int sh = pass == 0 ? 21 : pass == 1 ? 10 : 0, bits = pass == 2 ? 10 : 11; const unsigned nbm = (1u << bits) - 1u;
#pragma unroll
      for (int i = 0; i < 8; ++i) { *reinterpret_cast<uint4*>(reinterpret_cast<char*>(h0p) + (i * 64 + lane) * 16) = make_uint4(0u, 0u, 0u, 0u); *reinterpret_cast<uint4*>(reinterpret_cast<char*>(h1p) + (i * 64 + lane) * 16) = make_uint4(0u, 0u, 0u, 0u); }
#pragma unroll
      for (int i = 0; i < 32; ++i) if (i < nw) {
#pragma unroll
        for (int q = 0; q < 2; ++q) { const bool match = pass == 0 ? true : (key[q][i] >> (sh + bits)) == prefix[q];
          if (match) { const unsigned d = (key[q][i] >> sh) & nbm; atomicAdd(&(q ? h1p : h0p)[(d & ~31u) | ((d & 31u) ^ ((d >> 5) & 31u))], 1u); } } }
      unsigned tl[2] = {0u, 0u};
#pragma unroll
      for (int i = 0; i < 32; ++i) { tl[0] += h0p[32 * lane + (i ^ (lane & 31))]; tl[1] += h1p[32 * lane + (i ^ (lane & 31))]; }
      unsigned S[2] = {tl[0], tl[1]};
#pragma unroll
      for (int o = 1; o < 64; o <<= 1) {
        const unsigned v0 = (unsigned)__builtin_amdgcn_ds_bpermute(((lane + o) & 63) << 2, (int)S[0]), v1 = (unsigned)__builtin_amdgcn_ds_bpermute(((lane + o) & 63) << 2, (int)S[1]);
        if (lane + o < 64) { S[0] += v0; S[1] += v1; } }
      int Ls[2], rls[2];
#pragma unroll
      for (int q = 0; q < 2; ++q) { const u64 mk = __ballot((int)S[q] >= rneed[q]); Ls[q] = __builtin_amdgcn_readfirstlane(63 - __clzll(mk));
        rls[q] = __builtin_amdgcn_readlane(rneed[q] - (int)(S[q] - tl[q]), Ls[q]); }
      const int li = lane & 31;
      unsigned hbv[2] = {h0p[32 * Ls[0] + (li ^ (Ls[0] & 31))], h1p[32 * Ls[1] + (li ^ (Ls[1] & 31))]};
      unsigned P[2] = {hbv[0], hbv[1]};
#pragma unroll
      for (int o = 1; o < 32; o <<= 1) {
        const unsigned v0 = (unsigned)__builtin_amdgcn_ds_bpermute(((lane + o) & 63) << 2, (int)P[0]), v1 = (unsigned)__builtin_amdgcn_ds_bpermute(((lane + o) & 63) << 2, (int)P[1]);
        if (li + o < 32) { P[0] += v0; P[1] += v1; } }
#pragma unroll
      for (int q = 0; q < 2; ++q) {
        const unsigned mk2 = (unsigned)__ballot((int)P[q] >= rls[q]);
        const int bi = __builtin_amdgcn_readfirstlane(31 - __clz(mk2));
        const int hbs = __builtin_amdgcn_readlane((int)hbv[q], bi), Pbi = __builtin_amdgcn_readlane((int)P[q], bi);
        const int rn = rls[q] - (Pbi - hbs);
        if (!done[q]) { rneed[q] = rn; prefix[q] = (prefix[q] << bits) | (unsigned)(32 * Ls[q] + bi); thr[q] = prefix[q] << sh;
          if (hbs == rn) { done[q] = true; allsel[q] = true; } }
      }
    }
  }
}
__device__ __forceinline__ u64 mask_words(const unsigned (&key)[32], const unsigned thr, const bool allsel, const int lane) {
  u64 myword = 0ull;
  if (allsel) {
#pragma unroll
    for (int i = 0; i < 32; ++i) { const u64 word = __ballot(key[i] >= thr); if (lane == i) myword = word; }
  } else {
    int cgt = 0;
#pragma unroll
    for (int i = 0; i < 32; ++i) cgt += __popcll(__ballot(key[i] > thr));
    const int need = 256 - cgt; int taken = 0;
#pragma unroll
    for (int i = 0; i < 32; ++i) {
      const bool gt = key[i] > thr, eq = key[i] == thr; const u64 em = __ballot(eq);
      const int before = taken + (int)__builtin_amdgcn_mbcnt_hi((unsigned)(em >> 32), __builtin_amdgcn_mbcnt_lo((unsigned)em, 0u));
      const u64 word = __ballot(gt || (eq && before < need)); taken += __popcll(em);
      if (lane == i) myword = word;
    }
  }
  return myword;
}
__device__ __forceinline__ void indexer_unit(unsigned char* ws, const int tid, char* lds, const int b, const int c, const int half) {
  const int wid = __builtin_amdgcn_readfirstlane(tid >> 6), lane = tid & 63, l15 = lane & 15, G = lane >> 4;
  const size_t tb = (size_t)b * SEQ;
  const int nk = (c + 1) * 64, nw = c + 1, nt16 = nk / 16;
  u64* mrow = (u64*)(ws + OFF_MASK) + (tb + (size_t)c * 64 + half * 32) * 32;
  if (c < 4) {
    for (int i = tid; i < 32 * 32; i += 512) mrow[i] = (i & 31) <= c ? ~0ull : 0ull;
    return;
  }
  float* sc = reinterpret_cast<float*>(lds);
  const bf16_t* aiq = (const bf16_t*)(ws + OFF_AIQ); const bf16_t* aik = (const bf16_t*)(ws + OFF_AIK) + tb * 64; const bf16_t* aiwb = (const bf16_t*)(ws + OFF_AIWB);
  for (int r = 0; r < 2; ++r) {
    {
      const int qbase = c * 64 + half * 32 + r * 16;
      bf16x8 a[2][2][2][2]; f32x4 w[2][2][2];
#pragma unroll
      for (int hh = 0; hh < 2; ++hh)
#pragma unroll
      for (int p = 0; p < 2; ++p) { const size_t tq = tb + qbase + hh * 8 + 4 * p + (l15 >> 2); const int h = l15 & 3;
#pragma unroll
        for (int hg = 0; hg < 2; ++hg)
#pragma unroll
          for (int ks = 0; ks < 2; ++ks) a[hh][p][hg][ks] = *reinterpret_cast<const bf16x8*>(aiq + tq * 512 + (h + 4 * hg) * 64 + 8 * G + 32 * ks);
        { const uint4 wq = *reinterpret_cast<const uint4*>(aiwb + (tb + qbase + hh * 8 + 4 * p + G) * 256);
          w[hh][p][0] = (f32x4){__uint_as_float(wq.x << 16), __uint_as_float(wq.x & 0xffff0000u), __uint_as_float(wq.y << 16), __uint_as_float(wq.y & 0xffff0000u)};
          w[hh][p][1] = (f32x4){__uint_as_float(wq.z << 16), __uint_as_float(wq.z & 0xffff0000u), __uint_as_float(wq.w << 16), __uint_as_float(wq.w & 0xffff0000u)}; } }
      bf16x8 cb[4][2], nb[4][2];
#define IDX_LOADB(dst, t0) do { _Pragma("unroll") for (int k_ = 0; k_ < 4; ++k_) { int tk_ = (t0) + 8 * k_; tk_ = tk_ < nt16 ? tk_ : nt16 - 1; \
        const bf16_t* kp_ = aik + (size_t)(tk_ * 16 + l15) * 64 + 8 * G; dst[k_][0] = *reinterpret_cast<const bf16x8*>(kp_); dst[k_][1] = *reinterpret_cast<const bf16x8*>(kp_ + 32); } } while (0)
      IDX_LOADB(cb, wid);
      for (int t0 = wid; t0 < nt16; t0 += 32) {
        IDX_LOADB(nb, t0 + 32);
#pragma unroll
        for (int k = 0; k < 4; ++k) { const int tk = t0 + 8 * k;
          if (tk < nt16) {
#pragma unroll
            for (int hh = 0; hh < 2; ++hh)
#pragma unroll
            for (int p = 0; p < 2; ++p) {
              f32x4 c0 = {0.f, 0.f, 0.f, 0.f}, c1 = {0.f, 0.f, 0.f, 0.f};
              c0 = __builtin_amdgcn_mfma_f32_16x16x32_bf16(a[hh][p][0][0], cb[k][0], c0, 0, 0, 0); c0 = __builtin_amdgcn_mfma_f32_16x16x32_bf16(a[hh][p][0][1], cb[k][1], c0, 0, 0, 0);
              c1 = __builtin_amdgcn_mfma_f32_16x16x32_bf16(a[hh][p][1][0], cb[k][0], c1, 0, 0, 0); c1 = __builtin_amdgcn_mfma_f32_16x16x32_bf16(a[hh][p][1][1], cb[k][1], c1, 0, 0, 0);
              float sv = 0.f;
#pragma unroll
              for (int j = 0; j < 4; ++j) { const float r0 = __builtin_amdgcn_fmed3f(c0[j], 0.f, __builtin_inff()), r1 = __builtin_amdgcn_fmed3f(c1[j], 0.f, __builtin_inff());
                sv = __builtin_fmaf(r0, w[hh][p][0][j], sv); sv = __builtin_fmaf(r1, w[hh][p][1][j], sv); }
              sc[(8 * hh + 4 * p + G) * 2048 + tk * 16 + l15] = sv; } } }
#pragma unroll
        for (int k = 0; k < 4; ++k) { cb[k][0] = nb[k][0]; cb[k][1] = nb[k][1]; }
      }
#undef IDX_LOADB
    }
    __syncthreads();
    unsigned key[2][32];
#pragma unroll
    for (int i = 0; i < 32; ++i) { const unsigned k0 = ordkey(sc[wid * 2048 + i * 64 + lane]), k1 = ordkey(sc[(wid + 8) * 2048 + i * 64 + lane]);
      key[0][i] = i < nw ? k0 : 0u; key[1][i] = i < nw ? k1 : 0u; }
    asm volatile("s_waitcnt lgkmcnt(0)" ::: "memory");
    unsigned thr[2]; bool allsel[2];
    select2(key, nw, reinterpret_cast<unsigned*>(sc + wid * 2048), reinterpret_cast<unsigned*>(sc + (wid + 8) * 2048), lane, thr, allsel);
    const u64 w0 = mask_words(key[0], thr[0], allsel[0], lane), w1 = mask_words(key[1], thr[1], allsel[1], lane);
    if (lane < 32) { mrow[(size_t)(r * 16 + wid) * 32 + lane] = w0; mrow[(size_t)(r * 16 + wid + 8) * 32 + lane] = w1; }
    __syncthreads();
  }
}
}

#define XB_TMO      128
#define XB_XCNT(j)  (256  + 64 * (j))
#define XB_XSUB(j)  (1280 + 64 * (j))
#define XB_XGEN(j)  (2304 + 64 * (j))
#define XB_TOP      3328
#define XB_TOPGEN   3392
#define XCD_BAR_WORDS 3456
#define XB_SPIN_CAP (1u << 18)
#define LAS __attribute__((address_space(3)))

__device__ __forceinline__ unsigned xb_ld(unsigned* p)              { return __hip_atomic_load(p, __ATOMIC_RELAXED, __HIP_MEMORY_SCOPE_AGENT); }
__device__ __forceinline__ unsigned xb_add(unsigned* p, unsigned v) { return __hip_atomic_fetch_add(p, v, __ATOMIC_RELAXED, __HIP_MEMORY_SCOPE_AGENT); }
__device__ __forceinline__ unsigned xb_xcc_id() { return (unsigned)__builtin_amdgcn_s_getreg((3 << 11) | 20) & 0xFu; }
#define XB_SPIN(cond, bar) do { unsigned _sp = 0; while (cond) { __builtin_amdgcn_s_sleep(1); \
    if ((++_sp & 255u) == 0u) { if (xb_ld(&(bar)[XB_TMO])) break; if (_sp > XB_SPIN_CAP) { atomicAdd(&(bar)[XB_TMO], 1u); break; } } } } while (0)

struct XcdBarrier { unsigned* bar; unsigned x; volatile LAS unsigned* st; };

__device__ __forceinline__ XcdBarrier xcd_barrier_post(unsigned* bar, volatile LAS unsigned* st, int tid) {
    XcdBarrier b; b.bar = bar; b.x = xb_xcc_id(); b.st = st;
    if (tid == 0) (void)xb_add(&bar[XB_XCNT(b.x)], 1u);
    return b;
}
__device__ __forceinline__ void xcd_barrier_complete(unsigned* bar, unsigned x, unsigned& nloc, unsigned& nx) {
    const unsigned G = gridDim.x * gridDim.y * gridDim.z;
    unsigned sum, cnt, mine, sp = 0u;
    for (;;) {
        sum = 0u; cnt = 0u; mine = 0u;
#pragma unroll
        for (unsigned j = 0; j < 16; ++j) { const unsigned c = xb_ld(&bar[XB_XCNT(j)]); sum += c; cnt += (c > 0u) ? 1u : 0u; mine = (j == x) ? c : mine; }
        if (sum == G) break;
        __builtin_amdgcn_s_sleep(1);
        if ((++sp & 255u) == 0u) { if (xb_ld(&bar[XB_TMO])) break; if (sp > XB_SPIN_CAP) { atomicAdd(&bar[XB_TMO], 1u); break; } }
    }
    nloc = mine > 0u ? mine : 1u; nx = cnt > 0u ? cnt : 1u;
}
__device__ __forceinline__ void xcd_barrier(const XcdBarrier& b, int tid) {
    asm volatile("s_waitcnt vmcnt(0)" ::: "memory");
    __syncthreads();
    if (tid == 0) {
        unsigned* bar = b.bar;
        __builtin_amdgcn_s_waitcnt(0);
        unsigned nloc = b.st[0], nx = b.st[1];
        if (nloc == 0u) { xcd_barrier_complete(bar, b.x, nloc, nx); b.st[0] = nloc; b.st[1] = nx; }
        const unsigned old = xb_add(&bar[XB_XSUB(b.x)], 1u);
        const unsigned gen = old / nloc;
        if (old + 1u == (gen + 1u) * nloc) {
            __builtin_amdgcn_fence(__ATOMIC_RELEASE, "agent");
            asm volatile("s_waitcnt vmcnt(0)" ::: "memory");
            const unsigned og = xb_add(&bar[XB_TOP], 1u);
            const unsigned tg = og / nx;
            if (og + 1u == (tg + 1u) * nx) xb_add(&bar[XB_TOPGEN], 1u);
            else XB_SPIN(xb_ld(&bar[XB_TOPGEN]) == tg, bar);
            __builtin_amdgcn_fence(__ATOMIC_ACQUIRE, "agent");
            xb_add(&bar[XB_XGEN(b.x)], 1u);
            asm volatile("s_waitcnt vmcnt(0)" ::: "memory");
        } else {
            XB_SPIN(xb_ld(&bar[XB_XGEN(b.x)]) == gen, bar);
            __builtin_amdgcn_fence(__ATOMIC_ACQUIRE, "agent");
            asm volatile("s_waitcnt vmcnt(0)" ::: "memory");
        }
    }
    __syncthreads();
}

#ifndef RP_PREP
#define RP_PREP 1
#endif
#ifndef RP_P1
#define RP_P1 1
#endif
#ifndef RP_ATT
#define RP_ATT 1
#endif
#ifndef RP_MOE
#define RP_MOE 1
#endif
#ifndef RP_IDX
#define RP_IDX 1
#endif
#ifndef RP_RT
#define RP_RT 1
#endif
#ifndef RP_P4
#define RP_P4 1
#endif
#ifndef RP_UP
#define RP_UP 1
#endif
#ifndef RP_AIW
#define RP_AIW 1
#endif
#ifndef RP_BAR
#define RP_BAR 1
#endif
constexpr int NTHR = 512;
constexpr int LDS_BYTES = 163840;
constexpr int GEMM_LDS_OFF = 1024;
constexpr int XLDS_OFF = 1024 + 131072;
struct Args { const float* in[21]; float* x; unsigned char* ws; };

#define VB_LOOP2(NVB, BODY) do { for (int _i = blockIdx.x; _i < (NVB) / 4; _i += gridDim.x) { const int vb = 4 * _i + 2 * half; BODY; } } while (0)
#define VB_LOOP(NVB, BODY) do { for (int _i = blockIdx.x; _i < (NVB) / 2; _i += gridDim.x) { const int vb = 2 * _i + half; BODY; } } while (0)
#define ROW_LOOP(NROW, BODY) do { for (int row = blockIdx.x * 8 + wave; row < (NROW); row += gridDim.x * 8) { BODY; } } while (0)
#define ELEM_LOOP(N, BODY) do { for (int idx = blockIdx.x * NTHR + tid512; idx < (N); idx += gridDim.x * NTHR) { BODY; } } while (0)

#define AIN(k) as_global(a.in[k])
typedef const __attribute__((address_space(4))) Args* KArgs;
#define PH_BEGIN() KArgs ap_ = (KArgs)__builtin_amdgcn_kernarg_segment_ptr(); asm volatile("" : "+s"(ap_)); const __attribute__((address_space(4))) Args& a = *ap_; \
  int wv_ = wave_u; asm volatile("" : "+s"(wv_)); unsigned z_ = 0u; asm volatile("" : "+v"(z_)); int tid512 = wv_ * 64 + (int)__builtin_amdgcn_mbcnt_hi(~0u, __builtin_amdgcn_mbcnt_lo(~0u, z_)); asm volatile("" : "+v"(tid512)); \
  const int half = tid512 >> 8, tid = tid512 & 255, wave = tid512 >> 6, lane = tid512 & 63; (void)half; (void)tid; (void)wave; (void)lane; \
  size_t zo_ = 0; asm volatile("" : "+s"(zo_)); unsigned char* ws = as_global(a.ws) + zo_; float* x = as_global(a.x) + zo_; \
  char* sm = lds + 1024 + half * 36864; (void)sm; float* rstd = (float*)(ws + OFF_CTL + CTL_RSTD); (void)rstd;

__device__ __forceinline__ void prep_attn_weights(const __attribute__((address_space(4))) Args& a, unsigned char* ws, int l, int half, int tid, char* sm) {
  const float* g_attn = AIN(1) + l * 1024; const float* w_in = AIN(2) + (size_t)l * 1024 * NIN;
  { TrDesc d{w_in, nullptr, g_attn, (bf16_t*)(ws + OFF_WATT + WA_IN), NIN, 1024, NZP, 1}; VB_LOOP2(1664, b_transpose2(d, 0, 0, vb, tid, sm)); }
  { TrDesc d{AIN(4) + (size_t)l * 256 * 768, nullptr, AIN(3) + l * 256, (bf16_t*)(ws + OFF_WATT + WA_UQ), 768, 256, 768, 2}; VB_LOOP2(48, b_transpose2(d, 0, 0, vb, tid, sm)); }
  { TrDesc d{AIN(6) + (size_t)l * 128 * 1024, nullptr, AIN(5) + l * 128, (bf16_t*)(ws + OFF_WATT + WA_UKV), 1024, 128, 1024, 0, 256}; VB_LOOP2(32, b_transpose2(d, 0, 0, vb, tid, sm)); }
  { TrDesc d{AIN(8) + (size_t)l * 512 * 1024, nullptr, nullptr, (bf16_t*)(ws + OFF_WATT + WA_P), 1024, 512, 1024, 0}; VB_LOOP2(128, b_transpose2(d, 0, 0, vb, tid, sm)); }
  { TrDesc d{AIN(9) + (size_t)l * 512 * 1024, nullptr, nullptr, (bf16_t*)(ws + OFF_WATT + WA_P) + (size_t)1024 * 512, 1024, 512, 1024, 0}; VB_LOOP2(128, b_transpose2(d, 0, 0, vb, tid, sm)); }
  { TrDesc d{AIN(10) + (size_t)l * 512 * 1024, nullptr, nullptr, (bf16_t*)(ws + OFF_WATT + WA_P) + (size_t)2 * 1024 * 512, 1024, 512, 1024, 0}; VB_LOOP2(128, b_transpose2(d, 0, 0, vb, tid, sm)); }
  { TrDesc d{AIN(11) + (size_t)l * 1024 * 1024, nullptr, nullptr, (bf16_t*)(ws + OFF_WATT + WA_O), 1024, 1024, 1024, 0}; VB_LOOP2(256, b_transpose2(d, 0, 0, vb, tid, sm)); }
}

__device__ __forceinline__ int att_deal(int which, int i) {
  constexpr int tb[32] = {30, 31, 24, 26, 27, 25, 21, 20, 28, 29, 18, 19, 16, 17, 23, 22, 14, 15, 13, 12, 10, 9, 11, 5, 4, 8, 0, 6, 7, 2, 3, 1};
  constexpr int tc[32] = {22, 16, 15, 24, 27, 31, 10, 21, 0, 3, 9, 12, 11, 8, 1, 2, 30, 26, 29, 5, 19, 23, 17, 14, 13, 4, 25, 7, 6, 18, 20, 28};
  unsigned long long b0 = 0, b1 = 0, b2 = 0, c0 = 0, c1 = 0, c2 = 0;
#pragma unroll
  for (int k = 0; k < 12; ++k) { b0 |= (unsigned long long)tb[k] << (5 * k); b1 |= (unsigned long long)tb[12 + k] << (5 * k); c0 |= (unsigned long long)tc[k] << (5 * k); c1 |= (unsigned long long)tc[12 + k] << (5 * k);
    if (k < 8) { b2 |= (unsigned long long)tb[24 + k] << (5 * k); c2 |= (unsigned long long)tc[24 + k] << (5 * k); } }
  const unsigned long long wsel = which ? (i < 12 ? c0 : i < 24 ? c1 : c2) : (i < 12 ? b0 : i < 24 ? b1 : b2);
  return (int)((wsel >> (5 * (i < 12 ? i : i < 24 ? i - 12 : i - 24))) & 31ull);
}
#define GRID_BAR() do { PH_BEGIN(); XcdBarrier bar_; bar_.bar = (unsigned*)(ws + OFF_CTL + CTL_BAR); bar_.x = xb_xcc_id(); bar_.st = (volatile LAS unsigned*)lds; xcd_barrier(bar_, tid512); } while (0)
template <int l>
__device__ __forceinline__ void layer_phases(const int wave_u, char* lds) {
#define PH_P1() { PH_BEGIN(); __syncthreads(); \
      { pg8::InOrder S{(const char*)(ws + OFF_XB), (const char*)(ws + OFF_WATT + WA_IN), (int)gridDim.x, (int)blockIdx.x}; pg8::EpiIn E{ws}; \
        pg8::gemm_phase<pg8::EpiIn, pg8::InOrder, true, false, 1024, 1024, 1024>(tid512, (PG8_LAS unsigned char*)lds + GEMM_LDS_OFF, S, E); } }
    PH_P1();
#if RP_P1 > 1
    PH_P1();
#endif
#if RP_BAR > 1
    GRID_BAR(); GRID_BAR(); GRID_BAR(); GRID_BAR(); GRID_BAR(); GRID_BAR(); GRID_BAR(); GRID_BAR(); GRID_BAR(); GRID_BAR();
#endif
    GRID_BAR();
#define PH_UP() { PH_BEGIN(); __syncthreads(); pg8::UpOrder S{ws, (int)gridDim.x, (int)blockIdx.x}; pg8::EpiUpBoth E{ws}; \
      pg8::gemm_phase<pg8::EpiUpBoth, pg8::UpOrder, true, false, 384, 256, 256>(tid512, (PG8_LAS unsigned char*)lds + GEMM_LDS_OFF, S, E); }
    PH_UP();
#if RP_UP > 1
    PH_UP();
#endif
#define PH_IDX() { PH_BEGIN(); __syncthreads(); const int w = blockIdx.x, bb = w >> 5, i = w & 31;        \
      idx::indexer_unit(ws, tid512, lds + GEMM_LDS_OFF, bb, i, 0); idx::indexer_unit(ws, tid512, lds + GEMM_LDS_OFF, bb, 31 - i, 1); }
    PH_IDX();
#if RP_IDX > 1
    PH_IDX();
#endif
    GRID_BAR();
#define PH_ATT(dry) \
    { PH_BEGIN(); const int w = blockIdx.x, bb = w >> 5, i = w & 31; att::attn_unit<0>(ws, nullptr, tid512, lds + GEMM_LDS_OFF, bb, 0, i, dry); } \
    { PH_BEGIN(); const int w = blockIdx.x, bb = w >> 5, ub = att_deal(0, w & 31); att::attn_unit<1>(ws, nullptr, tid512, lds + GEMM_LDS_OFF, bb, ub & 3, ub >> 2, dry); } \
    { PH_BEGIN(); const float* relb_ = AIN(7) + l * 4 * 257; const int w = blockIdx.x, bb = w >> 5, uc = att_deal(1, w & 31); att::attn_unit<2>(ws, relb_, tid512, lds + GEMM_LDS_OFF, bb, uc & 3, uc >> 2, dry); }
#if RP_ATT > 1
    PH_ATT(true);
#endif
    PH_ATT(false);
    GRID_BAR();
    { PH_BEGIN(); if (blockIdx.x == 0 && tid512 < 128) ((unsigned*)(ws + OFF_CTL + CTL_CNT))[tid512] = 0u; }
#define PH_P4()     { PH_BEGIN(); __syncthreads(); \
      pg8::ProjOrder S{ws, (int)gridDim.x, (int)blockIdx.x}; pg8::EpiProj E{ws}; \
      pg8::gemm_phase<pg8::EpiProj, pg8::ProjOrder, false, false, 512, 512, 512>(tid512, (PG8_LAS unsigned char*)lds + GEMM_LDS_OFF, S, E); }
    PH_P4();
#if RP_P4 > 1
    PH_P4();
#endif
    GRID_BAR();
    { PH_BEGIN(); __syncthreads();
      pg8::PlainOrder S{(const char*)(ws + OFF_MIX), (const char*)(ws + OFF_WATT + WA_O), 1024, 1024, T / 256, 4, (int)gridDim.x, (int)blockIdx.x, 16}; pg8::EpiOut E{x, (bf16_t*)(ws + OFF_XB)};
      pg8::gemm_phase<pg8::EpiOut, pg8::PlainOrder, false, false, 1024, 1024, 1024>(tid512, (PG8_LAS unsigned char*)lds + GEMM_LDS_OFF, S, E); }
    GRID_BAR();
#define PH_RT(DRY)     { PH_BEGIN(); const float* bg_ = AIN(14) + l * 4; const float* br_ = AIN(16) + l * 32; \
      __syncthreads(); float* wt_ = (float*)(lds + GEMM_LDS_OFF); router_stage((const float*)(ws + OFF_CTL + CTL_WT), wt_, tid512); __syncthreads(); \
      for (int t0 = blockIdx.x * 64; t0 < T; t0 += gridDim.x * 64) \
        router_mfma((const float*)x, wt_, lds + GEMM_LDS_OFF + ROUTER_LDS, bg_, br_, (int*)(ws + OFF_CTL + CTL_TOKE), (float*)(ws + OFF_CTL + CTL_TOKW), rstd, (unsigned*)(ws + OFF_CTL + CTL_CNT), (int*)(ws + OFF_LIST), t0 + (wave & 3) * 16, wave, lane, DRY); \
      __syncthreads(); }
#define PH_MOE_PREP() { PH_BEGIN(); \
      { TrDesc d{AIN(17) + (size_t)l * 32 * 1024 * 256, AIN(18) + (size_t)l * 32 * 1024 * 256, AIN(12) + l * 1024, (bf16_t*)(ws + OFF_WGU), 256, 1024, 512, 3}; \
        b_transpose_stream(d, (size_t)1024 * 256, (size_t)512 * 1024, 128 * 32, (int)blockIdx.x, (int)gridDim.x, half, tid, sm); } \
      { TrDesc d{AIN(19) + (size_t)l * 32 * 256 * 1024, nullptr, nullptr, (bf16_t*)(ws + OFF_WD), 1024, 256, 1024, 0}; \
        b_transpose_stream(d, (size_t)256 * 1024, (size_t)1024 * 256, 64 * 32, (int)blockIdx.x, (int)gridDim.x, half, tid, sm); } }
#if RP_RT > 1
    PH_RT(true);
#endif
#if RP_PREP > 1
    PH_MOE_PREP();
#endif
    if ((blockIdx.x >> 3) & 1) { PH_MOE_PREP(); PH_RT(false); } else { PH_RT(false); PH_MOE_PREP(); }
    GRID_BAR();
#define MOE_TAB ((PG8_LAS unsigned*)((PG8_LAS unsigned char*)lds + XLDS_OFF))
#define PH_MOE_A() { PH_BEGIN(); __syncthreads(); pg8::moe_build_map((unsigned*)(ws + OFF_CTL + CTL_CNT), MOE_TAB, tid512); \
      pg8::MoeOrder<2, false> S{ws, (int)gridDim.x, ((int)blockIdx.x & 7) * 32 + ((int)blockIdx.x >> 3), MOE_TAB, 0, 256}; pg8::EpiGU E{ws};        \
      pg8::gemm_phase<pg8::EpiGU, pg8::MoeOrder<2, false>, true, true, 1024, 1024, 1024>(tid512, (PG8_LAS unsigned char*)lds + GEMM_LDS_OFF, S, E, (PG8_LAS unsigned char*)lds + XLDS_OFF + 1024); }
#define PH_MOE_B() \
    { PH_BEGIN(); __syncthreads(); pg8::moe_build_map((unsigned*)(ws + OFF_CTL + CTL_CNT), MOE_TAB, tid512); \
      pg8::MoeOrder<2, false> S{ws, (int)gridDim.x, (int)blockIdx.x, MOE_TAB, 256, 1 << 30}; pg8::EpiGU E{ws}; \
      pg8::gemm_phase<pg8::EpiGU, pg8::MoeOrder<2, false>, true, true, 1024, 1024, 1024>(tid512, (PG8_LAS unsigned char*)lds + GEMM_LDS_OFF, S, E, (PG8_LAS unsigned char*)lds + XLDS_OFF + 1024); \
      const int nt_ = __builtin_amdgcn_readfirstlane((int)MOE_TAB[255]); const int L_ = 256 + (int)blockIdx.x;       \
      asm volatile("s_waitcnt vmcnt(0)" ::: "memory"); __syncthreads(); \
      if (L_ < 2 * nt_ && tid512 == 0) { __builtin_amdgcn_fence(__ATOMIC_RELEASE, "agent"); asm volatile("s_waitcnt vmcnt(0)" ::: "memory"); \
        __hip_atomic_fetch_add((unsigned*)(ws + OFF_CTL + CTL_CNT) + 64 + (L_ / 2 - 128), 1u, __ATOMIC_RELAXED, __HIP_MEMORY_SCOPE_AGENT); } } \
    { PH_BEGIN(); __syncthreads(); const int nt_ = __builtin_amdgcn_readfirstlane((int)MOE_TAB[255]); const int nx_ = 2 * nt_ > 256 ? 2 * nt_ - 256 : 0; \
      pg8::MoeOrder<4, true> S{ws, (int)gridDim.x - nx_, (int)blockIdx.x - nx_, MOE_TAB, 0, 512}; pg8::EpiDown E{ws}; \
      pg8::gemm_phase<pg8::EpiDown, pg8::MoeOrder<4, true>, true, false, 256, 256, 256>(tid512, (PG8_LAS unsigned char*)lds + GEMM_LDS_OFF, S, E); } \
    { PH_BEGIN(); __syncthreads(); const int nt_ = __builtin_amdgcn_readfirstlane((int)MOE_TAB[255]); const int L_ = 512 + (int)blockIdx.x; \
      if (L_ < 4 * nt_) { if (tid512 == 0) { unsigned* fl_ = (unsigned*)(ws + OFF_CTL + CTL_CNT) + 64 + (L_ / 4 - 128); unsigned sp_ = 0; \
          while (__hip_atomic_load(fl_, __ATOMIC_RELAXED, __HIP_MEMORY_SCOPE_AGENT) < 2u && ++sp_ < (1u << 22)) __builtin_amdgcn_s_sleep(1); \
          __builtin_amdgcn_fence(__ATOMIC_ACQUIRE, "agent"); asm volatile("s_waitcnt vmcnt(0)" ::: "memory"); } } \
      __syncthreads(); \
      pg8::MoeOrder<4, true> S{ws, (int)gridDim.x, (int)blockIdx.x, MOE_TAB, 512, 1 << 30}; pg8::EpiDown E{ws}; \
      pg8::gemm_phase<pg8::EpiDown, pg8::MoeOrder<4, true>, true, false, 256, 256, 256>(tid512, (PG8_LAS unsigned char*)lds + GEMM_LDS_OFF, S, E); }
#if RP_MOE > 1
    PH_MOE_A(); GRID_BAR();
#endif
    PH_MOE_A();
    GRID_BAR();
    PH_MOE_B();
    GRID_BAR();
    if (l == 0) { { PH_BEGIN(); const float* g_ = AIN(12) + 1024; const float* wg_ = AIN(13) + (size_t)1024 * 4; const float* wr_ = AIN(15) + (size_t)1024 * 32; ELEM_LOOP(36 * 1024, b_router_table(g_, wg_, wr_, (float*)(ws + OFF_CTL + CTL_WT), idx)); }
      { PH_BEGIN(); ROW_LOOP(T, b_finalize<false>(x, ws, nullptr, row, lane)); } { PH_BEGIN(); prep_attn_weights(a, ws, 1, half, tid, sm); } if (RP_PREP > 1) { PH_BEGIN(); prep_attn_weights(a, ws, 1, half, tid, sm); } GRID_BAR(); }
    else { PH_BEGIN(); const float* gf_ = AIN(20); ROW_LOOP(T, b_finalize<true>(x, ws, gf_, row, lane)); }
}

__global__ void __launch_bounds__(NTHR, 2) mk_fwd(Args a_in) {
  extern __shared__ __attribute__((aligned(16))) char lds[];
  const int wave_u = __builtin_amdgcn_readfirstlane((int)threadIdx.x >> 6);
  { PH_BEGIN();
    if (tid512 == 0) { ((volatile LAS unsigned*)lds)[0] = 0u; ((volatile LAS unsigned*)lds)[1] = 0u; ((volatile LAS unsigned*)lds)[2] = 0u; ((volatile LAS unsigned*)lds)[3] = 0u; }
    __syncthreads();
    (void)xcd_barrier_post((unsigned*)(ws + OFF_CTL + CTL_BAR), (volatile LAS unsigned*)lds, tid512); }
  { PH_BEGIN(); ELEM_LOOP(2048 * 56, b_rope_tables((float*)(ws + OFF_CTL + CTL_ROPE), idx)); }
  { PH_BEGIN(); const float* g_ = AIN(12); const float* wg_ = AIN(13); const float* wr_ = AIN(15); ELEM_LOOP(36 * 1024, b_router_table(g_, wg_, wr_, (float*)(ws + OFF_CTL + CTL_WT), idx)); }
  { PH_BEGIN(); const float* xin = AIN(0); ROW_LOOP(T, b_x_init(xin, x, (bf16_t*)(ws + OFF_XB), rstd, row, lane)); }
  { PH_BEGIN(); prep_attn_weights(a, ws, 0, half, tid, sm); }
  if (RP_PREP > 1) { PH_BEGIN(); prep_attn_weights(a, ws, 0, half, tid, sm); }
  GRID_BAR();
  layer_phases<0>(wave_u, lds);
  layer_phases<1>(wave_u, lds);
}

extern "C" void kernel_launch(void* const* d_in, const int* in_sizes, int n_in, void* d_out, int out_size, void* d_ws, size_t ws_size, hipStream_t stream) {
  if (ws_size < WS_END) { fprintf(stderr, "kernel_launch: workspace too small: %zu < %zu\n", ws_size, WS_END); return; }
  static int grid = 0;
  if (!grid) {
    int dev = 0, cus = 0, per_cu = 0;
    hipGetDevice(&dev);
    hipDeviceGetAttribute(&cus, hipDeviceAttributeMultiprocessorCount, dev);
    hipFuncSetAttribute((const void*)mk_fwd, hipFuncAttributeMaxDynamicSharedMemorySize, LDS_BYTES);
    hipOccupancyMaxActiveBlocksPerMultiprocessor(&per_cu, (const void*)mk_fwd, NTHR, LDS_BYTES);
    if (per_cu < 1) { fprintf(stderr, "kernel_launch: occupancy query says %d blocks per CU\n", per_cu); return; }
    if (cus < 256) { fprintf(stderr, "kernel_launch: this kernel is laid out for 256 workgroups, one per CU; the device reports %d CUs\n", cus); return; }
    grid = 256;
  }
  Args a{};
  for (int i = 0; i < 21; ++i) a.in[i] = (const float*)d_in[i];
  a.x = (float*)d_out; a.ws = (unsigned char*)d_ws;
  hipMemsetAsync((unsigned char*)d_ws + OFF_CTL + CTL_BAR, 0, XCD_BAR_WORDS * sizeof(unsigned), stream);
  hipLaunchKernelGGL(mk_fwd, dim3(grid), dim3(NTHR), LDS_BYTES, stream, a);
}
```
